# Optimizing an MI355X kernel written in HIP

```python
import math
import jax, jax.numpy as jnp
from jax import lax
import numpy as np


D_MODEL = 2048
BATCH = 2
SEQ = 4096
DEPTH = 2
DEC_BATCH = 32
DEC_SEQ = 32
PAST_LEN = 4096

CHUNK = 64
N_EVEN = (DEPTH + 1) // 2
N_ODD = DEPTH // 2
A_WIDTH = D_MODEL // 2
A_HEADS = 8
A_HEAD_DIM = A_WIDTH // A_HEADS
A_BLOCK = 128
B_WIDTH = D_MODEL - A_WIDTH
B_HEADS = 4
B_KEY_DIM = 128
B_KEY_WIDTH = B_HEADS * B_KEY_DIM
B_VAL_DIM = B_WIDTH // B_HEADS
B_GATE_RANK = 16
B_GATE_TAU = 16.0
IN_EVEN = 2 * A_WIDTH + 2 * B_KEY_WIDTH + 2 * B_WIDTH + B_GATE_RANK
C_WIDTH = D_MODEL // 2
POOL_WINDOWS = (2, 4, 8, 16)
C_GROUPS = 4
C_GROUP_DIM = C_WIDTH // C_GROUPS
POOL_BUF = max(POOL_WINDOWS) - 1
D_WIDTH = D_MODEL - C_WIDTH
S5_GROUP_DIM = 16
S5_GROUPS = D_WIDTH // S5_GROUP_DIM
S5_STATE = 64
IN_ODD = C_WIDTH + D_WIDTH
D_FF = 5632
CONV_W = 3
EPS = 1e-6

kernel_name = "hybrid_streaming_encoder_step"


def rms_norm(x, g):
    xf = x.astype(jnp.float32)
    y = xf * lax.rsqrt(jnp.mean(xf * xf, axis=-1, keepdims=True) + EPS)
    return (y * g.astype(jnp.float32)).astype(x.dtype)


def layer_norm(x, g):
    xf = x.astype(jnp.float32)
    mu = jnp.mean(xf, axis=-1, keepdims=True)
    xc = xf - mu
    y = xc * lax.rsqrt(jnp.mean(xc * xc, axis=-1, keepdims=True) + EPS)
    return (y * g.astype(jnp.float32)).astype(x.dtype)


def block_causal_mask(n):
    i = jnp.arange(n)
    return (i[None, :] // CHUNK) <= (i[:, None] // CHUNK)


def spatial_gate(u, v, w_s, b_s):
    L = u.shape[2]
    w = jnp.where(block_causal_mask(L)[None], w_s[:, :L, :L], 0.0)
    s = jnp.einsum('hij,bnjhd->bnihd', w, v) + b_s[:, :L].T[None, None, :, :, None]
    return u * s


def gla_chunks(q, k, v, log_g, s0):
    def step(s, inp):
        qc, kc, vc, gc = inp
        cum = jnp.cumsum(gc, axis=1)
        tot = cum[:, -1]
        kd = kc * jnp.exp(tot[:, None] - cum)
        s = jnp.exp(tot)[..., None] * s + jnp.einsum('blhk,blhv->bhkv', kd, vc)
        o = jnp.einsum('blhk,bhkv->blhv', qc, s)
        return s, o
    xs = (jnp.moveaxis(q, 1, 0), jnp.moveaxis(k, 1, 0), jnp.moveaxis(v, 1, 0), jnp.moveaxis(log_g, 1, 0))
    s, o = lax.scan(step, s0, xs)
    return jnp.moveaxis(o, 0, 1), s


def even_mixer(h, s0, w_in, w_s, b_s, v_gain, w_gate, gate_bias, o_gain, w_out, a_len, b_len):
    bsz, t, _ = h.shape
    f32 = jnp.float32
    proj = h @ w_in
    o1 = A_WIDTH; o2 = o1 + A_WIDTH; o3 = o2 + B_KEY_WIDTH; o4 = o3 + B_KEY_WIDTH
    o5 = o4 + B_WIDTH; o6 = o5 + B_WIDTH
    a_u, a_v, q, k, v, r, g_lr = jnp.split(proj, [o1, o2, o3, o4, o5, o6], axis=-1)
    a_u = jax.nn.gelu(a_u)
    a_v = layer_norm(jax.nn.gelu(a_v), v_gain)
    shp = (bsz, t // a_len, a_len, A_HEADS, A_HEAD_DIM)
    a_out = spatial_gate(a_u.reshape(shp), a_v.reshape(shp), w_s, b_s).reshape(bsz, t, A_WIDTH)
    log_g = jax.nn.log_sigmoid((g_lr @ w_gate + gate_bias).astype(f32)) / B_GATE_TAU
    nc = t // b_len
    def heads(z, d):
        return z.astype(f32).reshape(bsz, nc, b_len, B_HEADS, d)
    o, s_new = gla_chunks(heads(q, B_KEY_DIM) * (B_KEY_DIM ** -0.5), heads(k, B_KEY_DIM),
                          heads(v, B_VAL_DIM), heads(log_g, B_KEY_DIM), s0.astype(f32))
    o = o * lax.rsqrt(jnp.mean(o * o, axis=-1, keepdims=True) + EPS)
    o = o.reshape(bsz, t, B_WIDTH) * o_gain.astype(f32) * jax.nn.silu(r.astype(f32))
    y = jnp.concatenate([a_out, o.astype(h.dtype)], axis=-1) @ w_out
    return y, s_new.astype(s0.dtype), a_v


def pool_mix(c, buf, pos0, c_map, c_scale):
    bsz, t, _ = c.shape
    f32 = jnp.float32
    xp = jnp.concatenate([buf.astype(c.dtype), c], axis=1)
    new_buf = xp[:, -POOL_BUF:]
    xf = xp.astype(f32)
    cs = jnp.concatenate([jnp.zeros((bsz, 1, C_WIDTH), f32), jnp.cumsum(xf, axis=1)], axis=1)
    pos = pos0 + jnp.arange(t)
    groups = []
    for g, w in enumerate(POOL_WINDOWS):
        lo, hi = g * C_GROUP_DIM, (g + 1) * C_GROUP_DIM
        total = cs[:, POOL_BUF + 1:POOL_BUF + 1 + t, lo:hi] - cs[:, POOL_BUF + 1 - w:POOL_BUF + 1 - w + t, lo:hi]
        cnt = jnp.minimum(pos + 1, w).astype(f32)
        groups.append(total / cnt[None, :, None])
    pooled = jnp.stack(groups, axis=2)
    delta = pooled - xf[:, POOL_BUF:].reshape(bsz, t, C_GROUPS, C_GROUP_DIM)
    y = jnp.einsum('btgc,gcd->btgd', delta, c_map.astype(f32)).reshape(bsz, t, C_WIDTH) * c_scale.astype(f32)
    return y.astype(c.dtype), new_buf


def s5_mix(u, s_re0, s_im0, a_re, a_im, log_dt, b_re, b_im, c_re, c_im, d_skip, w_glu):
    bsz, t, _ = u.shape
    f32 = jnp.float32
    ug = u.astype(f32).reshape(bsz, t, S5_GROUPS, S5_GROUP_DIM)
    lam = lax.complex(a_re.astype(f32), a_im.astype(f32))
    dt = jnp.exp(log_dt.astype(f32))[:, None]
    lam_bar = jnp.exp(lam * dt)
    b_bar = ((lam_bar - 1.0) / lam)[..., None] * lax.complex(b_re.astype(f32), b_im.astype(f32))
    bu = lax.complex(jnp.einsum('btgh,gph->btgp', ug, jnp.real(b_bar)),
                     jnp.einsum('btgh,gph->btgp', ug, jnp.imag(b_bar)))
    a_seq = jnp.broadcast_to(lam_bar, bu.shape)
    def combine(left, right):
        a1, x1 = left
        a2, x2 = right
        return a1 * a2, a2 * x1 + x2
    a_cum, s = lax.associative_scan(combine, (a_seq, bu), axis=1)
    s0 = lax.complex(s_re0.astype(f32), s_im0.astype(f32))
    s = s + a_cum * s0[:, None]
    y = (jnp.einsum('btgp,ghp->btgh', jnp.real(s), c_re.astype(f32))
         - jnp.einsum('btgp,ghp->btgh', jnp.imag(s), c_im.astype(f32))
         + d_skip.astype(f32).reshape(S5_GROUPS, S5_GROUP_DIM) * ug)
    y = jax.nn.gelu(y).reshape(bsz, t, D_WIDTH).astype(u.dtype)
    g_a, g_b = jnp.split(y @ w_glu, 2, axis=-1)
    out = g_a * jax.nn.sigmoid(g_b)
    s_last = s[:, -1]
    return out, jnp.real(s_last).astype(s_re0.dtype), jnp.imag(s_last).astype(s_im0.dtype)


def odd_mixer(h, pool_buf, s_re0, s_im0, pos0, w_in, c_map, c_scale, a_re, a_im, log_dt,
              b_re, b_im, c_re, c_im, d_skip, w_glu, w_out):
    proj = h @ w_in
    c_in, d_in = jnp.split(proj, [C_WIDTH], axis=-1)
    c_out, pool_new = pool_mix(c_in, pool_buf, pos0, c_map, c_scale)
    d_out, re_new, im_new = s5_mix(d_in, s_re0, s_im0, a_re, a_im, log_dt, b_re, b_im, c_re, c_im, d_skip, w_glu)
    y = jnp.concatenate([c_out, d_out], axis=-1) @ w_out
    return y, pool_new, re_new, im_new


def conv_ffn(h, buf, w_up, conv_w, conv_b, w_down):
    t = h.shape[1]
    gate, val = jnp.split(h @ w_up, 2, axis=-1)
    gp = jnp.concatenate([buf.astype(gate.dtype), gate], axis=1)
    conv = conv_b
    for k in range(CONV_W):
        conv = conv + conv_w[k] * gp[:, k:k + t]
    out = (jax.nn.gelu(conv) * val) @ w_down
    return out, gp[:, -(CONV_W - 1):]


def trunk(x, gla0, pool0, s5re0, s5im0, ffn0, pos0, a_len, b_len, p):
    new_gla, new_av, new_pool, new_re, new_im, new_ffn = [], [], [], [], [], []
    for layer in range(DEPTH):
        i = layer // 2
        h = rms_norm(x, p['norm_mix_pre'][layer])
        if layer % 2 == 0:
            m, s_new, av = even_mixer(h, gla0[i], p['w_in_even'][i], p['a_w_s'][i], p['a_b_s'][i],
                                      p['a_v_norm'][i], p['b_w_gate'][i], p['b_gate_bias'][i],
                                      p['b_out_norm'][i], p['w_out_even'][i], a_len, b_len)
            new_gla.append(s_new)
            new_av.append(av)
        else:
            m, pb, sre, sim = odd_mixer(h, pool0[i], s5re0[i], s5im0[i], pos0, p['w_in_odd'][i],
                                        p['c_map'][i], p['c_scale'][i], p['s5_a_re'][i], p['s5_a_im'][i],
                                        p['s5_log_dt'][i], p['s5_b_re'][i], p['s5_b_im'][i],
                                        p['s5_c_re'][i], p['s5_c_im'][i], p['s5_d'][i],
                                        p['s5_w_glu'][i], p['w_out_odd'][i])
            new_pool.append(pb)
            new_re.append(sre)
            new_im.append(sim)
        x = x + rms_norm(m, p['norm_mix_post'][layer])
        h = rms_norm(x, p['norm_ffn_pre'][layer])
        f, fb = conv_ffn(h, ffn0[layer], p['ffn_w_up'][layer], p['ffn_conv_w'][layer],
                         p['ffn_conv_b'][layer], p['ffn_w_down'][layer])
        new_ffn.append(fb)
        x = x + rms_norm(f, p['norm_ffn_post'][layer])
    return (x, jnp.stack(new_gla), jnp.stack(new_av), jnp.stack(new_pool),
            jnp.stack(new_re), jnp.stack(new_im), jnp.stack(new_ffn))


def setup_inputs(seed: int = 0) -> dict:
    key = jax.random.key(seed)
    keys = jax.random.split(key, 64)
    it = iter(range(64))

    def nrm(shape, scale):
        return scale * jax.random.normal(keys[next(it)], shape, jnp.float32)

    n_idx = jnp.arange(S5_STATE, dtype=jnp.float32)
    return {
        'x_prompt': nrm((BATCH, SEQ, D_MODEL), 1.0),
        'x_sample': nrm((DEC_BATCH, DEC_SEQ, D_MODEL), 1.0),
        'state_gla': nrm((N_EVEN, DEC_BATCH, B_HEADS, B_KEY_DIM, B_VAL_DIM), 1.0),
        'state_pool': nrm((N_ODD, DEC_BATCH, POOL_BUF, C_WIDTH), 1.0),
        'state_s5_re': nrm((N_ODD, DEC_BATCH, S5_GROUPS, S5_STATE), 0.3),
        'state_s5_im': nrm((N_ODD, DEC_BATCH, S5_GROUPS, S5_STATE), 0.3),
        'state_ffn_conv': nrm((DEPTH, DEC_BATCH, CONV_W - 1, D_FF), 1.0),
        'norm_mix_pre': 1.0 + nrm((DEPTH, D_MODEL), 0.05),
        'norm_mix_post': 1.0 + nrm((DEPTH, D_MODEL), 0.05),
        'norm_ffn_pre': 1.0 + nrm((DEPTH, D_MODEL), 0.05),
        'norm_ffn_post': 1.0 + nrm((DEPTH, D_MODEL), 0.05),
        'w_in_even': nrm((N_EVEN, D_MODEL, IN_EVEN), D_MODEL ** -0.5),
        'a_w_s': nrm((N_EVEN, A_HEADS, A_BLOCK, A_BLOCK), A_BLOCK ** -0.5),
        'a_b_s': 1.0 + nrm((N_EVEN, A_HEADS, A_BLOCK), 0.1),
        'a_v_norm': 1.0 + nrm((N_EVEN, A_WIDTH), 0.05),
        'b_w_gate': nrm((N_EVEN, B_GATE_RANK, B_KEY_WIDTH), B_GATE_RANK ** -0.5),
        'b_gate_bias': 2.0 + nrm((N_EVEN, B_KEY_WIDTH), 0.5),
        'b_out_norm': 1.0 + nrm((N_EVEN, B_WIDTH), 0.05),
        'w_out_even': nrm((N_EVEN, A_WIDTH + B_WIDTH, D_MODEL), (A_WIDTH + B_WIDTH) ** -0.5),
        'w_in_odd': nrm((N_ODD, D_MODEL, IN_ODD), D_MODEL ** -0.5),
        'c_map': nrm((N_ODD, C_GROUPS, C_GROUP_DIM, C_GROUP_DIM), C_GROUP_DIM ** -0.5),
        'c_scale': 1.0 + nrm((N_ODD, C_WIDTH), 0.1),
        's5_a_re': -0.5 + nrm((N_ODD, S5_GROUPS, S5_STATE), 0.01),
        's5_a_im': math.pi * n_idx + nrm((N_ODD, S5_GROUPS, S5_STATE), 0.01),
        's5_log_dt': jax.random.uniform(keys[next(it)], (N_ODD, S5_GROUPS), jnp.float32,
                                        minval=math.log(1e-3), maxval=math.log(1e-1)),
        's5_b_re': nrm((N_ODD, S5_GROUPS, S5_STATE, S5_GROUP_DIM), (2 * S5_GROUP_DIM) ** -0.5),
        's5_b_im': nrm((N_ODD, S5_GROUPS, S5_STATE, S5_GROUP_DIM), (2 * S5_GROUP_DIM) ** -0.5),
        's5_c_re': nrm((N_ODD, S5_GROUPS, S5_GROUP_DIM, S5_STATE), 0.5),
        's5_c_im': nrm((N_ODD, S5_GROUPS, S5_GROUP_DIM, S5_STATE), 0.5),
        's5_d': nrm((N_ODD, D_WIDTH), 0.5),
        's5_w_glu': nrm((N_ODD, D_WIDTH, 2 * D_WIDTH), D_WIDTH ** -0.5),
        'w_out_odd': nrm((N_ODD, C_WIDTH + D_WIDTH, D_MODEL), (C_WIDTH + D_WIDTH) ** -0.5),
        'ffn_w_up': nrm((DEPTH, D_MODEL, 2 * D_FF), D_MODEL ** -0.5),
        'ffn_conv_w': nrm((DEPTH, CONV_W, D_FF), CONV_W ** -0.5),
        'ffn_conv_b': nrm((DEPTH, D_FF), 0.02),
        'ffn_w_down': nrm((DEPTH, D_FF, D_MODEL), D_FF ** -0.5),
    }


def reference(x_prompt, x_sample, state_gla, state_pool, state_s5_re, state_s5_im, state_ffn_conv,
              norm_mix_pre, norm_mix_post, norm_ffn_pre, norm_ffn_post,
              w_in_even, a_w_s, a_b_s, a_v_norm, b_w_gate, b_gate_bias, b_out_norm, w_out_even,
              w_in_odd, c_map, c_scale, s5_a_re, s5_a_im, s5_log_dt, s5_b_re, s5_b_im, s5_c_re, s5_c_im,
              s5_d, s5_w_glu, w_out_odd, ffn_w_up, ffn_conv_w, ffn_conv_b, ffn_w_down):
    p = dict(norm_mix_pre=norm_mix_pre, norm_mix_post=norm_mix_post, norm_ffn_pre=norm_ffn_pre,
             norm_ffn_post=norm_ffn_post, w_in_even=w_in_even, a_w_s=a_w_s, a_b_s=a_b_s,
             a_v_norm=a_v_norm, b_w_gate=b_w_gate, b_gate_bias=b_gate_bias, b_out_norm=b_out_norm,
             w_out_even=w_out_even, w_in_odd=w_in_odd, c_map=c_map, c_scale=c_scale,
             s5_a_re=s5_a_re, s5_a_im=s5_a_im, s5_log_dt=s5_log_dt, s5_b_re=s5_b_re, s5_b_im=s5_b_im,
             s5_c_re=s5_c_re, s5_c_im=s5_c_im, s5_d=s5_d, s5_w_glu=s5_w_glu, w_out_odd=w_out_odd,
             ffn_w_up=ffn_w_up, ffn_conv_w=ffn_conv_w, ffn_conv_b=ffn_conv_b, ffn_w_down=ffn_w_down)
    bp = x_prompt.shape[0]
    dt = x_prompt.dtype
    (y_prompt, gla_prompt, _, pool_prompt, s5_re_prompt, s5_im_prompt, ffn_prompt) = trunk(
        x_prompt,
        jnp.zeros((N_EVEN, bp, B_HEADS, B_KEY_DIM, B_VAL_DIM), dt),
        jnp.zeros((N_ODD, bp, POOL_BUF, C_WIDTH), dt),
        jnp.zeros((N_ODD, bp, S5_GROUPS, S5_STATE), dt),
        jnp.zeros((N_ODD, bp, S5_GROUPS, S5_STATE), dt),
        jnp.zeros((DEPTH, bp, CONV_W - 1, D_FF), dt),
        0, A_BLOCK, CHUNK, p)
    t_s = x_sample.shape[1]
    (y_sample, gla_sample, av_sample, pool_sample, s5_re_sample, s5_im_sample, ffn_sample) = trunk(
        x_sample, state_gla, state_pool, state_s5_re, state_s5_im, state_ffn_conv,
        PAST_LEN, t_s, t_s, p)
    return (y_prompt, y_sample, gla_prompt, gla_sample, av_sample, pool_prompt, pool_sample,
            s5_re_prompt, s5_im_prompt, s5_re_sample, s5_im_sample, ffn_prompt, ffn_sample)
```

```cpp
#include <hip/hip_runtime.h>
#include <hip/hip_cooperative_groups.h>
#include <cstdio>
namespace cg = cooperative_groups;

#define LAS __attribute__((address_space(3)))
typedef unsigned short bf16_t;
typedef short bf16x8 __attribute__((ext_vector_type(8)));
typedef float f32x4 __attribute__((ext_vector_type(4)));
typedef float f32x2 __attribute__((ext_vector_type(2)));
typedef float f32x16 __attribute__((ext_vector_type(16)));
typedef unsigned u32x4 __attribute__((ext_vector_type(4)));
typedef unsigned u32x2 __attribute__((ext_vector_type(2)));

#ifndef MULTI_LAUNCH
#define MULTI_LAUNCH 0
#endif

constexpr int T = 9216, TP = 8192, DM = 2048, DFF = 5632, NE = 5120, NE_SRC = 5136;
constexpr float EPS = 1e-6f;
constexpr int PADK = 64, HLD = DM + PADK, ALD = DFF + PADK, YLD = 1024 + PADK, CLD = 256 + PADK;
constexpr int NPHASE = 21;
__device__ constexpr int SEQ[NPHASE] = {0, 1, 2, 3, 4, 5, 6, 7, 8, 9, 10, 11, 12, 13, 14, 15, 16, 17, 18, 19, 20};
constexpr int LDS_BYTES = 131072 + 16;

constexpr size_t al256(size_t x) { return (x + 255) & ~(size_t)255; }
constexpr size_t SZ_WIN_E = (size_t)NE * HLD * 2, SZ_WG = 16 * DM * 2, SZ_W22 = (size_t)DM * HLD * 2, SZ_WUP = (size_t)2 * DFF * HLD * 2,
                 SZ_WDN = (size_t)DM * ALD * 2, SZ_CMAP = 1024 * CLD * 2, SZ_WGLU = (size_t)2048 * YLD * 2, SZ_WSM = 8 * 128 * 128 * 2;
constexpr size_t OFF_WIN_E = 0;
constexpr size_t OFF_WG = OFF_WIN_E + SZ_WIN_E;
constexpr size_t OFF_WOUT_E = OFF_WG + SZ_WG;
constexpr size_t OFF_WUP0 = OFF_WOUT_E + SZ_W22;
constexpr size_t OFF_WUP1 = OFF_WUP0 + SZ_WUP;
constexpr size_t OFF_WDN0 = OFF_WUP1 + SZ_WUP;
constexpr size_t OFF_WDN1 = OFF_WDN0 + SZ_WDN;
constexpr size_t OFF_WIN_O = OFF_WDN1 + SZ_WDN;
constexpr size_t OFF_CMAP = OFF_WIN_O + SZ_W22;
constexpr size_t OFF_WGLU = OFF_CMAP + SZ_CMAP;
constexpr size_t OFF_WOUT_O = OFF_WGLU + SZ_WGLU;
constexpr size_t OFF_WSM = OFF_WOUT_O + SZ_W22;
constexpr size_t OFF_H = OFF_WSM + SZ_WSM;
constexpr size_t OFF_MIX = OFF_H + (size_t)T * HLD * 2;
constexpr size_t OFF_M = OFF_MIX + (size_t)T * HLD * 2;
constexpr size_t OFF_XA = OFF_M + (size_t)T * DM * 4;
constexpr size_t OFF_R1 = OFF_XA + (size_t)T * DM * 4;
constexpr size_t SZ_R1 = (size_t)T * DFF * 2 + (size_t)T * ALD * 2;
constexpr size_t OFF_PROJ = OFF_R1;
constexpr size_t OFF_UT = OFF_PROJ + (size_t)T * NE * 2;
constexpr size_t OFF_ST = OFF_UT + (size_t)512 * 256 * 128 * 4;
constexpr size_t OFF_DECAY = OFF_ST + (size_t)640 * 256 * 128 * 2;
constexpr size_t OFF_GLR = OFF_DECAY + (size_t)640 * 128 * 4;
static_assert(OFF_GLR + (size_t)T * 16 * 4 <= OFF_R1 + SZ_R1, "arena");
constexpr size_t OFF_GATE = OFF_R1;
constexpr size_t OFF_VAL = OFF_R1 + (size_t)T * DFF * 2;
constexpr size_t OFF_GF = OFF_R1;
constexpr size_t OFF_VF = OFF_GF + (size_t)576 * DFF * 2;
constexpr size_t OFF_GL = OFF_VF + (size_t)576 * DFF * 2;
constexpr size_t OFF_PROJ2 = OFF_R1;
constexpr size_t OFF_DELTA = OFF_PROJ2 + (size_t)T * DM * 4;
constexpr size_t OFF_YB = OFF_DELTA + (size_t)T * YLD * 2;
constexpr size_t OFF_E = OFF_YB + (size_t)T * YLD * 2;
constexpr size_t OFF_SLAB_A = OFF_R1;
constexpr size_t OFF_SLAB_B = OFF_MIX;
constexpr size_t OFF_BAR = OFF_R1 + SZ_R1;
constexpr size_t WS_END = OFF_BAR + 16384;

constexpr size_t O_Y = 0;
constexpr size_t O_GLA_P = O_Y + (size_t)T * DM;
constexpr size_t O_GLA_S = O_GLA_P + 2 * 4 * 128 * 256;
constexpr size_t O_AV = O_GLA_S + (size_t)32 * 4 * 128 * 256;
constexpr size_t O_POOL_P = O_AV + (size_t)32 * 32 * 1024;
constexpr size_t O_POOL_S = O_POOL_P + 2 * 15 * 1024;
constexpr size_t O_S5RE_P = O_POOL_S + 32 * 15 * 1024;
constexpr size_t O_S5IM_P = O_S5RE_P + 2 * 64 * 64;
constexpr size_t O_S5RE_S = O_S5IM_P + 2 * 64 * 64;
constexpr size_t O_S5IM_S = O_S5RE_S + 32 * 64 * 64;
constexpr size_t O_FFN_P = O_S5IM_S + 32 * 64 * 64;
constexpr size_t O_FFN_S = O_FFN_P + 2 * 2 * 2 * DFF;
constexpr size_t O_END = O_FFN_S + (size_t)2 * 32 * 2 * DFF;

struct Params {
    const float* in[36];
    float* out;
    unsigned char* ws;
    int ph_lo, ph_hi;
};

__device__ __forceinline__ unsigned cvt_pk_bf16(float lo, float hi) { unsigned r; asm volatile("v_cvt_pk_bf16_f32 %0, %1, %2" : "=v"(r) : "v"(lo), "v"(hi)); return r; }
__device__ __forceinline__ float bf_lo(unsigned w) { return __uint_as_float(w << 16); }
__device__ __forceinline__ float bf_hi(unsigned w) { return __uint_as_float(w & 0xffff0000u); }
__device__ __forceinline__ float bf1(bf16_t b) { return __uint_as_float(((unsigned)b) << 16); }
__device__ __forceinline__ float fast_rcp(float x) { return __builtin_amdgcn_rcpf(x); }
__device__ __forceinline__ float sigmoidf(float x) { return fast_rcp(1.0f + __builtin_amdgcn_exp2f(-1.4426950409f * x)); }
__device__ __forceinline__ float gelu_t(float x) { const float u = x * (1.5957691216f + 0.0713548163f * x * x); return x * fast_rcp(1.0f + __builtin_amdgcn_exp2f(-1.4426950409f * u)); }
__device__ __forceinline__ float wave_sum(float v) {
#pragma unroll
    for (int o = 32; o >= 1; o >>= 1) v += __shfl_xor(v, o);
    return v;
}
__device__ __forceinline__ const float* xrow_in(const Params& p, int row) { return row < TP ? p.in[0] + (size_t)row * DM : p.in[1] + (size_t)(row - TP) * DM; }

namespace pg8 {
constexpr int BM = 256, BK = 64, HALF = 128, HTB = HALF * BK * 2, STAGE_BYTES = 8 * HTB, NXCD = 8, WGM = 8;
__device__ __forceinline__ int lds_byte(int r, int c) { const int st = (r >> 4) * 2 + (c >> 5), rr = r & 15, cc = c & 31, ob = rr * 64 + cc * 2; return st * 1024 + (ob ^ (((ob >> 9) & 1) << 5)); }
__device__ __forceinline__ void stage_rc(int b, int& R, int& C) { const int st = b / 1024, sb = b % 1024, swz = sb ^ (((sb >> 9) & 1) << 5); R = (st >> 1) * 16 + swz / 64; C = (st & 1) * 32 + (swz % 64) / 2; }
__device__ __forceinline__ int perm32(int rho) { const int n = rho >> 4, i = rho & 15; return 8 * (i >> 2) + 4 * n + (i & 3); }
struct Unit { int pm, pn, ks; };
struct Gemm { const bf16_t* A; const bf16_t* Bt; int M, N, K, lda, ldb, a_pn_off; };
struct StaticOrder {
    int nM, nN, nwg, G, c;
    __device__ void init(int M, int N, int G_, int c_) { nM = M / BM; nN = N / BM; nwg = nM * nN; G = G_; c = c_; }
    __device__ bool next(int i, Unit& u) const {
        const long L = (long)i * G + c; if (L >= nwg) return false;
        int wgid = (int)L; { const int q = nwg / NXCD, r = nwg % NXCD, xcd = wgid % NXCD, off = wgid / NXCD; wgid = (xcd < r ? xcd * (q + 1) : r * (q + 1) + (xcd - r) * q) + off; }
        const int nig = WGM * nN, gid = wgid / nig, fm = gid * WGM, gsz = (nM - fm) < WGM ? (nM - fm) : WGM;
        u.pm = fm + ((wgid % nig) % gsz); u.pn = (wgid % nig) / gsz; u.ks = 0; return true;
    }
};
struct SplitOrder {
    int S, nsub, G, c;
    __device__ void init(int nN, int S_, int G_, int c_) { S = S_; nsub = 4 * nN * S_; G = G_; c = c_; }
    __device__ bool next(int i, Unit& u) const {
        const long L = (long)i * G + c; if (L >= nsub) return false;
        const int l = (int)L, tile = l / S; u.ks = l - tile * S; u.pm = tile & 3; u.pn = tile >> 2; return true;
    }
};

struct EpiF32 {
    static constexpr bool PERM = false;
    float* C; int ldc; size_t slab;
    __device__ __forceinline__ void operator()(const f32x4 (&acc)[2][2][4][2], const Unit& u, int wr, int wc, int fr, int fq) const {
        const int row0 = u.pm * BM + wr * 64 + fr, col0 = u.pn * BM + wc * 32 + 4 * fq;
#pragma unroll
        for (int ai = 0; ai < 2; ++ai)
#pragma unroll
            for (int m = 0; m < 4; ++m) { float* rowp = C + (size_t)u.ks * slab + (size_t)(row0 + ai * HALF + m * 16) * ldc + col0;
#pragma unroll
                for (int bj = 0; bj < 2; ++bj)
#pragma unroll
                    for (int n = 0; n < 2; ++n) *(f32x4*)(rowp + bj * HALF + n * 16) = acc[ai][bj][m][n]; }
    }
};
template <int MODE> struct EpiBf16 {
    static constexpr bool PERM = true;
    bf16_t* O; int ldc; int gelu_tiles; const float* scale; size_t slab;
    __device__ __forceinline__ void operator()(const f32x4 (&acc)[2][2][4][2], const Unit& u, int wr, int wc, int fr, int fq) const {
        const int row0 = u.pm * BM + wr * 64 + fr, col0 = u.pn * BM + wc * 32 + 8 * fq;
        bf16_t* Ob = O + (size_t)u.ks * slab;
        const bool dog = (MODE == 1) && (u.pn < gelu_tiles);
#pragma unroll
        for (int ai = 0; ai < 2; ++ai)
#pragma unroll
            for (int m = 0; m < 4; ++m) { bf16_t* rowp = Ob + (size_t)(row0 + ai * HALF + m * 16) * ldc + col0;
#pragma unroll
                for (int bj = 0; bj < 2; ++bj) { f32x4 v0 = acc[ai][bj][m][0], v1 = acc[ai][bj][m][1];
                    if (MODE == 2) { v0 = v0 * *(const f32x4*)(scale + col0 + bj * HALF); v1 = v1 * *(const f32x4*)(scale + col0 + bj * HALF + 4); }
                    if (dog) {
#pragma unroll
                        for (int j = 0; j < 4; ++j) { v0[j] = gelu_t(v0[j]); v1[j] = gelu_t(v1[j]); } }
                    u32x4 w; w.x = cvt_pk_bf16(v0[0], v0[1]); w.y = cvt_pk_bf16(v0[2], v0[3]); w.z = cvt_pk_bf16(v1[0], v1[1]); w.w = cvt_pk_bf16(v1[2], v1[3]);
                    *(u32x4*)(rowp + bj * HALF) = w; } }
    }
};
struct EpiGateVal {
    static constexpr bool PERM = true;
    bf16_t* ACT; bf16_t* GF; bf16_t* VF; bf16_t* GL; float* ffn_p; float* ffn_s; const float* cw; const float* cb;
    __device__ __forceinline__ void operator()(const f32x4 (&acc)[2][2][4][2], const Unit& u, int wr, int wc, int fr, int fq) const {
        const int lane = threadIdx.x & 63, row0 = u.pm * BM + wr * 64 + fr, col0 = u.pn * HALF + wc * 32 + 8 * fq;
        const int src1 = (lane & 48) | ((fr - 1) & 15), src2 = (lane & 48) | ((fr - 2) & 15);
        f32x4 w0[2], w1[2], w2[2], bb[2];
#pragma unroll
        for (int n = 0; n < 2; ++n) { w0[n] = *(const f32x4*)(cw + col0 + 4 * n); w1[n] = *(const f32x4*)(cw + DFF + col0 + 4 * n); w2[n] = *(const f32x4*)(cw + 2 * DFF + col0 + 4 * n); bb[n] = *(const f32x4*)(cb + col0 + 4 * n); }
#pragma unroll
        for (int ai = 0; ai < 2; ++ai) {
            f32x4 pP1[2], pP2[2];
#pragma unroll
            for (int n = 0; n < 2; ++n) { pP1[n] = (f32x4){0.f, 0.f, 0.f, 0.f}; pP2[n] = (f32x4){0.f, 0.f, 0.f, 0.f}; }
#pragma unroll
            for (int m = 0; m < 4; ++m) { const int row = row0 + ai * HALF + m * 16; const size_t off = (size_t)row * ALD + col0;
                const f32x4 g0 = acc[ai][0][m][0], g1v = acc[ai][0][m][1], v0 = acc[ai][1][m][0], v1 = acc[ai][1][m][1];
                u32x2 a2[2];
#pragma unroll
                for (int n = 0; n < 2; ++n) { const f32x4 g = n ? g1v : g0, v = n ? v1 : v0; f32x4 P1, P2;
#pragma unroll
                    for (int j = 0; j < 4; ++j) { P1[j] = __shfl(g[j], src1); P2[j] = __shfl(g[j], src2); }
                    const f32x4 h1 = fr >= 1 ? P1 : pP1[n], h2 = fr >= 2 ? P2 : pP2[n]; pP1[n] = P1; pP2[n] = P2;
                    const f32x4 cv = bb[n] + w0[n] * h2 + w1[n] * h1 + w2[n] * g; f32x4 o;
#pragma unroll
                    for (int j = 0; j < 4; ++j) o[j] = gelu_t(cv[j]) * v[j];
                    a2[n].x = cvt_pk_bf16(o[0], o[1]); a2[n].y = cvt_pk_bf16(o[2], o[3]); }
                const bool deferred = (fr < 2) && (m == 0 || (m == 2 && row >= TP));
                if (!deferred) { *(u32x4*)(ACT + off) = (u32x4){a2[0].x, a2[0].y, a2[1].x, a2[1].y}; }
                else { const size_t so = ((size_t)(row >> 5) * 2 + (row & 1)) * DFF + col0;
                    *(u32x4*)(GF + so) = (u32x4){cvt_pk_bf16(g0[0], g0[1]), cvt_pk_bf16(g0[2], g0[3]), cvt_pk_bf16(g1v[0], g1v[1]), cvt_pk_bf16(g1v[2], g1v[3])};
                    *(u32x4*)(VF + so) = (u32x4){cvt_pk_bf16(v0[0], v0[1]), cvt_pk_bf16(v0[2], v0[3]), cvt_pk_bf16(v1[0], v1[1]), cvt_pk_bf16(v1[2], v1[3])}; }
                if (m == 3 && fr >= 14 && row < TP) { const size_t so = ((size_t)(row >> 6) * 2 + (fr - 14)) * DFF + col0;
                    *(u32x4*)(GL + so) = (u32x4){cvt_pk_bf16(g0[0], g0[1]), cvt_pk_bf16(g0[2], g0[3]), cvt_pk_bf16(g1v[0], g1v[1]), cvt_pk_bf16(g1v[2], g1v[3])}; }
                float* sp = nullptr;
                if (row < TP) { const int t = row & 4095; if (t >= 4094) sp = ffn_p + ((size_t)(row >> 12) * 2 + (t - 4094)) * DFF + col0; }
                else { const int rr = row - TP, t = rr & 31; if (t >= 30) sp = ffn_s + ((size_t)(rr >> 5) * 2 + (t - 30)) * DFF + col0; }
                if (sp) { *(f32x4*)sp = g0; *(f32x4*)(sp + 4) = g1v; } }
        }
    }
};
struct EpiGlu {
    static constexpr bool PERM = true;
    bf16_t* O; int ldc;
    __device__ __forceinline__ void operator()(const f32x4 (&acc)[2][2][4][2], const Unit& u, int wr, int wc, int fr, int fq) const {
        const int row0 = u.pm * BM + wr * 64 + fr, col0 = u.pn * HALF + wc * 32 + 8 * fq;
#pragma unroll
        for (int ai = 0; ai < 2; ++ai)
#pragma unroll
            for (int m = 0; m < 4; ++m) { const int row = row0 + ai * HALF + m * 16;
                f32x4 a0 = acc[ai][0][m][0], a1 = acc[ai][0][m][1]; const f32x4 b0 = acc[ai][1][m][0], b1 = acc[ai][1][m][1];
#pragma unroll
                for (int j = 0; j < 4; ++j) { a0[j] *= sigmoidf(b0[j]); a1[j] *= sigmoidf(b1[j]); }
                u32x4 w; w.x = cvt_pk_bf16(a0[0], a0[1]); w.y = cvt_pk_bf16(a0[2], a0[3]); w.z = cvt_pk_bf16(a1[0], a1[1]); w.w = cvt_pk_bf16(a1[2], a1[3]);
                *(u32x4*)(O + (size_t)row * ldc + col0) = w; }
    }
};

template <class Epi, class Sched>
__device__ __forceinline__ void gemm_phase(LAS unsigned char* lds, const Gemm g, const Sched& S, const Epi& E) {
    const int tid = threadIdx.x, wid = __builtin_amdgcn_readfirstlane(tid >> 6), lane = tid & 63, wr = wid >> 2, wc = wid & 3, fr = lane & 15, fq = lane >> 4;
    const int K = g.K, nt = K / BK;
    unsigned voffA[2], voffB[2];
#pragma unroll
    for (int i = 0; i < 2; ++i) { int R, C; stage_rc(tid * 16 + i * 8192, R, C); const int Rb = Epi::PERM ? ((R & ~31) + perm32(R & 31)) : R;
        voffA[i] = (unsigned)(R * g.lda + C) * 2u; voffB[i] = (unsigned)(Rb * g.ldb + C) * 2u; }
    const size_t kstep = (size_t)(BK * 2);
    const size_t hstepA = (size_t)HALF * g.lda * 2, hstepB = (size_t)HALF * g.ldb * 2;
    const size_t tstepA = 2 * hstepA, tstepB = 2 * hstepB;
    const size_t pnoff = (size_t)g.a_pn_off * 2, ksb = (size_t)g.K * 2;
    const unsigned ldsw = (unsigned)wid * 1024u;
    const int aoff = lds_byte(wr * 64 + fr, fq * 8), boff = lds_byte(wc * 32 + fr, fq * 8);
#define PG8_SA(b, h) (((b) * 2 + (h)) * HTB)
#define PG8_SB(b, h) ((4 + (b) * 2 + (h)) * HTB)
#define PG8_STAGE(bufoff, gbase, voff) do { _Pragma("unroll") for (int _i = 0; _i < 2; ++_i) \
        __builtin_amdgcn_global_load_lds((const unsigned*)((const char*)(gbase) + (voff)[_i]), (LAS unsigned*)(lds + (bufoff) + ldsw + _i * 8192), 16, 0, 0); } while (0)
#define PG8_LDA(dst, b, h) do { _Pragma("unroll") for (int m = 0; m < 4; ++m) _Pragma("unroll") for (int k = 0; k < 2; ++k) dst[m][k] = *(const LAS bf16x8*)(lds + PG8_SA(b, h) + aoff + m * 2048 + k * 1024); } while (0)
#define PG8_LDB(dst, b, h) do { _Pragma("unroll") for (int n = 0; n < 2; ++n) _Pragma("unroll") for (int k = 0; k < 2; ++k) dst[n][k] = *(const LAS bf16x8*)(lds + PG8_SB(b, h) + boff + n * 2048 + k * 1024); } while (0)
#define PG8_MMA(ai, bj, At, Bt) do { __builtin_amdgcn_s_setprio(1); _Pragma("unroll") for (int m = 0; m < 4; ++m) _Pragma("unroll") for (int n = 0; n < 2; ++n) _Pragma("unroll") for (int k = 0; k < 2; ++k) \
        acc[ai][bj][m][n] = __builtin_amdgcn_mfma_f32_16x16x32_bf16(Bt[n][k], At[m][k], acc[ai][bj][m][n], 0, 0, 0); __builtin_amdgcn_s_setprio(0); } while (0)
#define PG8_WAIT_V(n) asm volatile("s_waitcnt vmcnt(" #n ")" ::: "memory")
#define PG8_WAIT_L(n) asm volatile("s_waitcnt lgkmcnt(" #n ")" ::: "memory")
#define PG8_BAR __builtin_amdgcn_s_barrier()
#define PG8_SCHED __builtin_amdgcn_sched_barrier(0)
    Unit cur, nxt; int ui = 0;
    if (!S.next(0, cur)) return;
    f32x4 acc[2][2][4][2];
#pragma unroll
    for (int a = 0; a < 2; ++a)
#pragma unroll
        for (int b = 0; b < 2; ++b)
#pragma unroll
            for (int m = 0; m < 4; ++m)
#pragma unroll
                for (int n = 0; n < 2; ++n) acc[a][b][m][n] = (f32x4){0.f, 0.f, 0.f, 0.f};
    bf16x8 At[4][2], B0[2][2], B1[2][2];
    const char* cA = (const char*)g.A + (size_t)cur.pm * tstepA + (size_t)cur.pn * pnoff + (size_t)cur.ks * ksb; const char* cB = (const char*)g.Bt + (size_t)cur.pn * tstepB + (size_t)cur.ks * ksb;
    PG8_STAGE(PG8_SB(0, 0), cB, voffB); PG8_STAGE(PG8_SA(0, 0), cA, voffA); PG8_STAGE(PG8_SB(0, 1), cB + hstepB, voffB); PG8_STAGE(PG8_SA(0, 1), cA + hstepA, voffA);
    if (wr == 1) PG8_BAR;
    PG8_WAIT_V(4); PG8_BAR;
    PG8_STAGE(PG8_SB(1, 0), cB + kstep, voffB); PG8_STAGE(PG8_SA(1, 0), cA + kstep, voffA); PG8_STAGE(PG8_SB(1, 1), cB + hstepB + kstep, voffB);
    PG8_WAIT_V(6); PG8_BAR;
    for (;;) {
        const bool has_next = S.next(ui + 1, nxt);
        const char* nA = has_next ? (const char*)g.A + (size_t)nxt.pm * tstepA + (size_t)nxt.pn * pnoff + (size_t)nxt.ks * ksb : cA; const char* nB = has_next ? (const char*)g.Bt + (size_t)nxt.pn * tstepB + (size_t)nxt.ks * ksb : cB;
        for (int t = 0; t < nt; t += 2) {
            const bool last = (t == nt - 2);
            const char* a1 = cA + (size_t)(t + 1) * kstep;
            const char* a2 = last ? nA : cA + (size_t)(t + 2) * kstep; const char* b2 = last ? nB : cB + (size_t)(t + 2) * kstep;
            const char* a3 = a2 + kstep; const char* b3 = b2 + kstep;
            PG8_LDB(B0, 0, 0); PG8_SCHED; PG8_LDA(At, 0, 0); PG8_STAGE(PG8_SA(1, 1), a1 + hstepA, voffA);
            PG8_WAIT_L(8); PG8_BAR; PG8_WAIT_L(0); PG8_MMA(0, 0, At, B0); PG8_BAR; PG8_SCHED;
            PG8_LDB(B1, 0, 1); PG8_STAGE(PG8_SB(0, 0), b2, voffB);
            PG8_BAR; PG8_WAIT_L(0); PG8_MMA(0, 1, At, B1); PG8_BAR;
            PG8_LDA(At, 0, 1); PG8_STAGE(PG8_SA(0, 0), a2, voffA);
            PG8_BAR; PG8_WAIT_L(0); PG8_MMA(1, 0, At, B0); PG8_BAR; PG8_SCHED;
            PG8_STAGE(PG8_SB(0, 1), b2 + hstepB, voffB);
            PG8_WAIT_V(6); PG8_BAR; PG8_MMA(1, 1, At, B1); PG8_BAR;
            PG8_LDB(B0, 1, 0); PG8_SCHED; PG8_LDA(At, 1, 0); PG8_STAGE(PG8_SA(0, 1), a2 + hstepA, voffA);
            PG8_WAIT_L(8); PG8_BAR; PG8_WAIT_L(0); PG8_MMA(0, 0, At, B0); PG8_BAR; PG8_SCHED;
            PG8_LDB(B1, 1, 1); PG8_STAGE(PG8_SB(1, 0), b3, voffB);
            PG8_BAR; PG8_WAIT_L(0); PG8_MMA(0, 1, At, B1); PG8_BAR;
            PG8_LDA(At, 1, 1); PG8_STAGE(PG8_SA(1, 0), a3, voffA);
            PG8_BAR; PG8_WAIT_L(0); PG8_MMA(1, 0, At, B0); PG8_BAR; PG8_SCHED;
            PG8_STAGE(PG8_SB(1, 1), b3 + hstepB, voffB);
            PG8_WAIT_V(6); PG8_BAR; PG8_MMA(1, 1, At, B1); PG8_BAR;
        }
        E(acc, cur, wr, wc, fr, fq);
        if (!has_next) break;
#pragma unroll
        for (int a = 0; a < 2; ++a)
#pragma unroll
            for (int b = 0; b < 2; ++b)
#pragma unroll
                for (int m = 0; m < 4; ++m)
#pragma unroll
                    for (int n = 0; n < 2; ++n) acc[a][b][m][n] = (f32x4){0.f, 0.f, 0.f, 0.f};
        cur = nxt; cA = nA; cB = nB; ++ui;
    }
    PG8_WAIT_V(0);
    if (wr == 0) PG8_BAR;
    PG8_BAR;
#undef PG8_SA
#undef PG8_SB
#undef PG8_STAGE
#undef PG8_LDA
#undef PG8_LDB
#undef PG8_MMA
#undef PG8_WAIT_V
#undef PG8_WAIT_L
#undef PG8_BAR
#undef PG8_SCHED
}
}

template <class Epi>
__device__ __forceinline__ void run_gemm(LAS unsigned char* lds, const bf16_t* A, const bf16_t* Bt, int N, int K, int lda, int ldb, int a_pn_off, const Epi& E, int vb, int M = T, int cshift = 0) {
    pg8::Gemm g; g.A = A; g.Bt = Bt; g.M = M; g.N = N; g.K = K; g.lda = lda; g.ldb = ldb; g.a_pn_off = a_pn_off;
    int c = vb - cshift; if (c < 0) c += (int)gridDim.x;
    pg8::StaticOrder S; S.init(M, N, (int)gridDim.x, c);
    pg8::gemm_phase<Epi, pg8::StaticOrder>(lds, g, S, E);
}
__device__ __forceinline__ void run_gemm_split(LAS unsigned char* lds, const bf16_t* A, const bf16_t* Bt, int K, int ld, int S, bf16_t* slabs, int vb) {
    pg8::Gemm g; g.A = A + (size_t)TP * ld; g.Bt = Bt; g.M = 1024; g.N = DM; g.K = K / S; g.lda = ld; g.ldb = ld; g.a_pn_off = 0;
    pg8::SplitOrder O; O.init(8, S, (int)gridDim.x, vb);
    pg8::EpiBf16<1> E; E.O = slabs; E.ldc = DM; E.gelu_tiles = 0; E.scale = nullptr; E.slab = (size_t)1024 * DM;
    pg8::gemm_phase<pg8::EpiBf16<1>, pg8::SplitOrder>(lds, g, O, E);
}

__device__ __forceinline__ void get_job(const Params& p, int j, const float*& src, bf16_t*& dst, int& K, int& N, int& ld, int& half, const float*& nscale) {
    unsigned char* ws = p.ws; half = 0; nscale = nullptr;
    switch (j) {
        case 0: src = p.in[11]; dst = (bf16_t*)(ws + OFF_WIN_E); K = DM; N = NE; ld = NE_SRC; break;
        case 1: src = p.in[18]; dst = (bf16_t*)(ws + OFF_WOUT_E); K = DM; N = DM; ld = DM; break;
        case 2: src = p.in[32]; dst = (bf16_t*)(ws + OFF_WUP0); K = DM; N = 2 * DFF; ld = 2 * DFF; half = DFF; break;
        case 3: src = p.in[32] + (size_t)DM * 2 * DFF; dst = (bf16_t*)(ws + OFF_WUP1); K = DM; N = 2 * DFF; ld = 2 * DFF; half = DFF; break;
        case 4: src = p.in[35]; dst = (bf16_t*)(ws + OFF_WDN0); K = DFF; N = DM; ld = DM; break;
        case 5: src = p.in[35] + (size_t)DFF * DM; dst = (bf16_t*)(ws + OFF_WDN1); K = DFF; N = DM; ld = DM; break;
        case 6: src = p.in[19]; dst = (bf16_t*)(ws + OFF_WIN_O); K = DM; N = DM; ld = DM; break;
        case 7: case 8: case 9: case 10: src = p.in[20] + (size_t)(j - 7) * 65536; dst = (bf16_t*)(ws + OFF_CMAP) + (size_t)(j - 7) * 256 * CLD; K = 256; N = 256; ld = 256; nscale = p.in[21] + (j - 7) * 256; break;
        case 11: src = p.in[30]; dst = (bf16_t*)(ws + OFF_WGLU); K = 1024; N = 2048; ld = 2048; half = 1024; break;
        default: src = p.in[31]; dst = (bf16_t*)(ws + OFF_WOUT_O); K = DM; N = DM; ld = DM; break;
    }
}
struct TileInfo { const float* src; bf16_t* dst; const float* nscale; int K, ld, half, k0, n0; };
__device__ __forceinline__ void prep_decode(const Params& p, int tile, TileInfo& ti) {
    int j, t0;
    if (tile < 640) { j = 0; t0 = 0; } else if (tile < 896) { j = 1; t0 = 640; } else if (tile < 2304) { j = 2; t0 = 896; } else if (tile < 3712) { j = 3; t0 = 2304; }
    else if (tile < 4416) { j = 4; t0 = 3712; } else if (tile < 5120) { j = 5; t0 = 4416; } else if (tile < 5376) { j = 6; t0 = 5120; }
    else if (tile < 5392) { j = 7 + ((tile - 5376) >> 2); t0 = 5376 + ((tile - 5376) & ~3); } else if (tile < 5520) { j = 11; t0 = 5392; } else { j = 12; t0 = 5520; }
    int N; get_job(p, j, ti.src, ti.dst, ti.K, N, ti.ld, ti.half, ti.nscale);
    const int local = tile - t0, ntn = N >> 8, tk = local / ntn, tn = local - tk * ntn; ti.k0 = tk * 64; ti.n0 = tn * 256;
}
constexpr int ND_G1 = 336, ND_G3 = 1456, ND_G4 = 640, ND_DEF = 2768, ND_P0 = ND_DEF - ND_G1 - ND_G3 - ND_G4, NQ_P0 = 3008 + ND_P0;
__device__ __forceinline__ int deferred_tile(int d) { return d < 1408 ? 2304 + d : 4416 + (d - 1408); }
__device__ __forceinline__ int phase0_tile(int q) { if (q < 2304) return q; if (q < 3008) return 3712 + (q - 2304); return deferred_tile(ND_G1 + ND_G3 + ND_G4 + (q - 3008)); }
template <bool P0>
__device__ __forceinline__ void prep_run(const Params& p, LAS unsigned char* lds, int q0, int qs, int qend) {
    const int tid = threadIdx.x, wid = tid >> 6, lane = tid & 63;
    constexpr int TROW = 144;
    int it = 0, q = q0;
    TileInfo cur; f32x4 v[8];
    if (q < qend) { prep_decode(p, P0 ? phase0_tile(q) : deferred_tile(q), cur);
#pragma unroll
        for (int i = 0; i < 8; ++i) v[i] = *(const f32x4*)(cur.src + (size_t)(cur.k0 + wid * 8 + i) * cur.ld + cur.n0 + lane * 4); }
    while (q < qend) {
        LAS unsigned char* buf = lds + (it & 1) * (256 * TROW);
        if (cur.nscale) { const f32x4 sc = *(const f32x4*)(cur.nscale + cur.n0 + lane * 4);
#pragma unroll
            for (int i = 0; i < 8; ++i) v[i] = v[i] * sc; }
#pragma unroll
        for (int e = 0; e < 4; ++e) { u32x4 w; w.x = cvt_pk_bf16(v[0][e], v[1][e]); w.y = cvt_pk_bf16(v[2][e], v[3][e]); w.z = cvt_pk_bf16(v[4][e], v[5][e]); w.w = cvt_pk_bf16(v[6][e], v[7][e]);
            *(LAS u32x4*)(buf + (lane * 4 + e) * TROW + wid * 16) = w; }
        const int nq = q + qs; TileInfo nxt = cur;
        if (nq < qend) { prep_decode(p, P0 ? phase0_tile(nq) : deferred_tile(nq), nxt);
#pragma unroll
            for (int i = 0; i < 8; ++i) v[i] = *(const f32x4*)(nxt.src + (size_t)(nxt.k0 + wid * 8 + i) * nxt.ld + nxt.n0 + lane * 4); }
        __syncthreads();
#pragma unroll
        for (int i = 0; i < 4; ++i) { const int n = i * 64 + (tid >> 3), kq = (tid & 7) * 8; const int ns = cur.n0 + n;
            int drow = ns; if (cur.half) { const int which = ns >= cur.half ? 1 : 0, nn = ns - which * cur.half; drow = (nn >> 7) * 256 + which * 128 + (nn & 127); }
            *(u32x4*)(cur.dst + (size_t)drow * (cur.K + PADK) + cur.k0 + kq) = *(const LAS u32x4*)(buf + n * TROW + kq * 2); }
        cur = nxt; q = nq; ++it;
    }
    __syncthreads();
}
__device__ __forceinline__ void phase_prep(const Params& p, LAS unsigned char* lds) {
    const int tid = threadIdx.x, wid = tid >> 6, lane = tid & 63;
    prep_run<true>(p, lds, (int)blockIdx.x, (int)gridDim.x, NQ_P0);
    if (gridDim.x != 256) prep_run<false>(p, lds, (int)blockIdx.x, (int)gridDim.x, ND_G1 + ND_G3 + ND_G4);
    const int gtid = blockIdx.x * 512 + tid, gstride = gridDim.x * 512;
    { bf16_t* wg = (bf16_t*)(p.ws + OFF_WG);
      for (int i = gtid; i < DM * 16; i += gstride) { const int k = i >> 4, r = i & 15; wg[r * DM + k] = (bf16_t)(cvt_pk_bf16(p.in[11][(size_t)k * NE_SRC + NE + r], 0.f) & 0xffffu); } }
    { bf16_t* wsm = (bf16_t*)(p.ws + OFF_WSM);
      for (int i = gtid; i < 8 * 128 * 128; i += gstride) { const int jj = i & 127, ii = (i >> 7) & 127; const float w = ((jj >> 6) <= (ii >> 6)) ? p.in[12][i] : 0.f; wsm[i] = (bf16_t)(cvt_pk_bf16(w, 0.f) & 0xffffu); } }
    { bf16_t* h = (bf16_t*)(p.ws + OFF_H); const float* g = p.in[7];
      for (int row = blockIdx.x * 8 + wid; row < T; row += gridDim.x * 8) {
          const float* x = xrow_in(p, row); f32x4 v[8]; float ss = 0.f;
#pragma unroll
          for (int q = 0; q < 4; ++q) { v[2 * q] = *(const f32x4*)(x + q * 512 + lane * 8); v[2 * q + 1] = *(const f32x4*)(x + q * 512 + lane * 8 + 4); }
#pragma unroll
          for (int q = 0; q < 8; ++q) ss += v[q][0] * v[q][0] + v[q][1] * v[q][1] + v[q][2] * v[q][2] + v[q][3] * v[q][3];
          ss = wave_sum(ss); const float rstd = rsqrtf(ss * (1.0f / DM) + EPS);
#pragma unroll
          for (int q = 0; q < 4; ++q) { const f32x4 ga = *(const f32x4*)(g + q * 512 + lane * 8), gb = *(const f32x4*)(g + q * 512 + lane * 8 + 4); const f32x4 a = v[2 * q] * rstd * ga, c = v[2 * q + 1] * rstd * gb;
              *(u32x4*)(h + (size_t)row * HLD + q * 512 + lane * 8) = (u32x4){cvt_pk_bf16(a[0], a[1]), cvt_pk_bf16(a[2], a[3]), cvt_pk_bf16(c[0], c[1]), cvt_pk_bf16(c[2], c[3])}; }
      } }
}

__device__ __forceinline__ void phase_norm(const Params& p, bool x_from_input, float* xout_f32, const float* g_post, const float* g_pre, const bf16_t* slabs, int nslab) {
    const int tid = threadIdx.x, wid = tid >> 6, lane = tid & 63;
    const bf16_t* m = (const bf16_t*)(p.ws + OFF_M); bf16_t* xa = (bf16_t*)(p.ws + OFF_XA); bf16_t* h = (bf16_t*)(p.ws + OFF_H);
    for (int row = blockIdx.x * 8 + wid; row < T; row += gridDim.x * 8) {
        float mv[4][8], xv[4][8]; float ss = 0.f;
        if (x_from_input) { const float* x = xrow_in(p, row);
#pragma unroll
            for (int q = 0; q < 4; ++q) { const f32x4 a = *(const f32x4*)(x + q * 512 + lane * 8), c = *(const f32x4*)(x + q * 512 + lane * 8 + 4);
#pragma unroll
                for (int e = 0; e < 4; ++e) { xv[q][e] = a[e]; xv[q][4 + e] = c[e]; } }
        } else { const bf16_t* x = xa + (size_t)row * DM;
#pragma unroll
            for (int q = 0; q < 4; ++q) { const u32x4 w = *(const u32x4*)(x + q * 512 + lane * 8);
#pragma unroll
                for (int e = 0; e < 4; ++e) { xv[q][2 * e] = bf_lo(w[e]); xv[q][2 * e + 1] = bf_hi(w[e]); } } }
        if (row < TP) { const bf16_t* mr = m + (size_t)row * DM;
#pragma unroll
            for (int q = 0; q < 4; ++q) { const u32x4 w = *(const u32x4*)(mr + q * 512 + lane * 8);
#pragma unroll
                for (int e = 0; e < 4; ++e) { mv[q][2 * e] = bf_lo(w[e]); mv[q][2 * e + 1] = bf_hi(w[e]); } }
        } else { const bf16_t* sr = slabs + (size_t)(row - TP) * DM;
#pragma unroll
            for (int q = 0; q < 4; ++q)
#pragma unroll
                for (int e = 0; e < 8; ++e) mv[q][e] = 0.f;
#pragma unroll 4
            for (int k = 0; k < nslab; ++k) {
#pragma unroll
                for (int q = 0; q < 4; ++q) { const u32x4 w = *(const u32x4*)(sr + (size_t)k * 1024 * DM + q * 512 + lane * 8);
#pragma unroll
                    for (int e = 0; e < 4; ++e) { mv[q][2 * e] += bf_lo(w[e]); mv[q][2 * e + 1] += bf_hi(w[e]); } } } }
#pragma unroll
        for (int q = 0; q < 4; ++q)
#pragma unroll
            for (int e = 0; e < 8; ++e) ss += mv[q][e] * mv[q][e];
        ss = wave_sum(ss); const float rstd = rsqrtf(ss * (1.0f / DM) + EPS); float s2 = 0.f;
#pragma unroll
        for (int q = 0; q < 4; ++q) { const f32x4 ga = *(const f32x4*)(g_post + q * 512 + lane * 8), gb = *(const f32x4*)(g_post + q * 512 + lane * 8 + 4);
#pragma unroll
            for (int e = 0; e < 8; ++e) { xv[q][e] += mv[q][e] * rstd * (e < 4 ? ga[e & 3] : gb[e & 3]); s2 += xv[q][e] * xv[q][e]; }
            if (xout_f32) { float* o = xout_f32 + (size_t)row * DM + q * 512 + lane * 8; *(f32x4*)o = (f32x4){xv[q][0], xv[q][1], xv[q][2], xv[q][3]}; *(f32x4*)(o + 4) = (f32x4){xv[q][4], xv[q][5], xv[q][6], xv[q][7]}; }
            else *(u32x4*)(xa + (size_t)row * DM + q * 512 + lane * 8) = (u32x4){cvt_pk_bf16(xv[q][0], xv[q][1]), cvt_pk_bf16(xv[q][2], xv[q][3]), cvt_pk_bf16(xv[q][4], xv[q][5]), cvt_pk_bf16(xv[q][6], xv[q][7])}; }
        if (g_pre) { s2 = wave_sum(s2); const float r2 = rsqrtf(s2 * (1.0f / DM) + EPS);
#pragma unroll
            for (int q = 0; q < 4; ++q) { const f32x4 ga = *(const f32x4*)(g_pre + q * 512 + lane * 8), gb = *(const f32x4*)(g_pre + q * 512 + lane * 8 + 4); float o[8];
#pragma unroll
                for (int e = 0; e < 8; ++e) o[e] = xv[q][e] * r2 * (e < 4 ? ga[e & 3] : gb[e & 3]);
                *(u32x4*)(h + (size_t)row * HLD + q * 512 + lane * 8) = (u32x4){cvt_pk_bf16(o[0], o[1]), cvt_pk_bf16(o[2], o[3]), cvt_pk_bf16(o[4], o[5]), cvt_pk_bf16(o[6], o[7])}; } }
    }
}

__device__ __forceinline__ void phase_glr(const Params& p, int vb) {
    const int tid = threadIdx.x, wid = tid >> 6, lane = tid & 63, fr = lane & 15, fq = lane >> 4;
    const bf16_t* h = (const bf16_t*)(p.ws + OFF_H); const bf16_t* wg = (const bf16_t*)(p.ws + OFF_WG); float* glr = (float*)(p.ws + OFF_GLR);
    for (int grp = ((int)gridDim.x - 1 - vb) * 8 + wid; grp < T / 16; grp += (int)gridDim.x * 8) {
        f32x4 acc = (f32x4){0.f, 0.f, 0.f, 0.f};
        const bf16_t* ap = h + (size_t)(grp * 16 + fr) * HLD + fq * 8; const bf16_t* bp = wg + (size_t)fr * DM + fq * 8;
#pragma unroll 8
        for (int ks = 0; ks < DM / 32; ++ks) { const bf16x8 a = *(const bf16x8*)(ap + ks * 32), b = *(const bf16x8*)(bp + ks * 32); acc = __builtin_amdgcn_mfma_f32_16x16x32_bf16(a, b, acc, 0, 0, 0); }
#pragma unroll
        for (int j = 0; j < 4; ++j) glr[(size_t)(grp * 16 + fq * 4 + j) * 16 + fr] = acc[j];
    }
}

template <int L>
__device__ __forceinline__ void amix_item(const Params& p, LAS unsigned char* lds, int item) {
    const int tid = threadIdx.x, wid = tid >> 6, lane = tid & 63;
    const bf16_t* proj = (const bf16_t*)(p.ws + OFF_PROJ); bf16_t* mix = (bf16_t*)(p.ws + OFF_MIX); const bf16_t* wsm = (const bf16_t*)(p.ws + OFF_WSM);
    const int tb = item >> 2, hp = item & 3; constexpr bool smp = (L == 32); const int row0 = smp ? TP + (tb - 64) * 32 : tb * 128;
    constexpr int VROW = 272;
    LAS float* stats = (LAS float*)(lds + 256 * VROW);
    for (int l0 = wid * 4; l0 < L; l0 += 32) {
        u32x4 a[4], b[4];
#pragma unroll
        for (int r4 = 0; r4 < 4; ++r4) { const bf16_t* r = proj + (size_t)(row0 + l0 + r4) * NE + 1024; a[r4] = *(const u32x4*)(r + lane * 8); b[r4] = *(const u32x4*)(r + 512 + lane * 8); }
#pragma unroll
        for (int r4 = 0; r4 < 4; ++r4) { float s = 0.f, q = 0.f;
#pragma unroll
            for (int e = 0; e < 4; ++e) { const float a0 = bf_lo(a[r4][e]), a1 = bf_hi(a[r4][e]), b0 = bf_lo(b[r4][e]), b1 = bf_hi(b[r4][e]); s += (a0 + a1) + (b0 + b1); q += (a0 * a0 + a1 * a1) + (b0 * b0 + b1 * b1); }
            s = wave_sum(s); q = wave_sum(q); const float mean = s * (1.0f / 1024.f), var = fmaxf(q * (1.0f / 1024.f) - mean * mean, 0.f);
            if (lane == 0) { stats[(l0 + r4) * 2] = mean; stats[(l0 + r4) * 2 + 1] = rsqrtf(var + EPS); } }
    }
    __syncthreads();
    const int c0 = hp * 256; const float* gain = p.in[14];
    for (int wi0 = tid; wi0 < L * 32; wi0 += 2048) {
        u32x4 av4[4];
#pragma unroll
        for (int u4 = 0; u4 < 4; ++u4) { const int wi = wi0 + u4 * 512; if (wi < L * 32) { const int j = wi % L, cg8 = wi / L; av4[u4] = *(const u32x4*)(proj + (size_t)(row0 + j) * NE + 1024 + c0 + cg8 * 8); } }
#pragma unroll
        for (int u4 = 0; u4 < 4; ++u4) { const int wi = wi0 + u4 * 512; if (wi < L * 32) { const int j = wi % L, cg8 = wi / L;
            const u32x4 a = av4[u4]; const float mean = stats[j * 2], rstd = stats[j * 2 + 1];
            const f32x4 g0 = *(const f32x4*)(gain + c0 + cg8 * 8), g1 = *(const f32x4*)(gain + c0 + cg8 * 8 + 4); float o[8];
#pragma unroll
            for (int e = 0; e < 4; ++e) { o[2 * e] = (bf_lo(a[e]) - mean) * rstd * (e < 2 ? g0[2 * e] : g1[2 * e - 4]); o[2 * e + 1] = (bf_hi(a[e]) - mean) * rstd * (e < 2 ? g0[2 * e + 1] : g1[2 * e - 3]); }
#pragma unroll
            for (int e = 0; e < 8; ++e) *(LAS bf16_t*)(lds + (cg8 * 8 + e) * VROW + j * 2) = (bf16_t)(cvt_pk_bf16(o[e], 0.f) & 0xffffu);
            if (smp) { float* av = p.out + O_AV + (size_t)(row0 - TP + j) * 1024 + c0 + cg8 * 8; *(f32x4*)av = (f32x4){o[0], o[1], o[2], o[3]}; *(f32x4*)(av + 4) = (f32x4){o[4], o[5], o[6], o[7]}; } } }
    }
    __syncthreads();
    const int hh = wid >> 2, dq = wid & 3, head = hp * 2 + hh, l31 = lane & 31, lh = lane >> 5;
    constexpr int nit = L >> 5, nks = L >> 4;
    f32x16 acc[4];
#pragma unroll
    for (int i = 0; i < 4; ++i)
#pragma unroll
        for (int r = 0; r < 16; ++r) acc[i][r] = 0.f;
    const LAS unsigned char* ap = lds + (hh * 128 + dq * 32 + l31) * VROW + lh * 16;
    const bf16_t* bp = wsm + (size_t)head * 16384 + (size_t)l31 * 128 + lh * 8;
    bf16x8 bq[4], bn[4];
#pragma unroll
    for (int i = 0; i < 4; ++i) { bq[i] = (bf16x8){0, 0, 0, 0, 0, 0, 0, 0}; if (i < nit) bq[i] = *(const bf16x8*)(bp + (size_t)i * 32 * 128); }
#pragma unroll
    for (int ks = 0; ks < nks; ++ks) {
        const bf16x8 a = *(const LAS bf16x8*)(ap + ks * 32);
#pragma unroll
        for (int i = 0; i < 4; ++i) { bn[i] = bq[i]; if (i < nit && ks + 1 < nks) bn[i] = *(const bf16x8*)(bp + (size_t)i * 32 * 128 + (ks + 1) * 16); }
#pragma unroll
        for (int i = 0; i < 4; ++i) if (i < nit) acc[i] = __builtin_amdgcn_mfma_f32_32x32x16_bf16(a, bq[i], acc[i], 0, 0, 0);
#pragma unroll
        for (int i = 0; i < 4; ++i) bq[i] = bn[i];
    }
    const float* bs = p.in[13] + head * 128;
#pragma unroll
    for (int i = 0; i < 4; ++i) if (i < nit) { const int ii = i * 32 + l31, row = row0 + ii; const float bias = bs[ii];
#pragma unroll
        for (int rg = 0; rg < 4; ++rg) { const int d = dq * 32 + rg * 8 + lh * 4, c = head * 128 + d; const u32x2 uu = *(const u32x2*)(proj + (size_t)row * NE + c);
            u32x2 w; w.x = cvt_pk_bf16(bf_lo(uu.x) * (acc[i][rg * 4] + bias), bf_hi(uu.x) * (acc[i][rg * 4 + 1] + bias)); w.y = cvt_pk_bf16(bf_lo(uu.y) * (acc[i][rg * 4 + 2] + bias), bf_hi(uu.y) * (acc[i][rg * 4 + 3] + bias));
            *(u32x2*)(mix + (size_t)row * HLD + c) = w; } }
    __syncthreads();
}

__device__ __forceinline__ void gla_item_decode(int it, int& s, int& h, int& row0, int& L) {
    if (it < 512) { s = it >> 8; h = (it >> 6) & 3; row0 = s * 4096 + (it & 63) * 64; L = 64; } else { const int q = it - 512; s = q >> 2; h = q & 3; row0 = TP + s * 32; L = 32; }
}
template <int L>
__device__ __forceinline__ void glau_item(const Params& p, LAS unsigned char* lds, int it) {
    const int tid = threadIdx.x, wid = tid >> 6, lane = tid & 63;
    const bf16_t* proj = (const bf16_t*)(p.ws + OFF_PROJ); const float* glr = (const float*)(p.ws + OFF_GLR);
    int s, h, row0, Lrt; gla_item_decode(it, s, h, row0, Lrt); constexpr bool smp = (L == 32);
    constexpr int KROW = 144;
    LAS unsigned char* kdT = lds;
    LAS unsigned char* vT = lds + 128 * KROW;
    LAS float* glt = (LAS float*)(lds + 384 * KROW);
    LAS float* part = glt + 64 * 16;
    LAS float* totl = part + 4 * 128;
    if (tid < L * 4) *(LAS f32x4*)(glt + tid * 4) = *(const f32x4*)(glr + (size_t)row0 * 16 + tid * 4);
    __syncthreads();
    const int d = tid & 127, lq = tid >> 7; constexpr int Lq = L >> 2;
    float wg[16];
#pragma unroll
    for (int r = 0; r < 16; ++r) wg[r] = p.in[15][r * 512 + h * 128 + d];
    const float gb = p.in[16][h * 128 + d];
    float cum[16]; float run = 0.f;
#pragma unroll
    for (int i = 0; i < 16; ++i) { cum[i] = 0.f; if (i < Lq) { const int l = lq * Lq + i; float x = gb;
#pragma unroll
            for (int r4 = 0; r4 < 4; ++r4) { const f32x4 gg = *(const LAS f32x4*)(glt + l * 16 + r4 * 4); x += gg[0] * wg[r4 * 4] + gg[1] * wg[r4 * 4 + 1] + gg[2] * wg[r4 * 4 + 2] + gg[3] * wg[r4 * 4 + 3]; }
            const float ls = fminf(x, 0.f) - __logf(1.0f + __expf(-fabsf(x)));
            run += ls * (1.0f / 16.0f); cum[i] = run; } }
    part[lq * 128 + d] = run;
    __syncthreads();
    float offs = 0.f, tot = 0.f;
#pragma unroll
    for (int q = 0; q < 4; ++q) { const float pv = part[q * 128 + d]; tot += pv; if (q < lq) offs += pv; }
    if (lq == 0) { totl[d] = tot; ((float*)(p.ws + OFF_DECAY))[(size_t)it * 128 + d] = __expf(tot); }
    { unsigned pk[8];
#pragma unroll
      for (int i = 0; i < 16; i += 2) { float v0 = 0.f, v1 = 0.f;
          if (i < Lq) { const int l = lq * Lq + i; v0 = bf1(proj[(size_t)(row0 + l) * NE + 2560 + h * 128 + d]) * __expf(tot - offs - cum[i]); v1 = bf1(proj[(size_t)(row0 + l + 1) * NE + 2560 + h * 128 + d]) * __expf(tot - offs - cum[i + 1]); }
          pk[i >> 1] = cvt_pk_bf16(v0, v1); }
      LAS unsigned char* dstp = kdT + d * KROW + lq * Lq * 2;
      *(LAS u32x4*)dstp = (u32x4){pk[0], pk[1], pk[2], pk[3]};
      if (Lq == 16) *(LAS u32x4*)(dstp + 16) = (u32x4){pk[4], pk[5], pk[6], pk[7]}; }
    { const int v = tid & 255, hf = tid >> 8; constexpr int Lh = L >> 1; unsigned pk[16];
#pragma unroll
      for (int i = 0; i < 32; i += 2) { unsigned a = 0, b = 0; if (i < Lh) { const int l = hf * Lh + i; a = proj[(size_t)(row0 + l) * NE + 3072 + h * 256 + v]; b = proj[(size_t)(row0 + l + 1) * NE + 3072 + h * 256 + v]; } pk[i >> 1] = a | (b << 16); }
      LAS unsigned char* dstp = vT + v * KROW + hf * Lh * 2;
      *(LAS u32x4*)dstp = (u32x4){pk[0], pk[1], pk[2], pk[3]}; *(LAS u32x4*)(dstp + 16) = (u32x4){pk[4], pk[5], pk[6], pk[7]};
      if (Lh == 32) { *(LAS u32x4*)(dstp + 32) = (u32x4){pk[8], pk[9], pk[10], pk[11]}; *(LAS u32x4*)(dstp + 48) = (u32x4){pk[12], pk[13], pk[14], pk[15]}; } }
    __syncthreads();
    const int l31 = lane & 31, lh = lane >> 5, vs = wid * 32; constexpr int nks = L >> 4;
    f32x16 acc[4];
#pragma unroll
    for (int i = 0; i < 4; ++i)
#pragma unroll
        for (int r = 0; r < 16; ++r) acc[i][r] = 0.f;
#pragma unroll
    for (int ks = 0; ks < nks; ++ks) { const bf16x8 b = *(const LAS bf16x8*)(vT + (vs + l31) * KROW + ks * 32 + lh * 16);
#pragma unroll
        for (int dt = 0; dt < 4; ++dt) { const bf16x8 a = *(const LAS bf16x8*)(kdT + (dt * 32 + l31) * KROW + ks * 32 + lh * 16); acc[dt] = __builtin_amdgcn_mfma_f32_32x32x16_bf16(a, b, acc[dt], 0, 0, 0); } }
    const int v = vs + l31;
    if (!smp) { float* ut = (float*)(p.ws + OFF_UT) + ((size_t)it * 256 + v) * 128;
#pragma unroll
        for (int dt = 0; dt < 4; ++dt)
#pragma unroll
            for (int rg = 0; rg < 4; ++rg) *(f32x4*)(ut + dt * 32 + rg * 8 + lh * 4) = (f32x4){acc[dt][rg * 4], acc[dt][rg * 4 + 1], acc[dt][rg * 4 + 2], acc[dt][rg * 4 + 3]};
    } else { const float* s0 = p.in[2] + ((size_t)s * 4 + h) * 128 * 256; float* so = p.out + O_GLA_S + ((size_t)s * 4 + h) * 128 * 256; bf16_t* st = (bf16_t*)(p.ws + OFF_ST) + ((size_t)it * 256 + v) * 128;
#pragma unroll
        for (int dt = 0; dt < 4; ++dt)
#pragma unroll
            for (int rg = 0; rg < 4; ++rg) { const int dd = dt * 32 + rg * 8 + lh * 4; float sv[4];
#pragma unroll
                for (int e = 0; e < 4; ++e) { sv[e] = __expf(totl[dd + e]) * s0[(size_t)(dd + e) * 256 + v] + acc[dt][rg * 4 + e]; so[(size_t)(dd + e) * 256 + v] = sv[e]; }
                u32x2 w; w.x = cvt_pk_bf16(sv[0], sv[1]); w.y = cvt_pk_bf16(sv[2], sv[3]); *(u32x2*)(st + dd) = w; } }
    __syncthreads();
}

__device__ __forceinline__ void phase_gla_scan(const Params& p) {
    for (int gtid = blockIdx.x * 512 + threadIdx.x; gtid < 2 * 4 * 256 * 64; gtid += gridDim.x * 512) {
    const int dq = gtid & 63, v = (gtid >> 6) & 255, sh = gtid >> 14;
    const float* ut = (const float*)(p.ws + OFF_UT); const float* dec = (const float*)(p.ws + OFF_DECAY); bf16_t* st = (bf16_t*)(p.ws + OFF_ST);
    f32x2 S = (f32x2){0.f, 0.f};
#pragma unroll 16
    for (int c = 0; c < 64; ++c) { const int it = sh * 64 + c; const f32x2 u = *(const f32x2*)(ut + ((size_t)it * 256 + v) * 128 + dq * 2), dc = *(const f32x2*)(dec + (size_t)it * 128 + dq * 2);
        S = S * dc + u; *(unsigned*)(st + ((size_t)it * 256 + v) * 128 + dq * 2) = cvt_pk_bf16(S[0], S[1]); }
    float* o = p.out + O_GLA_P + (size_t)sh * 128 * 256;
    o[(size_t)(dq * 2) * 256 + v] = S[0]; o[(size_t)(dq * 2 + 1) * 256 + v] = S[1];
    }
}

template <int L>
__device__ __forceinline__ void glao_item(const Params& p, LAS unsigned char* lds, int it) {
    const int tid = threadIdx.x, wid = tid >> 6, lane = tid & 63, l31 = lane & 31, lh = lane >> 5;
    const bf16_t* proj = (const bf16_t*)(p.ws + OFF_PROJ); bf16_t* mix = (bf16_t*)(p.ws + OFF_MIX);
    int s, h, row0, Lrt; gla_item_decode(it, s, h, row0, Lrt);
    constexpr int nlt = L >> 5; const int vs = wid * 32;
    LAS float* red = (LAS float*)lds;
    const bf16_t* ap = (const bf16_t*)(p.ws + OFF_ST) + ((size_t)it * 256 + vs + l31) * 128 + lh * 8;
    const bf16_t* bp = proj + (size_t)(row0 + l31) * NE + 2048 + h * 128 + lh * 8;
    f32x16 acc[2];
#pragma unroll
    for (int i = 0; i < 2; ++i)
#pragma unroll
        for (int r = 0; r < 16; ++r) acc[i][r] = 0.f;
#pragma unroll
    for (int ks = 0; ks < 8; ++ks) { const bf16x8 a = *(const bf16x8*)(ap + ks * 16);
#pragma unroll
        for (int lt = 0; lt < 2; ++lt) if (lt < nlt) { const bf16x8 b = *(const bf16x8*)(bp + (size_t)lt * 32 * NE + ks * 16); acc[lt] = __builtin_amdgcn_mfma_f32_32x32x16_bf16(a, b, acc[lt], 0, 0, 0); } }
    const float qs = 0.08838834764831845f;
#pragma unroll
    for (int lt = 0; lt < 2; ++lt) { float ss = 0.f;
#pragma unroll
        for (int r = 0; r < 16; ++r) { acc[lt][r] *= qs; ss += acc[lt][r] * acc[lt][r]; }
        ss += __shfl_xor(ss, 32);
        if (lh == 0) red[wid * 64 + lt * 32 + l31] = ss; }
    __syncthreads();
    const float* og = p.in[17] + h * 256;
#pragma unroll
    for (int lt = 0; lt < 2; ++lt) if (lt < nlt) { float tot = 0.f;
#pragma unroll
        for (int w = 0; w < 8; ++w) tot += red[w * 64 + lt * 32 + l31];
        const float rstd = rsqrtf(tot * (1.0f / 256.f) + EPS); const int row = row0 + lt * 32 + l31;
#pragma unroll
        for (int rg = 0; rg < 4; ++rg) { const int vv = vs + rg * 8 + lh * 4; const u32x2 rr = *(const u32x2*)(proj + (size_t)row * NE + 4096 + h * 256 + vv); const f32x4 gg = *(const f32x4*)(og + vv);
            const float r0 = bf_lo(rr.x), r1 = bf_hi(rr.x), r2 = bf_lo(rr.y), r3 = bf_hi(rr.y);
            u32x2 w; w.x = cvt_pk_bf16(acc[lt][rg * 4] * rstd * gg[0] * r0 * sigmoidf(r0), acc[lt][rg * 4 + 1] * rstd * gg[1] * r1 * sigmoidf(r1));
            w.y = cvt_pk_bf16(acc[lt][rg * 4 + 2] * rstd * gg[2] * r2 * sigmoidf(r2), acc[lt][rg * 4 + 3] * rstd * gg[3] * r3 * sigmoidf(r3));
            *(u32x2*)(mix + (size_t)row * HLD + 1024 + h * 256 + vv) = w; } }
    __syncthreads();
}

__device__ __forceinline__ void phase_convfix(const Params& p, int layer) {
    bf16_t* ACT = (bf16_t*)(p.ws + OFF_VAL); const bf16_t* GF = (const bf16_t*)(p.ws + OFF_GF); const bf16_t* VF = (const bf16_t*)(p.ws + OFF_VF); const bf16_t* GL = (const bf16_t*)(p.ws + OFF_GL);
    const float* cw = p.in[33] + (size_t)layer * 3 * DFF; const float* cb = p.in[34] + (size_t)layer * DFF; const float* st = p.in[6] + (size_t)layer * 32 * 2 * DFF;
    for (int idx = blockIdx.x * 512 + threadIdx.x; idx < 160 * 704; idx += gridDim.x * 512) {
        const int pr = idx / 704, c = (idx - pr * 704) * 8;
        const int ra = pr < 128 ? pr * 64 : TP + (pr - 128) * 32, hb = ra >> 5;
        float w0[8], w1[8], w2[8], bb[8], h0[8], h1[8], ga[8], gb[8], va[8], vb[8];
#pragma unroll
        for (int e = 0; e < 8; e += 4) { const f32x4 a = *(const f32x4*)(cw + c + e), b = *(const f32x4*)(cw + DFF + c + e), d = *(const f32x4*)(cw + 2 * DFF + c + e), f = *(const f32x4*)(cb + c + e);
#pragma unroll
            for (int j = 0; j < 4; ++j) { w0[e + j] = a[j]; w1[e + j] = b[j]; w2[e + j] = d[j]; bb[e + j] = f[j]; } }
        if (ra >= TP) { const float* sp = st + (size_t)(pr - 128) * 2 * DFF + c;
#pragma unroll
            for (int e = 0; e < 8; e += 4) { const f32x4 a = *(const f32x4*)(sp + e), b = *(const f32x4*)(sp + DFF + e);
#pragma unroll
                for (int j = 0; j < 4; ++j) { h0[e + j] = a[j]; h1[e + j] = b[j]; } } }
        else if ((ra & 4095) == 0) {
#pragma unroll
            for (int e = 0; e < 8; ++e) { h0[e] = 0.f; h1[e] = 0.f; } }
        else { const u32x4 a = *(const u32x4*)(GL + ((size_t)((ra >> 6) - 1) * 2) * DFF + c), b = *(const u32x4*)(GL + ((size_t)((ra >> 6) - 1) * 2 + 1) * DFF + c);
#pragma unroll
            for (int e = 0; e < 4; ++e) { h0[2 * e] = bf_lo(a[e]); h0[2 * e + 1] = bf_hi(a[e]); h1[2 * e] = bf_lo(b[e]); h1[2 * e + 1] = bf_hi(b[e]); } }
        { const u32x4 a = *(const u32x4*)(GF + ((size_t)hb * 2) * DFF + c), b = *(const u32x4*)(GF + ((size_t)hb * 2 + 1) * DFF + c), d = *(const u32x4*)(VF + ((size_t)hb * 2) * DFF + c), f = *(const u32x4*)(VF + ((size_t)hb * 2 + 1) * DFF + c);
#pragma unroll
          for (int e = 0; e < 4; ++e) { ga[2 * e] = bf_lo(a[e]); ga[2 * e + 1] = bf_hi(a[e]); gb[2 * e] = bf_lo(b[e]); gb[2 * e + 1] = bf_hi(b[e]); va[2 * e] = bf_lo(d[e]); va[2 * e + 1] = bf_hi(d[e]); vb[2 * e] = bf_lo(f[e]); vb[2 * e + 1] = bf_hi(f[e]); } }
        float oa[8], ob[8];
#pragma unroll
        for (int e = 0; e < 8; ++e) { oa[e] = gelu_t(bb[e] + w0[e] * h0[e] + w1[e] * h1[e] + w2[e] * ga[e]) * va[e]; ob[e] = gelu_t(bb[e] + w0[e] * h1[e] + w1[e] * ga[e] + w2[e] * gb[e]) * vb[e]; }
        *(u32x4*)(ACT + (size_t)ra * ALD + c) = (u32x4){cvt_pk_bf16(oa[0], oa[1]), cvt_pk_bf16(oa[2], oa[3]), cvt_pk_bf16(oa[4], oa[5]), cvt_pk_bf16(oa[6], oa[7])};
        *(u32x4*)(ACT + (size_t)(ra + 1) * ALD + c) = (u32x4){cvt_pk_bf16(ob[0], ob[1]), cvt_pk_bf16(ob[2], ob[3]), cvt_pk_bf16(ob[4], ob[5]), cvt_pk_bf16(ob[6], ob[7])};
    }
}

template <int W>
__device__ __forceinline__ void pool_item(const Params& p, const float* proj2, bf16_t* delta, int r8, int c) {
    const int row0 = r8 * 8; const bool smp = row0 >= TP;
    const int seq = smp ? (row0 - TP) >> 5 : row0 >> 12, t0 = smp ? (row0 - TP) & 31 : row0 & 4095, rowbase = row0 - t0;
    const float* spool = p.in[3] + (size_t)seq * 15 * 1024 + c;
    f32x4 xs[W + 7];
#pragma unroll
    for (int j = 0; j < W + 7; ++j) { const int t = t0 - (W - 1) + j; const bool hist = smp && t < 0; const bool ok = t >= 0 || hist;
        const float* ptr = hist ? spool + (size_t)(15 + t) * 1024 : proj2 + (size_t)(rowbase + (t >= 0 ? t : 0)) * DM + c;
        const f32x4 v = *(const f32x4*)ptr; xs[j] = ok ? v : (f32x4){0.f, 0.f, 0.f, 0.f}; }
    f32x4 Wd = xs[0];
#pragma unroll
    for (int j = 1; j < W; ++j) Wd = Wd + xs[j];
#pragma unroll
    for (int u = 0; u < 8; ++u) { const int t = t0 + u; const f32x4 x = xs[u + W - 1];
        const float cnt = smp ? (float)W : (float)((t + 1) < W ? (t + 1) : W); const f32x4 dl = Wd * (1.0f / cnt) - x;
        u32x2 o; o.x = cvt_pk_bf16(dl[0], dl[1]); o.y = cvt_pk_bf16(dl[2], dl[3]); *(u32x2*)(delta + (size_t)(row0 + u) * YLD + c) = o;
        if (!smp && t >= 4081) *(f32x4*)(p.out + O_POOL_P + ((size_t)seq * 15 + (t - 4081)) * 1024 + c) = x;
        if (smp && t >= 17) *(f32x4*)(p.out + O_POOL_S + ((size_t)seq * 15 + (t - 17)) * 1024 + c) = x;
        if (u < 7) Wd = Wd + xs[u + W] - xs[u]; }
}
__device__ __forceinline__ void phase_pool(const Params& p) {
    const float* proj2 = (const float*)(p.ws + OFF_PROJ2); bf16_t* delta = (bf16_t*)(p.ws + OFF_DELTA);
    for (int idx = blockIdx.x * 512 + threadIdx.x; idx < (T / 8) * 256; idx += gridDim.x * 512) {
        const int r8 = idx >> 8, c = (idx & 255) * 4, g = c >> 8;
        if (g == 0) pool_item<2>(p, proj2, delta, r8, c); else if (g == 1) pool_item<4>(p, proj2, delta, r8, c);
        else if (g == 2) pool_item<8>(p, proj2, delta, r8, c); else pool_item<16>(p, proj2, delta, r8, c);
    }
}

template <int PASS>
__device__ __forceinline__ void phase_s5(const Params& p, LAS unsigned char* lds, int nitems) {
    const int tid = threadIdx.x, wid = tid >> 6, lane = tid & 63, hcol = lane & 15, q4 = lane >> 4;
    const float* proj2 = (const float*)(p.ws + OFF_PROJ2); float* Eb = (float*)(p.ws + OFF_E); bf16_t* yb = (bf16_t*)(p.ws + OFF_YB);
    LAS float* ut = (LAS float*)lds;
    constexpr int SROW = 272;
    LAS unsigned char* sb = lds + 32768 + wid * 32 * SROW;
    int oct_cur = -1;
    float lbr = 0.f, lbi = 0.f, p64r = 0.f, p64i = 0.f, dsk = 0.f; f32x2 bb[16]; bf16x8 Bc[4];
#pragma unroll
    for (int i = 0; i < 16; ++i) bb[i] = (f32x2){0.f, 0.f};
#pragma unroll
    for (int i = 0; i < 4; ++i) Bc[i] = (bf16x8){0, 0, 0, 0, 0, 0, 0, 0};
    f32x4 un[4];
    auto issue_u = [&](int item) {
        const int cs = item >> 3, oct = item & 7; const bool smp = cs >= 128;
        const int b = smp ? cs - 128 : cs >> 6, ch = smp ? 0 : cs & 63, L = smp ? 32 : 64, row0 = smp ? TP + b * 32 : b * 4096 + ch * 64;
#pragma unroll
        for (int k = 0; k < 4; ++k) { const int i = tid + k * 512; un[k] = (f32x4){0.f, 0.f, 0.f, 0.f}; if (i < L * 32) un[k] = *(const f32x4*)(proj2 + (size_t)(row0 + (i >> 5)) * DM + 1024 + oct * 128 + (i & 31) * 4); }
    };
    if ((int)blockIdx.x < nitems) issue_u((int)blockIdx.x);
    for (int item = blockIdx.x; item < nitems; item += gridDim.x) {
        const int cs = item >> 3, oct = item & 7, g = oct * 8 + wid; const bool smp = cs >= 128;
        const int b = smp ? cs - 128 : cs >> 6, ch = smp ? 0 : cs & 63, L = smp ? 32 : 64, row0 = smp ? TP + b * 32 : b * 4096 + ch * 64;
#pragma unroll
        for (int k = 0; k < 4; ++k) { const int i = tid + k * 512; if (i < L * 32) *(LAS f32x4*)(ut + (i >> 5) * 128 + (i & 31) * 4) = un[k]; }
        if (item + (int)gridDim.x < nitems) issue_u(item + (int)gridDim.x);
        if (oct != oct_cur) {
            oct_cur = oct;
            const float are = p.in[22][g * 64 + lane], aim = p.in[23][g * 64 + lane], dt = __expf(p.in[24][g]);
            const float er = __expf(are * dt); float rev = aim * dt * 0.15915494309189535f; rev -= floorf(rev);
            lbr = er * __builtin_amdgcn_cosf(rev); lbi = er * __builtin_amdgcn_sinf(rev);
            const float den = 1.0f / (are * are + aim * aim); const float nr = lbr - 1.0f, ni = lbi;
            const float cr = (nr * are + ni * aim) * den, ci = (ni * are - nr * aim) * den;
            const float* br = p.in[25] + ((size_t)g * 64 + lane) * 16; const float* bi = p.in[26] + ((size_t)g * 64 + lane) * 16;
#pragma unroll
            for (int q = 0; q < 4; ++q) { const f32x4 x = *(const f32x4*)(br + q * 4), y = *(const f32x4*)(bi + q * 4);
#pragma unroll
                for (int e = 0; e < 4; ++e) bb[q * 4 + e] = (f32x2){cr * x[e] - ci * y[e], cr * y[e] + ci * x[e]}; }
            if (PASS == 2) {
                p64r = lbr; p64i = lbi;
#pragma unroll
                for (int q = 0; q < 6; ++q) { const float t = p64r * p64r - p64i * p64i; p64i = 2.f * p64r * p64i; p64r = t; }
#pragma unroll
                for (int ks = 0; ks < 4; ++ks) { const float* src = (ks < 2 ? p.in[27] : p.in[28]) + ((size_t)g * 16 + hcol) * 64 + (ks & 1) * 32 + q4 * 8; const float sg = ks < 2 ? 1.f : -1.f;
                    const f32x4 x = *(const f32x4*)src, y = *(const f32x4*)(src + 4); u32x4 w; w.x = cvt_pk_bf16(sg * x[0], sg * x[1]); w.y = cvt_pk_bf16(sg * x[2], sg * x[3]); w.z = cvt_pk_bf16(sg * y[0], sg * y[1]); w.w = cvt_pk_bf16(sg * y[2], sg * y[3]);
                    Bc[ks] = __builtin_bit_cast(bf16x8, w); }
                dsk = p.in[29][g * 16 + hcol]; }
        }
        float sr = 0.f, si = 0.f;
        if (PASS == 2) {
            if (smp) { sr = p.in[4][((size_t)b * 64 + g) * 64 + lane]; si = p.in[5][((size_t)b * 64 + g) * 64 + lane]; }
            else { const float* e0 = Eb + (((size_t)b * 64) * 64 + g) * 128 + lane * 2;
                for (int j0 = 0; j0 < ch; j0 += 16) { f32x2 ev[16];
#pragma unroll
                    for (int jj = 0; jj < 16; ++jj) { const int j = (j0 + jj) < ch ? (j0 + jj) : (ch - 1); ev[jj] = *(const f32x2*)(e0 + (size_t)j * 64 * 128); }
#pragma unroll
                    for (int jj = 0; jj < 16; ++jj) { const bool on = (j0 + jj) < ch; const float t = p64r * sr - p64i * si + ev[jj].x, u2 = p64r * si + p64i * sr + ev[jj].y; sr = on ? t : sr; si = on ? u2 : si; } } }
        }
        __syncthreads();
        for (int sub = 0; sub < L; sub += 32) {
#pragma unroll 2
            for (int tt = 0; tt < 32; ++tt) { const int t = sub + tt; f32x2 bu0 = (f32x2){0.f, 0.f}, bu1 = (f32x2){0.f, 0.f};
#pragma unroll
                for (int q = 0; q < 4; ++q) { const f32x4 u = *(const LAS f32x4*)(ut + t * 128 + wid * 16 + q * 4);
                    bu0 = bu0 + bb[q * 4] * u[0]; bu1 = bu1 + bb[q * 4 + 1] * u[1]; bu0 = bu0 + bb[q * 4 + 2] * u[2]; bu1 = bu1 + bb[q * 4 + 3] * u[3]; }
                const float bur = bu0[0] + bu1[0], bui = bu0[1] + bu1[1];
                const float nr2 = lbr * sr - lbi * si + bur; si = lbr * si + lbi * sr + bui; sr = nr2;
                if (PASS == 2) { *(LAS bf16_t*)(sb + tt * SROW + lane * 2) = (bf16_t)(cvt_pk_bf16(sr, 0.f) & 0xffffu); *(LAS bf16_t*)(sb + tt * SROW + 128 + lane * 2) = (bf16_t)(cvt_pk_bf16(si, 0.f) & 0xffffu); } }
            if (PASS == 2) {
                __syncthreads();
#pragma unroll
                for (int mt = 0; mt < 2; ++mt) { f32x4 acc = (f32x4){0.f, 0.f, 0.f, 0.f};
#pragma unroll
                    for (int ks = 0; ks < 4; ++ks) { const bf16x8 a = *(const LAS bf16x8*)(sb + (mt * 16 + hcol) * SROW + ks * 64 + q4 * 16); acc = __builtin_amdgcn_mfma_f32_16x16x32_bf16(a, Bc[ks], acc, 0, 0, 0); }
#pragma unroll
                    for (int j = 0; j < 4; ++j) { const int t = sub + mt * 16 + q4 * 4 + j; const float y = acc[j] + dsk * ut[t * 128 + wid * 16 + hcol];
                        yb[(size_t)(row0 + t) * YLD + g * 16 + hcol] = (bf16_t)(cvt_pk_bf16(gelu_t(y), 0.f) & 0xffffu); } }
                __syncthreads();
            }
        }
        if (PASS == 1) { *(f32x2*)(Eb + ((((size_t)b * 64 + ch) * 64) + g) * 128 + lane * 2) = (f32x2){sr, si}; }
        else { if (smp) { p.out[O_S5RE_S + ((size_t)b * 64 + g) * 64 + lane] = sr; p.out[O_S5IM_S + ((size_t)b * 64 + g) * 64 + lane] = si; }
               else if (ch == 63) { p.out[O_S5RE_P + ((size_t)b * 64 + g) * 64 + lane] = sr; p.out[O_S5IM_P + ((size_t)b * 64 + g) * 64 + lane] = si; } }
        __syncthreads();
    }
}


__device__ __forceinline__ void phase_s5_ends(const Params& p, LAS unsigned char* lds, int nitems) {
    const int tid = threadIdx.x, wid = tid >> 6, lane = tid & 63, l31 = lane & 31, hh = lane >> 5;
    const float* proj2 = (const float*)(p.ws + OFF_PROJ2); float* Eb = (float*)(p.ws + OFF_E);
    constexpr int UROW = 272;
    int oct_cur = -1;
    float lr[2] = {0.f, 0.f}, li[2] = {0.f, 0.f}, l4r[2] = {0.f, 0.f}, l4i[2] = {0.f, 0.f}; bf16x8 Bre[2], Bim[2];
#pragma unroll
    for (int i = 0; i < 2; ++i) { Bre[i] = (bf16x8){0, 0, 0, 0, 0, 0, 0, 0}; Bim[i] = Bre[i]; }
    for (int item = blockIdx.x; item < nitems; item += gridDim.x) {
        const int cs = item >> 3, oct = item & 7, g = oct * 8 + wid, b = cs >> 6, ch = cs & 63, row0 = b * 4096 + ch * 64;
#pragma unroll
        for (int k = 0; k < 4; ++k) { const int i = tid + k * 512, t = i >> 5, q = i & 31; const f32x4 v = *(const f32x4*)(proj2 + (size_t)(row0 + t) * DM + 1024 + oct * 128 + q * 4);
            u32x2 w; w.x = cvt_pk_bf16(v[0], v[1]); w.y = cvt_pk_bf16(v[2], v[3]); *(LAS u32x2*)(lds + t * UROW + q * 8) = w; }
        if (oct != oct_cur) { oct_cur = oct;
            const float dt = __expf(p.in[24][g]);
#pragma unroll
            for (int sx = 0; sx < 2; ++sx) { const int st = l31 + 32 * sx;
                const float are = p.in[22][g * 64 + st], aim = p.in[23][g * 64 + st];
                const float er = __expf(are * dt); float rev = aim * dt * 0.15915494309189535f; rev -= floorf(rev);
                lr[sx] = er * __builtin_amdgcn_cosf(rev); li[sx] = er * __builtin_amdgcn_sinf(rev);
                const float den = 1.0f / (are * are + aim * aim); const float nr = lr[sx] - 1.0f, ni = li[sx];
                const float cr = (nr * are + ni * aim) * den, ci = (ni * are - nr * aim) * den;
                const float* br = p.in[25] + ((size_t)g * 64 + st) * 16 + hh * 8; const float* bi = p.in[26] + ((size_t)g * 64 + st) * 16 + hh * 8;
                const f32x4 x0 = *(const f32x4*)br, x1 = *(const f32x4*)(br + 4), y0 = *(const f32x4*)bi, y1 = *(const f32x4*)(bi + 4);
                u32x4 wr, wi;
                wr.x = cvt_pk_bf16(cr * x0[0] - ci * y0[0], cr * x0[1] - ci * y0[1]); wr.y = cvt_pk_bf16(cr * x0[2] - ci * y0[2], cr * x0[3] - ci * y0[3]);
                wr.z = cvt_pk_bf16(cr * x1[0] - ci * y1[0], cr * x1[1] - ci * y1[1]); wr.w = cvt_pk_bf16(cr * x1[2] - ci * y1[2], cr * x1[3] - ci * y1[3]);
                wi.x = cvt_pk_bf16(cr * y0[0] + ci * x0[0], cr * y0[1] + ci * x0[1]); wi.y = cvt_pk_bf16(cr * y0[2] + ci * x0[2], cr * y0[3] + ci * x0[3]);
                wi.z = cvt_pk_bf16(cr * y1[0] + ci * x1[0], cr * y1[1] + ci * x1[1]); wi.w = cvt_pk_bf16(cr * y1[2] + ci * x1[2], cr * y1[3] + ci * x1[3]);
                Bre[sx] = __builtin_bit_cast(bf16x8, wr); Bim[sx] = __builtin_bit_cast(bf16x8, wi);
                const float t2r = lr[sx] * lr[sx] - li[sx] * li[sx], t2i = 2.f * lr[sx] * li[sx]; l4r[sx] = t2r * t2r - t2i * t2i; l4i[sx] = 2.f * t2r * t2i; } }
        __syncthreads();
        float sr[2] = {0.f, 0.f}, si[2] = {0.f, 0.f};
#pragma unroll
        for (int sub = 0; sub < 2; ++sub) {
            const bf16x8 a = *(const LAS bf16x8*)(lds + (sub * 32 + l31) * UROW + (wid * 16 + hh * 8) * 2);
            f32x16 z;
#pragma unroll
            for (int r = 0; r < 16; ++r) z[r] = 0.f;
#pragma unroll
            for (int sx = 0; sx < 2; ++sx) { const f32x16 ar = __builtin_amdgcn_mfma_f32_32x32x16_bf16(a, Bre[sx], z, 0, 0, 0), ai = __builtin_amdgcn_mfma_f32_32x32x16_bf16(a, Bim[sx], z, 0, 0, 0);
#pragma unroll
                for (int ag = 0; ag < 4; ++ag) {
#pragma unroll
                    for (int bq = 0; bq < 4; ++bq) { const float t = lr[sx] * sr[sx] - li[sx] * si[sx] + ar[ag * 4 + bq]; si[sx] = lr[sx] * si[sx] + li[sx] * sr[sx] + ai[ag * 4 + bq]; sr[sx] = t; }
                    if (!(sub == 1 && ag == 3)) { const float t = l4r[sx] * sr[sx] - l4i[sx] * si[sx]; si[sx] = l4r[sx] * si[sx] + l4i[sx] * sr[sx]; sr[sx] = t; } } }
        }
#pragma unroll
        for (int sx = 0; sx < 2; ++sx) { if (hh == 0) { const float t = l4r[sx] * sr[sx] - l4i[sx] * si[sx]; si[sx] = l4r[sx] * si[sx] + l4i[sx] * sr[sx]; sr[sx] = t; }
            const float tr = sr[sx] + __shfl_xor(sr[sx], 32), ti = si[sx] + __shfl_xor(si[sx], 32);
            if (hh == 0) *(f32x2*)(Eb + ((((size_t)b * 64 + ch) * 64) + g) * 128 + (l31 + 32 * sx) * 2) = (f32x2){tr, ti}; }
        __syncthreads();
    }
}

__device__ __forceinline__ void phase_s5_out(const Params& p, LAS unsigned char* lds, int nitems) {
    const int tid = threadIdx.x, wid = tid >> 6, lane = tid & 63, l31 = lane & 31, hh = lane >> 5, hcol = lane & 15, q4 = lane >> 4;
    const float* proj2 = (const float*)(p.ws + OFF_PROJ2); const float* Eb = (const float*)(p.ws + OFF_E); bf16_t* yb = (bf16_t*)(p.ws + OFF_YB);
    constexpr int UROW = 272, SROW = 272;
    LAS unsigned char* sb = lds + 64 * UROW + wid * 32 * SROW;
    int oct_cur = -1;
    float lr[2] = {0.f, 0.f}, li[2] = {0.f, 0.f}, p64r[2] = {0.f, 0.f}, p64i[2] = {0.f, 0.f}; f32x4 dsk4 = (f32x4){0.f, 0.f, 0.f, 0.f}; bf16x8 Bre[2], Bim[2], Bc[4];
#pragma unroll
    for (int i = 0; i < 2; ++i) { Bre[i] = (bf16x8){0, 0, 0, 0, 0, 0, 0, 0}; Bim[i] = Bre[i]; }
#pragma unroll
    for (int i = 0; i < 4; ++i) Bc[i] = (bf16x8){0, 0, 0, 0, 0, 0, 0, 0};
    for (int item = blockIdx.x; item < nitems; item += gridDim.x) {
        const int cs = item >> 3, oct = item & 7, g = oct * 8 + wid; const bool smp = cs >= 128;
        const int b = smp ? cs - 128 : cs >> 6, ch = smp ? 0 : cs & 63, L = smp ? 32 : 64, row0 = smp ? TP + b * 32 : b * 4096 + ch * 64;
#pragma unroll
        for (int k = 0; k < 4; ++k) { const int i = tid + k * 512, t = i >> 5, q = i & 31; if (i < L * 32) { const f32x4 v = *(const f32x4*)(proj2 + (size_t)(row0 + t) * DM + 1024 + oct * 128 + q * 4);
            u32x2 w; w.x = cvt_pk_bf16(v[0], v[1]); w.y = cvt_pk_bf16(v[2], v[3]); *(LAS u32x2*)(lds + t * UROW + q * 8) = w; } }
        if (oct != oct_cur) { oct_cur = oct;
            const float dt = __expf(p.in[24][g]);
#pragma unroll
            for (int sx = 0; sx < 2; ++sx) { const int st = l31 + 32 * sx;
                const float are = p.in[22][g * 64 + st], aim = p.in[23][g * 64 + st];
                const float er = __expf(are * dt); float rev = aim * dt * 0.15915494309189535f; rev -= floorf(rev);
                lr[sx] = er * __builtin_amdgcn_cosf(rev); li[sx] = er * __builtin_amdgcn_sinf(rev);
                const float den = 1.0f / (are * are + aim * aim); const float nr = lr[sx] - 1.0f, ni = li[sx];
                const float cr = (nr * are + ni * aim) * den, ci = (ni * are - nr * aim) * den;
                const float* br = p.in[25] + ((size_t)g * 64 + st) * 16 + hh * 8; const float* bi = p.in[26] + ((size_t)g * 64 + st) * 16 + hh * 8;
                const f32x4 x0 = *(const f32x4*)br, x1 = *(const f32x4*)(br + 4), y0 = *(const f32x4*)bi, y1 = *(const f32x4*)(bi + 4);
                u32x4 wr, wi;
                wr.x = cvt_pk_bf16(cr * x0[0] - ci * y0[0], cr * x0[1] - ci * y0[1]); wr.y = cvt_pk_bf16(cr * x0[2] - ci * y0[2], cr * x0[3] - ci * y0[3]);
                wr.z = cvt_pk_bf16(cr * x1[0] - ci * y1[0], cr * x1[1] - ci * y1[1]); wr.w = cvt_pk_bf16(cr * x1[2] - ci * y1[2], cr * x1[3] - ci * y1[3]);
                wi.x = cvt_pk_bf16(cr * y0[0] + ci * x0[0], cr * y0[1] + ci * x0[1]); wi.y = cvt_pk_bf16(cr * y0[2] + ci * x0[2], cr * y0[3] + ci * x0[3]);
                wi.z = cvt_pk_bf16(cr * y1[0] + ci * x1[0], cr * y1[1] + ci * x1[1]); wi.w = cvt_pk_bf16(cr * y1[2] + ci * x1[2], cr * y1[3] + ci * x1[3]);
                Bre[sx] = __builtin_bit_cast(bf16x8, wr); Bim[sx] = __builtin_bit_cast(bf16x8, wi);
                float pr = lr[sx], pi = li[sx];
#pragma unroll
                for (int q = 0; q < 6; ++q) { const float t = pr * pr - pi * pi; pi = 2.f * pr * pi; pr = t; }
                p64r[sx] = pr; p64i[sx] = pi; }
#pragma unroll
            for (int ks = 0; ks < 4; ++ks) { const float* src = (ks < 2 ? p.in[27] : p.in[28]) + ((size_t)g * 16 + hcol) * 64 + (ks & 1) * 32 + q4 * 8; const float sg = ks < 2 ? 1.f : -1.f;
                const f32x4 x = *(const f32x4*)src, y = *(const f32x4*)(src + 4); u32x4 w; w.x = cvt_pk_bf16(sg * x[0], sg * x[1]); w.y = cvt_pk_bf16(sg * x[2], sg * x[3]); w.z = cvt_pk_bf16(sg * y[0], sg * y[1]); w.w = cvt_pk_bf16(sg * y[2], sg * y[3]);
                Bc[ks] = __builtin_bit_cast(bf16x8, w); }
            dsk4 = *(const f32x4*)(p.in[29] + g * 16 + q4 * 4); }
        float sr[2] = {0.f, 0.f}, si[2] = {0.f, 0.f};
        if (smp) {
#pragma unroll
            for (int sx = 0; sx < 2; ++sx) { const int st = l31 + 32 * sx; sr[sx] = p.in[4][((size_t)b * 64 + g) * 64 + st]; si[sx] = p.in[5][((size_t)b * 64 + g) * 64 + st]; }
        } else { const float* e0 = Eb + (((size_t)b * 64) * 64 + g) * 128 + l31 * 2;
            for (int j0 = 0; j0 < ch; j0 += 16) { f32x2 ev[2][16];
#pragma unroll
                for (int jj = 0; jj < 16; ++jj) { const int j = (j0 + jj) < ch ? (j0 + jj) : (ch - 1); ev[0][jj] = *(const f32x2*)(e0 + (size_t)j * 64 * 128); ev[1][jj] = *(const f32x2*)(e0 + (size_t)j * 64 * 128 + 64); }
#pragma unroll
                for (int jj = 0; jj < 16; ++jj) { const bool on = (j0 + jj) < ch;
#pragma unroll
                    for (int sx = 0; sx < 2; ++sx) { const float t = p64r[sx] * sr[sx] - p64i[sx] * si[sx] + ev[sx][jj].x, u2 = p64r[sx] * si[sx] + p64i[sx] * sr[sx] + ev[sx][jj].y; sr[sx] = on ? t : sr[sx]; si[sx] = on ? u2 : si[sx]; } } } }
        __syncthreads();
        for (int sub = 0; sub < L; sub += 32) {
            const bf16x8 a = *(const LAS bf16x8*)(lds + (sub + l31) * UROW + (wid * 16 + hh * 8) * 2);
            f32x16 z;
#pragma unroll
            for (int r = 0; r < 16; ++r) z[r] = 0.f;
#pragma unroll
            for (int sx = 0; sx < 2; ++sx) {
                const f32x16 ar = __builtin_amdgcn_mfma_f32_32x32x16_bf16(a, Bre[sx], z, 0, 0, 0), ai = __builtin_amdgcn_mfma_f32_32x32x16_bf16(a, Bim[sx], z, 0, 0, 0);
                const float lrs = lr[sx], lis = li[sx]; float s_r = sr[sx], s_i = si[sx];
#pragma unroll
                for (int ag = 0; ag < 4; ++ag) {
                    float c1r[4], c1i[4], c2r[4], c2i[4]; float tr = s_r, ti = s_i;
#pragma unroll
                    for (int bq = 0; bq < 4; ++bq) { const float t = lrs * tr - lis * ti + ar[ag * 4 + bq]; ti = lrs * ti + lis * tr + ai[ag * 4 + bq]; tr = t; c1r[bq] = tr; c1i[bq] = ti; }
                    float xr = __shfl_xor(tr, 32), xi = __shfl_xor(ti, 32);
#pragma unroll
                    for (int bq = 0; bq < 4; ++bq) { const float t = lrs * xr - lis * xi + ar[ag * 4 + bq]; xi = lrs * xi + lis * xr + ai[ag * 4 + bq]; xr = t; c2r[bq] = xr; c2i[bq] = xi; }
                    s_r = __shfl_xor(xr, 32); s_i = __shfl_xor(xi, 32);
#pragma unroll
                    for (int bq = 0; bq < 4; ++bq) { const int tt = ag * 8 + hh * 4 + bq; const float vr = hh ? c2r[bq] : c1r[bq], vi = hh ? c2i[bq] : c1i[bq];
                        *(LAS bf16_t*)(sb + tt * SROW + (l31 + 32 * sx) * 2) = (bf16_t)(cvt_pk_bf16(vr, 0.f) & 0xffffu); *(LAS bf16_t*)(sb + tt * SROW + 128 + (l31 + 32 * sx) * 2) = (bf16_t)(cvt_pk_bf16(vi, 0.f) & 0xffffu); }
                }
                sr[sx] = s_r; si[sx] = s_i; __builtin_amdgcn_sched_barrier(0); }
            __syncthreads();
#pragma unroll
            for (int mt = 0; mt < 2; ++mt) { f32x4 acc = (f32x4){0.f, 0.f, 0.f, 0.f};
#pragma unroll
                for (int ks = 0; ks < 4; ++ks) { const bf16x8 af = *(const LAS bf16x8*)(sb + (mt * 16 + hcol) * SROW + ks * 64 + q4 * 16); acc = __builtin_amdgcn_mfma_f32_16x16x32_bf16(Bc[ks], af, acc, 0, 0, 0); }
                const int t = sub + mt * 16 + hcol; const u32x2 uw = *(const LAS u32x2*)(lds + t * UROW + (wid * 16 + q4 * 4) * 2);
                const float y0 = acc[0] + dsk4[0] * bf_lo(uw.x), y1 = acc[1] + dsk4[1] * bf_hi(uw.x), y2 = acc[2] + dsk4[2] * bf_lo(uw.y), y3 = acc[3] + dsk4[3] * bf_hi(uw.y);
                u32x2 w; w.x = cvt_pk_bf16(gelu_t(y0), gelu_t(y1)); w.y = cvt_pk_bf16(gelu_t(y2), gelu_t(y3));
                *(u32x2*)(yb + (size_t)(row0 + t) * YLD + g * 16 + q4 * 4) = w; }
            __syncthreads();
        }
        if (hh == 0 && (smp || ch == 63)) { float* ore = p.out + (smp ? O_S5RE_S : O_S5RE_P) + ((size_t)b * 64 + g) * 64; float* oim = p.out + (smp ? O_S5IM_S : O_S5IM_P) + ((size_t)b * 64 + g) * 64;
#pragma unroll
            for (int sx = 0; sx < 2; ++sx) { ore[l31 + 32 * sx] = sr[sx]; oim[l31 + 32 * sx] = si[sx]; } }
        __syncthreads();
    }
}

#define XB_TMO      128
#define XB_XCNT(j)  (256  + 64 * (j))
#define XB_XSUB(j)  (1280 + 64 * (j))
#define XB_XGEN(j)  (2304 + 64 * (j))
#define XB_TOP      3328
#define XB_TOPGEN   3392
#define XCD_BAR_WORDS 3456
#define XB_SPIN_CAP (1u << 20)
__device__ __forceinline__ unsigned xb_ld(unsigned* p)              { return __hip_atomic_load(p, __ATOMIC_RELAXED, __HIP_MEMORY_SCOPE_AGENT); }
__device__ __forceinline__ unsigned xb_add(unsigned* p, unsigned v) { return __hip_atomic_fetch_add(p, v, __ATOMIC_RELAXED, __HIP_MEMORY_SCOPE_AGENT); }
__device__ __forceinline__ unsigned xb_xcc_id() { return (unsigned)__builtin_amdgcn_s_getreg((3 << 11) | 20) & 0xFu; }
#define XB_SPIN(cond, bar) do { unsigned _sp = 0; while (cond) { __builtin_amdgcn_s_sleep(1); \
    if ((++_sp & 255u) == 0u) { if (xb_ld(&(bar)[XB_TMO])) break; if (_sp > XB_SPIN_CAP) { atomicAdd(&(bar)[XB_TMO], 1u); break; } } } } while (0)
struct XcdBarrier { unsigned* bar; unsigned x; volatile LAS unsigned* st; };
__device__ __forceinline__ XcdBarrier xcd_barrier_post(unsigned* bar, volatile LAS unsigned* st) {
    XcdBarrier b; b.bar = bar; b.x = xb_xcc_id(); b.st = st;
    if (threadIdx.x == 0) (void)xb_add(&bar[XB_XCNT(b.x)], 1u);
    return b;
}
__device__ __forceinline__ void xcd_barrier_complete(unsigned* bar, unsigned x, unsigned& nloc, unsigned& nx) {
    const unsigned G = gridDim.x * gridDim.y * gridDim.z;
    unsigned sum, cnt, mine, sp = 0u;
    for (;;) {
        sum = 0u; cnt = 0u; mine = 0u;
#pragma unroll
        for (unsigned j = 0; j < 16; ++j) { const unsigned c = xb_ld(&bar[XB_XCNT(j)]); sum += c; cnt += (c > 0u) ? 1u : 0u; mine = (j == x) ? c : mine; }
        if (sum == G) break;
        __builtin_amdgcn_s_sleep(1);
        if ((++sp & 255u) == 0u) { if (xb_ld(&bar[XB_TMO])) break; if (sp > XB_SPIN_CAP) { atomicAdd(&bar[XB_TMO], 1u); break; } }
    }
    nloc = mine > 0u ? mine : 1u; nx = cnt > 0u ? cnt : 1u;
}
__device__ __forceinline__ void xcd_barrier(const XcdBarrier& b) {
    asm volatile("s_waitcnt vmcnt(0)" ::: "memory");
    __syncthreads();
    if (threadIdx.x == 0) {
        unsigned* bar = b.bar;
        __builtin_amdgcn_s_waitcnt(0);
        unsigned nloc = b.st[0], nx = b.st[1];
        if (nloc == 0u) { xcd_barrier_complete(bar, b.x, nloc, nx); b.st[0] = nloc; b.st[1] = nx; }
        const unsigned old = xb_add(&bar[XB_XSUB(b.x)], 1u);
        const unsigned gen = old / nloc;
        if (old + 1u == (gen + 1u) * nloc) {
            __builtin_amdgcn_fence(__ATOMIC_RELEASE, "agent");
            asm volatile("s_waitcnt vmcnt(0)" ::: "memory");
            const unsigned og = xb_add(&bar[XB_TOP], 1u);
            const unsigned tg = og / nx;
            if (og + 1u == (tg + 1u) * nx) xb_add(&bar[XB_TOPGEN], 1u);
            else XB_SPIN(xb_ld(&bar[XB_TOPGEN]) == tg, bar);
            __builtin_amdgcn_fence(__ATOMIC_ACQUIRE, "agent");
            xb_add(&bar[XB_XGEN(b.x)], 1u);
            asm volatile("s_waitcnt vmcnt(0)" ::: "memory");
        } else {
            XB_SPIN(xb_ld(&bar[XB_XGEN(b.x)]) == gen, bar);
            __builtin_amdgcn_fence(__ATOMIC_ACQUIRE, "agent");
            asm volatile("s_waitcnt vmcnt(0)" ::: "memory");
        }
    }
    __syncthreads();
}

__device__ __forceinline__ void run_phase(const Params& p, LAS unsigned char* lds, const int ph, const int vb) {
#ifdef ONLY_PH
    if (ph != ONLY_PH) return;
#endif
    unsigned char* ws = p.ws; const int nb = gridDim.x;
    switch (ph) {
    case 0: phase_prep(p, lds); break;
    case 1: { pg8::EpiBf16<1> E; E.O = (bf16_t*)(ws + OFF_PROJ); E.ldc = NE; E.gelu_tiles = 8; E.scale = nullptr; E.slab = 0;
              run_gemm(lds, (const bf16_t*)(ws + OFF_H), (const bf16_t*)(ws + OFF_WIN_E), NE, DM, HLD, HLD, 0, E, vb);
              phase_glr(p, vb);
              if (nb == 256 && vb >= 208) prep_run<false>(p, lds, vb - 208, 48, ND_G1); } break;
    case 2: { for (int it = blockIdx.x; it < 640; it += nb) { if (it < 512) glau_item<64>(p, lds, it); else glau_item<32>(p, lds, it); }
              for (int it = nb - 1 - (int)blockIdx.x; it < 384; it += nb) { if (it < 256) amix_item<128>(p, lds, it); else amix_item<32>(p, lds, it); } } break;
    case 3: phase_gla_scan(p); break;
    case 4: for (int it = blockIdx.x; it < 640; it += nb) { if (it < 512) glao_item<64>(p, lds, it); else glao_item<32>(p, lds, it); } break;
    case 5: case 15: { pg8::EpiBf16<1> E; E.O = (bf16_t*)(ws + OFF_M); E.ldc = DM; E.gelu_tiles = 0; E.scale = nullptr; E.slab = 0;
              const bf16_t* W = (const bf16_t*)(ws + (ph == 5 ? OFF_WOUT_E : OFF_WOUT_O));
              run_gemm(lds, (const bf16_t*)(ws + OFF_MIX), W, DM, DM, HLD, HLD, 0, E, vb, TP);
              run_gemm_split(lds, (const bf16_t*)(ws + OFF_MIX), W, DM, HLD, 8, (bf16_t*)(ws + OFF_SLAB_A), vb); } break;
    case 6: phase_norm(p, true, nullptr, p.in[8], p.in[9], (const bf16_t*)(ws + OFF_SLAB_A), 8); break;
    case 7: case 17: { const int layer = ph == 7 ? 0 : 1; pg8::EpiGateVal E; E.ACT = (bf16_t*)(ws + OFF_VAL); E.GF = (bf16_t*)(ws + OFF_GF); E.VF = (bf16_t*)(ws + OFF_VF); E.GL = (bf16_t*)(ws + OFF_GL);
              E.ffn_p = p.out + O_FFN_P + (size_t)layer * 2 * 2 * DFF; E.ffn_s = p.out + O_FFN_S + (size_t)layer * 32 * 2 * DFF;
              E.cw = p.in[33] + (size_t)layer * 3 * DFF; E.cb = p.in[34] + (size_t)layer * DFF;
              run_gemm(lds, (const bf16_t*)(ws + OFF_H), (const bf16_t*)(ws + (layer ? OFF_WUP1 : OFF_WUP0)), 2 * DFF, DM, HLD, HLD, 0, E, vb);
              if (layer == 0 && nb == 256 && vb >= 48) prep_run<false>(p, lds, ND_G1 + (vb - 48), 208, ND_G1 + ND_G3); } break;
    case 8: phase_convfix(p, 0); break;
    case 18: phase_convfix(p, 1); break;
    case 9: case 19: { pg8::EpiBf16<1> E; E.O = (bf16_t*)(ws + OFF_M); E.ldc = DM; E.gelu_tiles = 0; E.scale = nullptr; E.slab = 0;
              const bf16_t* W = (const bf16_t*)(ws + (ph == 9 ? OFF_WDN0 : OFF_WDN1));
              run_gemm(lds, (const bf16_t*)(ws + OFF_VAL), W, DM, DFF, ALD, ALD, 0, E, vb, TP);
              run_gemm_split(lds, (const bf16_t*)(ws + OFF_VAL), W, DFF, ALD, 4, (bf16_t*)(ws + OFF_SLAB_B), vb);
              if (ph == 9 && nb == 256 && vb >= 128) prep_run<false>(p, lds, ND_G1 + ND_G3 + (vb - 128), 128, ND_G1 + ND_G3 + ND_G4); } break;
    case 10: phase_norm(p, false, nullptr, p.in[10], p.in[7] + DM, (const bf16_t*)(ws + OFF_SLAB_B), 4); break;
    case 11: { pg8::EpiF32 E; E.C = (float*)(ws + OFF_PROJ2); E.ldc = DM; E.slab = 0;
              run_gemm(lds, (const bf16_t*)(ws + OFF_H), (const bf16_t*)(ws + OFF_WIN_O), DM, DM, HLD, HLD, 0, E, vb); } break;
    case 12: { phase_pool(p); phase_s5_ends(p, lds, 1024); } break;
    case 13: phase_s5_out(p, lds, 1280); break;
    case 14: { pg8::EpiGlu E; E.O = (bf16_t*)(ws + OFF_MIX) + 1024; E.ldc = HLD;
              run_gemm(lds, (const bf16_t*)(ws + OFF_YB), (const bf16_t*)(ws + OFF_WGLU), 2048, 1024, YLD, YLD, 0, E, vb); }
             { pg8::EpiBf16<1> E2; E2.O = (bf16_t*)(ws + OFF_MIX); E2.ldc = HLD; E2.gelu_tiles = 0; E2.scale = nullptr; E2.slab = 0;
              run_gemm(lds, (const bf16_t*)(ws + OFF_DELTA), (const bf16_t*)(ws + OFF_CMAP), 1024, 256, YLD, CLD, 256, E2, vb, T, nb >= 64 ? 32 : 0); } break;
    case 16: phase_norm(p, false, nullptr, p.in[8] + DM, p.in[9] + DM, (const bf16_t*)(ws + OFF_SLAB_A), 8); break;
    case 20: phase_norm(p, false, p.out + O_Y, p.in[10] + DM, nullptr, (const bf16_t*)(ws + OFF_SLAB_B), 4); break;
    default: break;
    }
}

__global__ void __launch_bounds__(512, 2) fwd_megakernel(Params p) {
    extern __shared__ __attribute__((aligned(16))) unsigned char shm[];
    LAS unsigned char* lds = (LAS unsigned char*)shm;
    cg::grid_group grid = cg::this_grid();
    volatile LAS unsigned* xst = (volatile LAS unsigned*)(lds + 131072);
    if (threadIdx.x == 0) { xst[0] = 0u; xst[1] = 0u; }
    __syncthreads();
    const XcdBarrier xb = xcd_barrier_post((unsigned*)(p.ws + OFF_BAR), xst);
    const int vb = (int)blockIdx.x;
    if (p.ph_hi > NPHASE) grid.sync();
#define GSYNC() xcd_barrier(xb)
#ifndef DUP_MASK
#define DUP_MASK 0u
#endif
#ifndef EXTRA_SYNC
#define EXTRA_SYNC 0
#endif
#define PH(n) if (p.ph_lo <= (n) && (n) < p.ph_hi) { run_phase(p, lds, SEQ[n], vb); if ((DUP_MASK >> (n)) & 1u) { GSYNC(); run_phase(p, lds, SEQ[n], vb); } \
        if ((n) + 1 < p.ph_hi) { GSYNC(); for (int _e = 0; _e < EXTRA_SYNC; ++_e) GSYNC(); } }
    PH(0) PH(1) PH(2) PH(3) PH(4) PH(5) PH(6) PH(7) PH(8) PH(9) PH(10) PH(11) PH(12) PH(13) PH(14) PH(15) PH(16) PH(17) PH(18) PH(19) PH(20)
#undef PH
}

extern "C" void kernel_launch(void* const* d_in, const int* in_sizes, int n_in, void* d_out, int out_size, void* d_ws, size_t ws_size, hipStream_t stream) {
    static int grid_blocks = 0;
    if (grid_blocks == 0) {
        if (n_in != 36 || (size_t)out_size != O_END || ws_size < WS_END) { fprintf(stderr, "kernel_launch: unexpected sizes n_in %d out %d ws %zu (need %zu)\n", n_in, out_size, ws_size, (size_t)WS_END); grid_blocks = -1; return; }
        int dev = 0, cus = 0, per_cu = 0;
        hipGetDevice(&dev); hipDeviceGetAttribute(&cus, hipDeviceAttributeMultiprocessorCount, dev);
        if (hipFuncSetAttribute((const void*)fwd_megakernel, hipFuncAttributeMaxDynamicSharedMemorySize, LDS_BYTES) != hipSuccess) { fprintf(stderr, "kernel_launch: hipFuncSetAttribute failed\n"); grid_blocks = -1; return; }
        hipOccupancyMaxActiveBlocksPerMultiprocessor(&per_cu, (const void*)fwd_megakernel, 512, LDS_BYTES);
        if (per_cu < 1) { fprintf(stderr, "kernel_launch: occupancy query says %d blocks per CU\n", per_cu); per_cu = 1; }
        (void)hipGetLastError();
        grid_blocks = cus;
    }
    if (grid_blocks < 0) return;
    Params p{};
    for (int i = 0; i < 36; ++i) p.in[i] = (const float*)d_in[i];
    p.out = (float*)d_out; p.ws = (unsigned char*)d_ws;
#if MULTI_LAUNCH
    for (int ph = 0; ph < NPHASE; ++ph) { p.ph_lo = ph; p.ph_hi = ph + 1; hipLaunchKernelGGL(fwd_megakernel, dim3(grid_blocks), dim3(512), LDS_BYTES, stream, p); }
#else
    p.ph_lo = 0; p.ph_hi = NPHASE;
    if (hipMemsetAsync((unsigned char*)d_ws + OFF_BAR, 0, 16384, stream) != hipSuccess) { fprintf(stderr, "kernel_launch: barrier memset failed\n"); return; }
    void* args[] = {&p};
    hipError_t e = hipLaunchCooperativeKernel((const void*)fwd_megakernel, dim3(grid_blocks), dim3(512), args, LDS_BYTES, stream);
    if (e != hipSuccess) fprintf(stderr, "cooperative launch failed: %s (grid %d)\n", hipGetErrorString(e), grid_blocks);
#endif
}
```

```cpp
#include <hip/hip_runtime.h>
#include <hip/hip_cooperative_groups.h>
#include <cstdio>
namespace cg = cooperative_groups;

#define LAS __attribute__((address_space(3)))
typedef unsigned short bf16_t;
typedef short bf16x8 __attribute__((ext_vector_type(8)));
typedef float f32x4 __attribute__((ext_vector_type(4)));
typedef float f32x2 __attribute__((ext_vector_type(2)));
typedef float f32x16 __attribute__((ext_vector_type(16)));
typedef unsigned u32x4 __attribute__((ext_vector_type(4)));
typedef unsigned u32x2 __attribute__((ext_vector_type(2)));

#ifndef MULTI_LAUNCH
#define MULTI_LAUNCH 0
#endif

constexpr int T = 9216, TP = 8192, DM = 2048, DFF = 5632, NE = 5120, NE_SRC = 5136;
constexpr float EPS = 1e-6f;
constexpr int PADK = 64, HLD = DM + PADK, ALD = DFF + PADK, YLD = 1024 + PADK, CLD = 256 + PADK;
constexpr int NPHASE = 21;
__device__ constexpr int SEQ[NPHASE] = {0, 1, 2, 3, 4, 5, 6, 7, 8, 9, 10, 11, 12, 13, 14, 15, 16, 17, 18, 19, 20};
constexpr int LDS_BYTES = 131072 + 16;

constexpr size_t al256(size_t x) { return (x + 255) & ~(size_t)255; }
constexpr size_t SZ_WIN_E = (size_t)NE * HLD * 2, SZ_WG = 16 * DM * 2, SZ_W22 = (size_t)DM * HLD * 2, SZ_WUP = (size_t)2 * DFF * HLD * 2,
                 SZ_WDN = (size_t)DM * ALD * 2, SZ_CMAP = 1024 * CLD * 2, SZ_WGLU = (size_t)2048 * YLD * 2, SZ_WSM = 8 * 128 * 128 * 2;
constexpr size_t OFF_WIN_E = 0;
constexpr size_t OFF_WG = OFF_WIN_E + SZ_WIN_E;
constexpr size_t OFF_WOUT_E = OFF_WG + SZ_WG;
constexpr size_t OFF_WUP0 = OFF_WOUT_E + SZ_W22;
constexpr size_t OFF_WUP1 = OFF_WUP0 + SZ_WUP;
constexpr size_t OFF_WDN0 = OFF_WUP1 + SZ_WUP;
constexpr size_t OFF_WDN1 = OFF_WDN0 + SZ_WDN;
constexpr size_t OFF_WIN_O = OFF_WDN1 + SZ_WDN;
constexpr size_t OFF_CMAP = OFF_WIN_O + SZ_W22;
constexpr size_t OFF_WGLU = OFF_CMAP + SZ_CMAP;
constexpr size_t OFF_WOUT_O = OFF_WGLU + SZ_WGLU;
constexpr size_t OFF_WSM = OFF_WOUT_O + SZ_W22;
constexpr size_t OFF_H = OFF_WSM + SZ_WSM;
constexpr size_t OFF_MIX = OFF_H + (size_t)T * HLD * 2;
constexpr size_t OFF_M = OFF_MIX + (size_t)T * HLD * 2;
constexpr size_t OFF_XA = OFF_M + (size_t)T * DM * 4;
constexpr size_t OFF_R1 = OFF_XA + (size_t)T * DM * 4;
constexpr size_t SZ_R1 = (size_t)T * DFF * 2 + (size_t)T * ALD * 2;
constexpr size_t OFF_PROJ = OFF_R1;
constexpr size_t OFF_UT = OFF_PROJ + (size_t)T * NE * 2;
constexpr size_t OFF_ST = OFF_UT + (size_t)512 * 256 * 128 * 4;
constexpr size_t OFF_DECAY = OFF_ST + (size_t)640 * 256 * 128 * 2;
constexpr size_t OFF_GLR = OFF_DECAY + (size_t)640 * 128 * 4;
static_assert(OFF_GLR + (size_t)T * 16 * 4 <= OFF_R1 + SZ_R1, "arena");
constexpr size_t OFF_GATE = OFF_R1;
constexpr size_t OFF_VAL = OFF_R1 + (size_t)T * DFF * 2;
constexpr size_t OFF_GF = OFF_R1;
constexpr size_t OFF_VF = OFF_GF + (size_t)576 * DFF * 2;
constexpr size_t OFF_GL = OFF_VF + (size_t)576 * DFF * 2;
constexpr size_t OFF_PROJ2 = OFF_R1;
constexpr size_t OFF_DELTA = OFF_PROJ2 + (size_t)T * DM * 4;
constexpr size_t OFF_YB = OFF_DELTA + (size_t)T * YLD * 2;
constexpr size_t OFF_E = OFF_YB + (size_t)T * YLD * 2;
constexpr size_t OFF_SLAB_A = OFF_R1;
constexpr size_t OFF_SLAB_B = OFF_MIX;
constexpr size_t OFF_BAR = OFF_R1 + SZ_R1;
constexpr size_t WS_END = OFF_BAR + 16384;

constexpr size_t O_Y = 0;
constexpr size_t O_GLA_P = O_Y + (size_t)T * DM;
constexpr size_t O_GLA_S = O_GLA_P + 2 * 4 * 128 * 256;
constexpr size_t O_AV = O_GLA_S + (size_t)32 * 4 * 128 * 256;
constexpr size_t O_POOL_P = O_AV + (size_t)32 * 32 * 1024;
constexpr size_t O_POOL_S = O_POOL_P + 2 * 15 * 1024;
constexpr size_t O_S5RE_P = O_POOL_S + 32 * 15 * 1024;
constexpr size_t O_S5IM_P = O_S5RE_P + 2 * 64 * 64;
constexpr size_t O_S5RE_S = O_S5IM_P + 2 * 64 * 64;
constexpr size_t O_S5IM_S = O_S5RE_S + 32 * 64 * 64;
constexpr size_t O_FFN_P = O_S5IM_S + 32 * 64 * 64;
constexpr size_t O_FFN_S = O_FFN_P + 2 * 2 * 2 * DFF;
constexpr size_t O_END = O_FFN_S + (size_t)2 * 32 * 2 * DFF;

struct Params {
    const float* in[36];
    float* out;
    unsigned char* ws;
    int ph_lo, ph_hi;
};

__device__ __forceinline__ unsigned cvt_pk_bf16(float lo, float hi) { unsigned r; asm volatile("v_cvt_pk_bf16_f32 %0, %1, %2" : "=v"(r) : "v"(lo), "v"(hi)); return r; }
__device__ __forceinline__ float bf_lo(unsigned w) { return __uint_as_float(w << 16); }
__device__ __forceinline__ float bf_hi(unsigned w) { return __uint_as_float(w & 0xffff0000u); }
__device__ __forceinline__ float bf1(bf16_t b) { return __uint_as_float(((unsigned)b) << 16); }
__device__ __forceinline__ float fast_rcp(float x) { return __builtin_amdgcn_rcpf(x); }
__device__ __forceinline__ float sigmoidf(float x) { return fast_rcp(1.0f + __builtin_amdgcn_exp2f(-1.4426950409f * x)); }
__device__ __forceinline__ float gelu_t(float x) { const float u = x * (1.5957691216f + 0.0713548163f * x * x); return x * fast_rcp(1.0f + __builtin_amdgcn_exp2f(-1.4426950409f * u)); }
__device__ __forceinline__ float wave_sum(float v) {
#pragma unroll
    for (int o = 32; o >= 1; o >>= 1) v += __shfl_xor(v, o);
    return v;
}
__device__ __forceinline__ const float* xrow_in(const Params& p, int row) { return row < TP ? p.in[0] + (size_t)row * DM : p.in[1] + (size_t)(row - TP) * DM; }

namespace pg8 {
constexpr int BM = 256, BK = 64, HALF = 128, HTB = HALF * BK * 2, STAGE_BYTES = 8 * HTB, NXCD = 8, WGM = 8;
__device__ __forceinline__ int lds_byte(int r, int c) { const int st = (r >> 4) * 2 + (c >> 5), rr = r & 15, cc = c & 31, ob = rr * 64 + cc * 2; return st * 1024 + (ob ^ (((ob >> 9) & 1) << 5)); }
__device__ __forceinline__ void stage_rc(int b, int& R, int& C) { const int st = b / 1024, sb = b % 1024, swz = sb ^ (((sb >> 9) & 1) << 5); R = (st >> 1) * 16 + swz / 64; C = (st & 1) * 32 + (swz % 64) / 2; }
__device__ __forceinline__ int perm32(int rho) { const int n = rho >> 4, i = rho & 15; return 8 * (i >> 2) + 4 * n + (i & 3); }
struct Unit { int pm, pn, ks; };
struct Gemm { const bf16_t* A; const bf16_t* Bt; int M, N, K, lda, ldb, a_pn_off; };
struct StaticOrder {
    int nM, nN, nwg, G, c;
    __device__ void init(int M, int N, int G_, int c_) { nM = M / BM; nN = N / BM; nwg = nM * nN; G = G_; c = c_; }
    __device__ bool next(int i, Unit& u) const {
        const long L = (long)i * G + c; if (L >= nwg) return false;
        int wgid = (int)L; { const int q = nwg / NXCD, r = nwg % NXCD, xcd = wgid % NXCD, off = wgid / NXCD; wgid = (xcd < r ? xcd * (q + 1) : r * (q + 1) + (xcd - r) * q) + off; }
        const int nig = WGM * nN, gid = wgid / nig, fm = gid * WGM, gsz = (nM - fm) < WGM ? (nM - fm) : WGM;
        u.pm = fm + ((wgid % nig) % gsz); u.pn = (wgid % nig) / gsz; u.ks = 0; return true;
    }
};
struct SplitOrder {
    int S, nsub, G, c;
    __device__ void init(int nN, int S_, int G_, int c_) { S = S_; nsub = 4 * nN * S_; G = G_; c = c_; }
    __device__ bool next(int i, Unit& u) const {
        const long L = (long)i * G + c; if (L >= nsub) return false;
        const int l = (int)L, tile = l / S; u.ks = l - tile * S; u.pm = tile & 3; u.pn = tile >> 2; return true;
    }
};

struct EpiF32 {
    static constexpr bool PERM = false;
    float* C; int ldc; size_t slab;
    __device__ __forceinline__ void operator()(const f32x4 (&acc)[2][2][4][2], const Unit& u, int wr, int wc, int fr, int fq) const {
        const int row0 = u.pm * BM + wr * 64 + fr, col0 = u.pn * BM + wc * 32 + 4 * fq;
#pragma unroll
        for (int ai = 0; ai < 2; ++ai)
#pragma unroll
            for (int m = 0; m < 4; ++m) { float* rowp = C + (size_t)u.ks * slab + (size_t)(row0 + ai * HALF + m * 16) * ldc + col0;
#pragma unroll
                for (int bj = 0; bj < 2; ++bj)
#pragma unroll
                    for (int n = 0; n < 2; ++n) *(f32x4*)(rowp + bj * HALF + n * 16) = acc[ai][bj][m][n]; }
    }
};
template <int MODE> struct EpiBf16 {
    static constexpr bool PERM = true;
    bf16_t* O; int ldc; int gelu_tiles; const float* scale; size_t slab;
    __device__ __forceinline__ void operator()(const f32x4 (&acc)[2][2][4][2], const Unit& u, int wr, int wc, int fr, int fq) const {
        const int row0 = u.pm * BM + wr * 64 + fr, col0 = u.pn * BM + wc * 32 + 8 * fq;
        bf16_t* Ob = O + (size_t)u.ks * slab;
        const bool dog = (MODE == 1) && (u.pn < gelu_tiles);
#pragma unroll
        for (int ai = 0; ai < 2; ++ai)
#pragma unroll
            for (int m = 0; m < 4; ++m) { bf16_t* rowp = Ob + (size_t)(row0 + ai * HALF + m * 16) * ldc + col0;
#pragma unroll
                for (int bj = 0; bj < 2; ++bj) { f32x4 v0 = acc[ai][bj][m][0], v1 = acc[ai][bj][m][1];
                    if (MODE == 2) { v0 = v0 * *(const f32x4*)(scale + col0 + bj * HALF); v1 = v1 * *(const f32x4*)(scale + col0 + bj * HALF + 4); }
                    if (dog) {
#pragma unroll
                        for (int j = 0; j < 4; ++j) { v0[j] = gelu_t(v0[j]); v1[j] = gelu_t(v1[j]); } }
                    u32x4 w; w.x = cvt_pk_bf16(v0[0], v0[1]); w.y = cvt_pk_bf16(v0[2], v0[3]); w.z = cvt_pk_bf16(v1[0], v1[1]); w.w = cvt_pk_bf16(v1[2], v1[3]);
                    *(u32x4*)(rowp + bj * HALF) = w; } }
    }
};
struct EpiGateVal {
    static constexpr bool PERM = true;
    bf16_t* ACT; bf16_t* GF; bf16_t* VF; bf16_t* GL; float* ffn_p; float* ffn_s; const float* cw; const float* cb;
    __device__ __forceinline__ void operator()(const f32x4 (&acc)[2][2][4][2], const Unit& u, int wr, int wc, int fr, int fq) const {
        const int lane = threadIdx.x & 63, row0 = u.pm * BM + wr * 64 + fr, col0 = u.pn * HALF + wc * 32 + 8 * fq;
        const int src1 = (lane & 48) | ((fr - 1) & 15), src2 = (lane & 48) | ((fr - 2) & 15);
        f32x4 w0[2], w1[2], w2[2], bb[2];
#pragma unroll
        for (int n = 0; n < 2; ++n) { w0[n] = *(const f32x4*)(cw + col0 + 4 * n); w1[n] = *(const f32x4*)(cw + DFF + col0 + 4 * n); w2[n] = *(const f32x4*)(cw + 2 * DFF + col0 + 4 * n); bb[n] = *(const f32x4*)(cb + col0 + 4 * n); }
#pragma unroll
        for (int ai = 0; ai < 2; ++ai) {
            f32x4 pP1[2], pP2[2];
#pragma unroll
            for (int n = 0; n < 2; ++n) { pP1[n] = (f32x4){0.f, 0.f, 0.f, 0.f}; pP2[n] = (f32x4){0.f, 0.f, 0.f, 0.f}; }
#pragma unroll
            for (int m = 0; m < 4; ++m) { const int row = row0 + ai * HALF + m * 16; const size_t off = (size_t)row * ALD + col0;
                const f32x4 g0 = acc[ai][0][m][0], g1v = acc[ai][0][m][1], v0 = acc[ai][1][m][0], v1 = acc[ai][1][m][1];
                u32x2 a2[2];
#pragma unroll
                for (int n = 0; n < 2; ++n) { const f32x4 g = n ? g1v : g0, v = n ? v1 : v0; f32x4 P1, P2;
#pragma unroll
                    for (int j = 0; j < 4; ++j) { P1[j] = __shfl(g[j], src1); P2[j] = __shfl(g[j], src2); }
                    const f32x4 h1 = fr >= 1 ? P1 : pP1[n], h2 = fr >= 2 ? P2 : pP2[n]; pP1[n] = P1; pP2[n] = P2;
                    const f32x4 cv = bb[n] + w0[n] * h2 + w1[n] * h1 + w2[n] * g; f32x4 o;
#pragma unroll
                    for (int j = 0; j < 4; ++j) o[j] = gelu_t(cv[j]) * v[j];
                    a2[n].x = cvt_pk_bf16(o[0], o[1]); a2[n].y = cvt_pk_bf16(o[2], o[3]); }
                const bool deferred = (fr < 2) && (m == 0 || (m == 2 && row >= TP));
                if (!deferred) { *(u32x4*)(ACT + off) = (u32x4){a2[0].x, a2[0].y, a2[1].x, a2[1].y}; }
                else { const size_t so = ((size_t)(row >> 5) * 2 + (row & 1)) * DFF + col0;
                    *(u32x4*)(GF + so) = (u32x4){cvt_pk_bf16(g0[0], g0[1]), cvt_pk_bf16(g0[2], g0[3]), cvt_pk_bf16(g1v[0], g1v[1]), cvt_pk_bf16(g1v[2], g1v[3])};
                    *(u32x4*)(VF + so) = (u32x4){cvt_pk_bf16(v0[0], v0[1]), cvt_pk_bf16(v0[2], v0[3]), cvt_pk_bf16(v1[0], v1[1]), cvt_pk_bf16(v1[2], v1[3])}; }
                if (m == 3 && fr >= 14 && row < TP) { const size_t so = ((size_t)(row >> 6) * 2 + (fr - 14)) * DFF + col0;
                    *(u32x4*)(GL + so) = (u32x4){cvt_pk_bf16(g0[0], g0[1]), cvt_pk_bf16(g0[2], g0[3]), cvt_pk_bf16(g1v[0], g1v[1]), cvt_pk_bf16(g1v[2], g1v[3])}; }
                float* sp = nullptr;
                if (row < TP) { const int t = row & 4095; if (t >= 4094) sp = ffn_p + ((size_t)(row >> 12) * 2 + (t - 4094)) * DFF + col0; }
                else { const int rr = row - TP, t = rr & 31; if (t >= 30) sp = ffn_s + ((size_t)(rr >> 5) * 2 + (t - 30)) * DFF + col0; }
                if (sp) { *(f32x4*)sp = g0; *(f32x4*)(sp + 4) = g1v; } }
        }
    }
};
struct EpiGlu {
    static constexpr bool PERM = true;
    bf16_t* O; int ldc;
    __device__ __forceinline__ void operator()(const f32x4 (&acc)[2][2][4][2], const Unit& u, int wr, int wc, int fr, int fq) const {
        const int row0 = u.pm * BM + wr * 64 + fr, col0 = u.pn * HALF + wc * 32 + 8 * fq;
#pragma unroll
        for (int ai = 0; ai < 2; ++ai)
#pragma unroll
            for (int m = 0; m < 4; ++m) { const int row = row0 + ai * HALF + m * 16;
                f32x4 a0 = acc[ai][0][m][0], a1 = acc[ai][0][m][1]; const f32x4 b0 = acc[ai][1][m][0], b1 = acc[ai][1][m][1];
#pragma unroll
                for (int j = 0; j < 4; ++j) { a0[j] *= sigmoidf(b0[j]); a1[j] *= sigmoidf(b1[j]); }
                u32x4 w; w.x = cvt_pk_bf16(a0[0], a0[1]); w.y = cvt_pk_bf16(a0[2], a0[3]); w.z = cvt_pk_bf16(a1[0], a1[1]); w.w = cvt_pk_bf16(a1[2], a1[3]);
                *(u32x4*)(O + (size_t)row * ldc + col0) = w; }
    }
};

template <class Epi, class Sched>
__device__ __forceinline__ void gemm_phase(LAS unsigned char* lds, const Gemm g, const Sched& S, const Epi& E) {
    const int tid = threadIdx.x, wid = __builtin_amdgcn_readfirstlane(tid >> 6), lane = tid & 63, wr = wid >> 2, wc = wid & 3, fr = lane & 15, fq = lane >> 4;
    const int K = g.K, nt = K / BK;
    unsigned voffA[2], voffB[2];
#pragma unroll
    for (int i = 0; i < 2; ++i) { int R, C; stage_rc(tid * 16 + i * 8192, R, C); const int Rb = Epi::PERM ? ((R & ~31) + perm32(R & 31)) : R;
        voffA[i] = (unsigned)(R * g.lda + C) * 2u; voffB[i] = (unsigned)(Rb * g.ldb + C) * 2u; }
    const size_t kstep = (size_t)(BK * 2);
    const size_t hstepA = (size_t)HALF * g.lda * 2, hstepB = (size_t)HALF * g.ldb * 2;
    const size_t tstepA = 2 * hstepA, tstepB = 2 * hstepB;
    const size_t pnoff = (size_t)g.a_pn_off * 2, ksb = (size_t)g.K * 2;
    const unsigned ldsw = (unsigned)wid * 1024u;
    const int aoff = lds_byte(wr * 64 + fr, fq * 8), boff = lds_byte(wc * 32 + fr, fq * 8);
#define PG8_SA(b, h) (((b) * 2 + (h)) * HTB)
#define PG8_SB(b, h) ((4 + (b) * 2 + (h)) * HTB)
#define PG8_STAGE(bufoff, gbase, voff) do { _Pragma("unroll") for (int _i = 0; _i < 2; ++_i) \
        __builtin_amdgcn_global_load_lds((const unsigned*)((const char*)(gbase) + (voff)[_i]), (LAS unsigned*)(lds + (bufoff) + ldsw + _i * 8192), 16, 0, 0); } while (0)
#define PG8_LDA(dst, b, h) do { _Pragma("unroll") for (int m = 0; m < 4; ++m) _Pragma("unroll") for (int k = 0; k < 2; ++k) dst[m][k] = *(const LAS bf16x8*)(lds + PG8_SA(b, h) + aoff + m * 2048 + k * 1024); } while (0)
#define PG8_LDB(dst, b, h) do { _Pragma("unroll") for (int n = 0; n < 2; ++n) _Pragma("unroll") for (int k = 0; k < 2; ++k) dst[n][k] = *(const LAS bf16x8*)(lds + PG8_SB(b, h) + boff + n * 2048 + k * 1024); } while (0)
#define PG8_MMA(ai, bj, At, Bt) do { __builtin_amdgcn_s_setprio(1); _Pragma("unroll") for (int m = 0; m < 4; ++m) _Pragma("unroll") for (int n = 0; n < 2; ++n) _Pragma("unroll") for (int k = 0; k < 2; ++k) \
        acc[ai][bj][m][n] = __builtin_amdgcn_mfma_f32_16x16x32_bf16(Bt[n][k], At[m][k], acc[ai][bj][m][n], 0, 0, 0); __builtin_amdgcn_s_setprio(0); } while (0)
#define PG8_WAIT_V(n) asm volatile("s_waitcnt vmcnt(" #n ")" ::: "memory")
#define PG8_WAIT_L(n) asm volatile("s_waitcnt lgkmcnt(" #n ")" ::: "memory")
#define PG8_BAR __builtin_amdgcn_s_barrier()
#define PG8_SCHED __builtin_amdgcn_sched_barrier(0)
    Unit cur, nxt; int ui = 0;
    if (!S.next(0, cur)) return;
    f32x4 acc[2][2][4][2];
#pragma unroll
    for (int a = 0; a < 2; ++a)
#pragma unroll
        for (int b = 0; b < 2; ++b)
#pragma unroll
            for (int m = 0; m < 4; ++m)
#pragma unroll
                for (int n = 0; n < 2; ++n) acc[a][b][m][n] = (f32x4){0.f, 0.f, 0.f, 0.f};
    bf16x8 At[4][2], B0[2][2], B1[2][2];
    const char* cA = (const char*)g.A + (size_t)cur.pm * tstepA + (size_t)cur.pn * pnoff + (size_t)cur.ks * ksb; const char* cB = (const char*)g.Bt + (size_t)cur.pn * tstepB + (size_t)cur.ks * ksb;
    PG8_STAGE(PG8_SB(0, 0), cB, voffB); PG8_STAGE(PG8_SA(0, 0), cA, voffA); PG8_STAGE(PG8_SB(0, 1), cB + hstepB, voffB); PG8_STAGE(PG8_SA(0, 1), cA + hstepA, voffA);
    if (wr == 1) PG8_BAR;
    PG8_WAIT_V(4); PG8_BAR;
    PG8_STAGE(PG8_SB(1, 0), cB + kstep, voffB); PG8_STAGE(PG8_SA(1, 0), cA + kstep, voffA); PG8_STAGE(PG8_SB(1, 1), cB + hstepB + kstep, voffB);
    PG8_WAIT_V(6); PG8_BAR;
    for (;;) {
        const bool has_next = S.next(ui + 1, nxt);
        const char* nA = has_next ? (const char*)g.A + (size_t)nxt.pm * tstepA + (size_t)nxt.pn * pnoff + (size_t)nxt.ks * ksb : cA; const char* nB = has_next ? (const char*)g.Bt + (size_t)nxt.pn * tstepB + (size_t)nxt.ks * ksb : cB;
        for (int t = 0; t < nt; t += 2) {
            const bool last = (t == nt - 2);
            const char* a1 = cA + (size_t)(t + 1) * kstep;
            const char* a2 = last ? nA : cA + (size_t)(t + 2) * kstep; const char* b2 = last ? nB : cB + (size_t)(t + 2) * kstep;
            const char* a3 = a2 + kstep; const char* b3 = b2 + kstep;
            PG8_LDB(B0, 0, 0); PG8_SCHED; PG8_LDA(At, 0, 0); PG8_STAGE(PG8_SA(1, 1), a1 + hstepA, voffA);
            PG8_WAIT_L(8); PG8_BAR; PG8_WAIT_L(0); PG8_MMA(0, 0, At, B0); PG8_BAR; PG8_SCHED;
            PG8_LDB(B1, 0, 1); PG8_STAGE(PG8_SB(0, 0), b2, voffB);
            PG8_BAR; PG8_WAIT_L(0); PG8_MMA(0, 1, At, B1); PG8_BAR;
            PG8_LDA(At, 0, 1); PG8_STAGE(PG8_SA(0, 0), a2, voffA);
            PG8_BAR; PG8_WAIT_L(0); PG8_MMA(1, 0, At, B0); PG8_BAR; PG8_SCHED;
            PG8_STAGE(PG8_SB(0, 1), b2 + hstepB, voffB);
            PG8_WAIT_V(6); PG8_BAR; PG8_MMA(1, 1, At, B1); PG8_BAR;
            PG8_LDB(B0, 1, 0); PG8_SCHED; PG8_LDA(At, 1, 0); PG8_STAGE(PG8_SA(0, 1), a2 + hstepA, voffA);
            PG8_WAIT_L(8); PG8_BAR; PG8_WAIT_L(0); PG8_MMA(0, 0, At, B0); PG8_BAR; PG8_SCHED;
            PG8_LDB(B1, 1, 1); PG8_STAGE(PG8_SB(1, 0), b3, voffB);
            PG8_BAR; PG8_WAIT_L(0); PG8_MMA(0, 1, At, B1); PG8_BAR;
            PG8_LDA(At, 1, 1); PG8_STAGE(PG8_SA(1, 0), a3, voffA);
            PG8_BAR; PG8_WAIT_L(0); PG8_MMA(1, 0, At, B0); PG8_BAR; PG8_SCHED;
            PG8_STAGE(PG8_SB(1, 1), b3 + hstepB, voffB);
            PG8_WAIT_V(6); PG8_BAR; PG8_MMA(1, 1, At, B1); PG8_BAR;
        }
        E(acc, cur, wr, wc, fr, fq);
        if (!has_next) break;
#pragma unroll
        for (int a = 0; a < 2; ++a)
#pragma unroll
            for (int b = 0; b < 2; ++b)
#pragma unroll
                for (int m = 0; m < 4; ++m)
#pragma unroll
                    for (int n = 0; n < 2; ++n) acc[a][b][m][n] = (f32x4){0.f, 0.f, 0.f, 0.f};
        cur = nxt; cA = nA; cB = nB; ++ui;
    }
    PG8_WAIT_V(0);
    if (wr == 0) PG8_BAR;
    PG8_BAR;
#undef PG8_SA
#undef PG8_SB
#undef PG8_STAGE
#undef PG8_LDA
#undef PG8_LDB
#undef PG8_MMA
#undef PG8_WAIT_V
#undef PG8_WAIT_L
#undef PG8_BAR
#undef PG8_SCHED
}
}

template <class Epi>
__device__ __forceinline__ void run_gemm(LAS unsigned char* lds, const bf16_t* A, const bf16_t* Bt, int N, int K, int lda, int ldb, int a_pn_off, const Epi& E, int vb, int M = T, int cshift = 0) {
    pg8::Gemm g; g.A = A; g.Bt = Bt; g.M = M; g.N = N; g.K = K; g.lda = lda; g.ldb = ldb; g.a_pn_off = a_pn_off;
    int c = vb - cshift; if (c < 0) c += (int)gridDim.x;
    pg8::StaticOrder S; S.init(M, N, (int)gridDim.x, c);
    pg8::gemm_phase<Epi, pg8::StaticOrder>(lds, g, S, E);
}
__device__ __forceinline__ void run_gemm_split(LAS unsigned char* lds, const bf16_t* A, const bf16_t* Bt, int K, int ld, int S, bf16_t* slabs, int vb) {
    pg8::Gemm g; g.A = A + (size_t)TP * ld; g.Bt = Bt; g.M = 1024; g.N = DM; g.K = K / S; g.lda = ld; g.ldb = ld; g.a_pn_off = 0;
    pg8::SplitOrder O; O.init(8, S, (int)gridDim.x, vb);
    pg8::EpiBf16<1> E; E.O = slabs; E.ldc = DM; E.gelu_tiles = 0; E.scale = nullptr; E.slab = (size_t)1024 * DM;
    pg8::gemm_phase<pg8::EpiBf16<1>, pg8::SplitOrder>(lds, g, O, E);
}

__device__ __forceinline__ void get_job(const Params& p, int j, const float*& src, bf16_t*& dst, int& K, int& N, int& ld, int& half, const float*& nscale) {
    unsigned char* ws = p.ws; half = 0; nscale = nullptr;
    switch (j) {
        case 0: src = p.in[11]; dst = (bf16_t*)(ws + OFF_WIN_E); K = DM; N = NE; ld = NE_SRC; break;
        case 1: src = p.in[18]; dst = (bf16_t*)(ws + OFF_WOUT_E); K = DM; N = DM; ld = DM; break;
        case 2: src = p.in[32]; dst = (bf16_t*)(ws + OFF_WUP0); K = DM; N = 2 * DFF; ld = 2 * DFF; half = DFF; break;
        case 3: src = p.in[32] + (size_t)DM * 2 * DFF; dst = (bf16_t*)(ws + OFF_WUP1); K = DM; N = 2 * DFF; ld = 2 * DFF; half = DFF; break;
        case 4: src = p.in[35]; dst = (bf16_t*)(ws + OFF_WDN0); K = DFF; N = DM; ld = DM; break;
        case 5: src = p.in[35] + (size_t)DFF * DM; dst = (bf16_t*)(ws + OFF_WDN1); K = DFF; N = DM; ld = DM; break;
        case 6: src = p.in[19]; dst = (bf16_t*)(ws + OFF_WIN_O); K = DM; N = DM; ld = DM; break;
        case 7: case 8: case 9: case 10: src = p.in[20] + (size_t)(j - 7) * 65536; dst = (bf16_t*)(ws + OFF_CMAP) + (size_t)(j - 7) * 256 * CLD; K = 256; N = 256; ld = 256; nscale = p.in[21] + (j - 7) * 256; break;
        case 11: src = p.in[30]; dst = (bf16_t*)(ws + OFF_WGLU); K = 1024; N = 2048; ld = 2048; half = 1024; break;
        default: src = p.in[31]; dst = (bf16_t*)(ws + OFF_WOUT_O); K = DM; N = DM; ld = DM; break;
    }
}
struct TileInfo { const float* src; bf16_t* dst; const float* nscale; int K, ld, half, k0, n0; };
__device__ __forceinline__ void prep_decode(const Params& p, int tile, TileInfo& ti) {
    int j, t0;
    if (tile < 640) { j = 0; t0 = 0; } else if (tile < 896) { j = 1; t0 = 640; } else if (tile < 2304) { j = 2; t0 = 896; } else if (tile < 3712) { j = 3; t0 = 2304; }
    else if (tile < 4416) { j = 4; t0 = 3712; } else if (tile < 5120) { j = 5; t0 = 4416; } else if (tile < 5376) { j = 6; t0 = 5120; }
    else if (tile < 5392) { j = 7 + ((tile - 5376) >> 2); t0 = 5376 + ((tile - 5376) & ~3); } else if (tile < 5520) { j = 11; t0 = 5392; } else { j = 12; t0 = 5520; }
    int N; get_job(p, j, ti.src, ti.dst, ti.K, N, ti.ld, ti.half, ti.nscale);
    const int local = tile - t0, ntn = N >> 8, tk = local / ntn, tn = local - tk * ntn; ti.k0 = tk * 64; ti.n0 = tn * 256;
}
constexpr int NL0 = 2048, NL1 = 336, NL2 = 1456, NL3 = 640, NL4 = 592, NL5 = 704;
__device__ __forceinline__ int list_tile(int list, int q) {
    switch (list) {
        case 0: return q < 640 ? q : 896 + (q - 640);
        case 1: return q < 256 ? 640 + q : 3712 + (q - 256);
        case 2: return q < 624 ? 3792 + q : (q < 1280 ? 5120 + (q - 624) : 2304 + (q - 1280));
        case 3: return 2480 + q;
        case 4: return 3120 + q;
        default: return 4416 + q;
    }
}
template <int LIST>
__device__ __forceinline__ void prep_run(const Params& p, LAS unsigned char* lds, int q0, int qs, int qend) {
    const int tid = threadIdx.x, wid = tid >> 6, lane = tid & 63;
    constexpr int TROW = 144;
    int it = 0, q = q0;
    TileInfo cur; f32x4 v[8];
    if (q < qend) { prep_decode(p, list_tile(LIST, q), cur);
#pragma unroll
        for (int i = 0; i < 8; ++i) v[i] = *(const f32x4*)(cur.src + (size_t)(cur.k0 + wid * 8 + i) * cur.ld + cur.n0 + lane * 4); }
    while (q < qend) {
        LAS unsigned char* buf = lds + (it & 1) * (256 * TROW);
        if (cur.nscale) { const f32x4 sc = *(const f32x4*)(cur.nscale + cur.n0 + lane * 4);
#pragma unroll
            for (int i = 0; i < 8; ++i) v[i] = v[i] * sc; }
#pragma unroll
        for (int e = 0; e < 4; ++e) { u32x4 w; w.x = cvt_pk_bf16(v[0][e], v[1][e]); w.y = cvt_pk_bf16(v[2][e], v[3][e]); w.z = cvt_pk_bf16(v[4][e], v[5][e]); w.w = cvt_pk_bf16(v[6][e], v[7][e]);
            *(LAS u32x4*)(buf + (lane * 4 + e) * TROW + wid * 16) = w; }
        const int nq = q + qs; TileInfo nxt = cur;
        if (nq < qend) { prep_decode(p, list_tile(LIST, nq), nxt);
#pragma unroll
            for (int i = 0; i < 8; ++i) v[i] = *(const f32x4*)(nxt.src + (size_t)(nxt.k0 + wid * 8 + i) * nxt.ld + nxt.n0 + lane * 4); }
        __syncthreads();
#pragma unroll
        for (int i = 0; i < 4; ++i) { const int n = i * 64 + (tid >> 3), kq = (tid & 7) * 8; const int ns = cur.n0 + n;
            int drow = ns; if (cur.half) { const int which = ns >= cur.half ? 1 : 0, nn = ns - which * cur.half; drow = (nn >> 7) * 256 + which * 128 + (nn & 127); }
            *(u32x4*)(cur.dst + (size_t)drow * (cur.K + PADK) + cur.k0 + kq) = *(const LAS u32x4*)(buf + n * TROW + kq * 2); }
        cur = nxt; q = nq; ++it;
    }
    __syncthreads();
}
__device__ __forceinline__ void phase_prep(const Params& p, LAS unsigned char* lds) {
    const int tid = threadIdx.x, wid = tid >> 6, lane = tid & 63;
    prep_run<0>(p, lds, (int)blockIdx.x, (int)gridDim.x, NL0);
    if (gridDim.x != 256) {
        prep_run<1>(p, lds, (int)blockIdx.x, (int)gridDim.x, NL1); prep_run<2>(p, lds, (int)blockIdx.x, (int)gridDim.x, NL2); prep_run<3>(p, lds, (int)blockIdx.x, (int)gridDim.x, NL3);
        prep_run<4>(p, lds, (int)blockIdx.x, (int)gridDim.x, NL4); prep_run<5>(p, lds, (int)blockIdx.x, (int)gridDim.x, NL5); }
    const int gtid = blockIdx.x * 512 + tid, gstride = gridDim.x * 512;
    { bf16_t* wg = (bf16_t*)(p.ws + OFF_WG);
      for (int i = gtid; i < DM * 16; i += gstride) { const int k = i >> 4, r = i & 15; wg[r * DM + k] = (bf16_t)(cvt_pk_bf16(p.in[11][(size_t)k * NE_SRC + NE + r], 0.f) & 0xffffu); } }
    { bf16_t* wsm = (bf16_t*)(p.ws + OFF_WSM);
      for (int i = gtid; i < 8 * 128 * 128; i += gstride) { const int jj = i & 127, ii = (i >> 7) & 127; const float w = ((jj >> 6) <= (ii >> 6)) ? p.in[12][i] : 0.f; wsm[i] = (bf16_t)(cvt_pk_bf16(w, 0.f) & 0xffffu); } }
    { bf16_t* h = (bf16_t*)(p.ws + OFF_H); const float* g = p.in[7];
      for (int row = blockIdx.x * 8 + wid; row < T; row += gridDim.x * 8) {
          const float* x = xrow_in(p, row); f32x4 v[8]; float ss = 0.f;
#pragma unroll
          for (int q = 0; q < 4; ++q) { v[2 * q] = *(const f32x4*)(x + q * 512 + lane * 8); v[2 * q + 1] = *(const f32x4*)(x + q * 512 + lane * 8 + 4); }
#pragma unroll
          for (int q = 0; q < 8; ++q) ss += v[q][0] * v[q][0] + v[q][1] * v[q][1] + v[q][2] * v[q][2] + v[q][3] * v[q][3];
          ss = wave_sum(ss); const float rstd = rsqrtf(ss * (1.0f / DM) + EPS);
#pragma unroll
          for (int q = 0; q < 4; ++q) { const f32x4 ga = *(const f32x4*)(g + q * 512 + lane * 8), gb = *(const f32x4*)(g + q * 512 + lane * 8 + 4); const f32x4 a = v[2 * q] * rstd * ga, c = v[2 * q + 1] * rstd * gb;
              *(u32x4*)(h + (size_t)row * HLD + q * 512 + lane * 8) = (u32x4){cvt_pk_bf16(a[0], a[1]), cvt_pk_bf16(a[2], a[3]), cvt_pk_bf16(c[0], c[1]), cvt_pk_bf16(c[2], c[3])}; }
      } }
}

__device__ __forceinline__ void phase_norm(const Params& p, bool x_from_input, float* xout_f32, const float* g_post, const float* g_pre, const bf16_t* slabs, int nslab) {
    const int tid = threadIdx.x, wid = tid >> 6, lane = tid & 63;
    const bf16_t* m = (const bf16_t*)(p.ws + OFF_M); bf16_t* xa = (bf16_t*)(p.ws + OFF_XA); bf16_t* h = (bf16_t*)(p.ws + OFF_H);
    for (int row = blockIdx.x * 8 + wid; row < T; row += gridDim.x * 8) {
        float mv[4][8], xv[4][8]; float ss = 0.f;
        if (x_from_input) { const float* x = xrow_in(p, row);
#pragma unroll
            for (int q = 0; q < 4; ++q) { const f32x4 a = *(const f32x4*)(x + q * 512 + lane * 8), c = *(const f32x4*)(x + q * 512 + lane * 8 + 4);
#pragma unroll
                for (int e = 0; e < 4; ++e) { xv[q][e] = a[e]; xv[q][4 + e] = c[e]; } }
        } else { const bf16_t* x = xa + (size_t)row * DM;
#pragma unroll
            for (int q = 0; q < 4; ++q) { const u32x4 w = *(const u32x4*)(x + q * 512 + lane * 8);
#pragma unroll
                for (int e = 0; e < 4; ++e) { xv[q][2 * e] = bf_lo(w[e]); xv[q][2 * e + 1] = bf_hi(w[e]); } } }
        if (row < TP) { const bf16_t* mr = m + (size_t)row * DM;
#pragma unroll
            for (int q = 0; q < 4; ++q) { const u32x4 w = *(const u32x4*)(mr + q * 512 + lane * 8);
#pragma unroll
                for (int e = 0; e < 4; ++e) { mv[q][2 * e] = bf_lo(w[e]); mv[q][2 * e + 1] = bf_hi(w[e]); } }
        } else { const bf16_t* sr = slabs + (size_t)(row - TP) * DM;
#pragma unroll
            for (int q = 0; q < 4; ++q)
#pragma unroll
                for (int e = 0; e < 8; ++e) mv[q][e] = 0.f;
#pragma unroll 4
            for (int k = 0; k < nslab; ++k) {
#pragma unroll
                for (int q = 0; q < 4; ++q) { const u32x4 w = *(const u32x4*)(sr + (size_t)k * 1024 * DM + q * 512 + lane * 8);
#pragma unroll
                    for (int e = 0; e < 4; ++e) { mv[q][2 * e] += bf_lo(w[e]); mv[q][2 * e + 1] += bf_hi(w[e]); } } } }
#pragma unroll
        for (int q = 0; q < 4; ++q)
#pragma unroll
            for (int e = 0; e < 8; ++e) ss += mv[q][e] * mv[q][e];
        ss = wave_sum(ss); const float rstd = rsqrtf(ss * (1.0f / DM) + EPS); float s2 = 0.f;
#pragma unroll
        for (int q = 0; q < 4; ++q) { const f32x4 ga = *(const f32x4*)(g_post + q * 512 + lane * 8), gb = *(const f32x4*)(g_post + q * 512 + lane * 8 + 4);
#pragma unroll
            for (int e = 0; e < 8; ++e) { xv[q][e] += mv[q][e] * rstd * (e < 4 ? ga[e & 3] : gb[e & 3]); s2 += xv[q][e] * xv[q][e]; }
            if (xout_f32) { float* o = xout_f32 + (size_t)row * DM + q * 512 + lane * 8; *(f32x4*)o = (f32x4){xv[q][0], xv[q][1], xv[q][2], xv[q][3]}; *(f32x4*)(o + 4) = (f32x4){xv[q][4], xv[q][5], xv[q][6], xv[q][7]}; }
            else *(u32x4*)(xa + (size_t)row * DM + q * 512 + lane * 8) = (u32x4){cvt_pk_bf16(xv[q][0], xv[q][1]), cvt_pk_bf16(xv[q][2], xv[q][3]), cvt_pk_bf16(xv[q][4], xv[q][5]), cvt_pk_bf16(xv[q][6], xv[q][7])}; }
        if (g_pre) { s2 = wave_sum(s2); const float r2 = rsqrtf(s2 * (1.0f / DM) + EPS);
#pragma unroll
            for (int q = 0; q < 4; ++q) { const f32x4 ga = *(const f32x4*)(g_pre + q * 512 + lane * 8), gb = *(const f32x4*)(g_pre + q * 512 + lane * 8 + 4); float o[8];
#pragma unroll
                for (int e = 0; e < 8; ++e) o[e] = xv[q][e] * r2 * (e < 4 ? ga[e & 3] : gb[e & 3]);
                *(u32x4*)(h + (size_t)row * HLD + q * 512 + lane * 8) = (u32x4){cvt_pk_bf16(o[0], o[1]), cvt_pk_bf16(o[2], o[3]), cvt_pk_bf16(o[4], o[5]), cvt_pk_bf16(o[6], o[7])}; } }
    }
}

__device__ __forceinline__ void phase_glr(const Params& p, int vb) {
    const int tid = threadIdx.x, wid = tid >> 6, lane = tid & 63, fr = lane & 15, fq = lane >> 4;
    const bf16_t* h = (const bf16_t*)(p.ws + OFF_H); const bf16_t* wg = (const bf16_t*)(p.ws + OFF_WG); float* glr = (float*)(p.ws + OFF_GLR);
    for (int grp = ((int)gridDim.x - 1 - vb) * 8 + wid; grp < T / 16; grp += (int)gridDim.x * 8) {
        f32x4 acc = (f32x4){0.f, 0.f, 0.f, 0.f};
        const bf16_t* ap = h + (size_t)(grp * 16 + fr) * HLD + fq * 8; const bf16_t* bp = wg + (size_t)fr * DM + fq * 8;
#pragma unroll 8
        for (int ks = 0; ks < DM / 32; ++ks) { const bf16x8 a = *(const bf16x8*)(ap + ks * 32), b = *(const bf16x8*)(bp + ks * 32); acc = __builtin_amdgcn_mfma_f32_16x16x32_bf16(a, b, acc, 0, 0, 0); }
#pragma unroll
        for (int j = 0; j < 4; ++j) glr[(size_t)(grp * 16 + fq * 4 + j) * 16 + fr] = acc[j];
    }
}

template <int L>
__device__ __forceinline__ void amix_item(const Params& p, LAS unsigned char* lds, int item) {
    const int tid = threadIdx.x, wid = tid >> 6, lane = tid & 63;
    const bf16_t* proj = (const bf16_t*)(p.ws + OFF_PROJ); bf16_t* mix = (bf16_t*)(p.ws + OFF_MIX); const bf16_t* wsm = (const bf16_t*)(p.ws + OFF_WSM);
    const int tb = item >> 2, hp = item & 3; constexpr bool smp = (L == 32); const int row0 = smp ? TP + (tb - 64) * 32 : tb * 128;
    constexpr int VROW = 272;
    LAS float* stats = (LAS float*)(lds + 256 * VROW);
    for (int l0 = wid * 4; l0 < L; l0 += 32) {
        u32x4 a[4], b[4];
#pragma unroll
        for (int r4 = 0; r4 < 4; ++r4) { const bf16_t* r = proj + (size_t)(row0 + l0 + r4) * NE + 1024; a[r4] = *(const u32x4*)(r + lane * 8); b[r4] = *(const u32x4*)(r + 512 + lane * 8); }
#pragma unroll
        for (int r4 = 0; r4 < 4; ++r4) { float s = 0.f, q = 0.f;
#pragma unroll
            for (int e = 0; e < 4; ++e) { const float a0 = bf_lo(a[r4][e]), a1 = bf_hi(a[r4][e]), b0 = bf_lo(b[r4][e]), b1 = bf_hi(b[r4][e]); s += (a0 + a1) + (b0 + b1); q += (a0 * a0 + a1 * a1) + (b0 * b0 + b1 * b1); }
            s = wave_sum(s); q = wave_sum(q); const float mean = s * (1.0f / 1024.f), var = fmaxf(q * (1.0f / 1024.f) - mean * mean, 0.f);
            if (lane == 0) { stats[(l0 + r4) * 2] = mean; stats[(l0 + r4) * 2 + 1] = rsqrtf(var + EPS); } }
    }
    __syncthreads();
    const int c0 = hp * 256; const float* gain = p.in[14];
    for (int wi0 = tid; wi0 < L * 32; wi0 += 2048) {
        u32x4 av4[4];
#pragma unroll
        for (int u4 = 0; u4 < 4; ++u4) { const int wi = wi0 + u4 * 512; if (wi < L * 32) { const int j = wi % L, cg8 = wi / L; av4[u4] = *(const u32x4*)(proj + (size_t)(row0 + j) * NE + 1024 + c0 + cg8 * 8); } }
#pragma unroll
        for (int u4 = 0; u4 < 4; ++u4) { const int wi = wi0 + u4 * 512; if (wi < L * 32) { const int j = wi % L, cg8 = wi / L;
            const u32x4 a = av4[u4]; const float mean = stats[j * 2], rstd = stats[j * 2 + 1];
            const f32x4 g0 = *(const f32x4*)(gain + c0 + cg8 * 8), g1 = *(const f32x4*)(gain + c0 + cg8 * 8 + 4); float o[8];
#pragma unroll
            for (int e = 0; e < 4; ++e) { o[2 * e] = (bf_lo(a[e]) - mean) * rstd * (e < 2 ? g0[2 * e] : g1[2 * e - 4]); o[2 * e + 1] = (bf_hi(a[e]) - mean) * rstd * (e < 2 ? g0[2 * e + 1] : g1[2 * e - 3]); }
#pragma unroll
            for (int e = 0; e < 8; ++e) *(LAS bf16_t*)(lds + (cg8 * 8 + e) * VROW + j * 2) = (bf16_t)(cvt_pk_bf16(o[e], 0.f) & 0xffffu);
            if (smp) { float* av = p.out + O_AV + (size_t)(row0 - TP + j) * 1024 + c0 + cg8 * 8; *(f32x4*)av = (f32x4){o[0], o[1], o[2], o[3]}; *(f32x4*)(av + 4) = (f32x4){o[4], o[5], o[6], o[7]}; } } }
    }
    __syncthreads();
    const int hh = wid >> 2, dq = wid & 3, head = hp * 2 + hh, l31 = lane & 31, lh = lane >> 5;
    constexpr int nit = L >> 5, nks = L >> 4;
    f32x16 acc[4];
#pragma unroll
    for (int i = 0; i < 4; ++i)
#pragma unroll
        for (int r = 0; r < 16; ++r) acc[i][r] = 0.f;
    const LAS unsigned char* ap = lds + (hh * 128 + dq * 32 + l31) * VROW + lh * 16;
    const bf16_t* bp = wsm + (size_t)head * 16384 + (size_t)l31 * 128 + lh * 8;
    bf16x8 bq[4], bn[4];
#pragma unroll
    for (int i = 0; i < 4; ++i) { bq[i] = (bf16x8){0, 0, 0, 0, 0, 0, 0, 0}; if (i < nit) bq[i] = *(const bf16x8*)(bp + (size_t)i * 32 * 128); }
#pragma unroll
    for (int ks = 0; ks < nks; ++ks) {
        const bf16x8 a = *(const LAS bf16x8*)(ap + ks * 32);
#pragma unroll
        for (int i = 0; i < 4; ++i) { bn[i] = bq[i]; if (i < nit && ks + 1 < nks) bn[i] = *(const bf16x8*)(bp + (size_t)i * 32 * 128 + (ks + 1) * 16); }
#pragma unroll
        for (int i = 0; i < 4; ++i) if (i < nit) acc[i] = __builtin_amdgcn_mfma_f32_32x32x16_bf16(a, bq[i], acc[i], 0, 0, 0);
#pragma unroll
        for (int i = 0; i < 4; ++i) bq[i] = bn[i];
    }
    const float* bs = p.in[13] + head * 128;
#pragma unroll
    for (int i = 0; i < 4; ++i) if (i < nit) { const int ii = i * 32 + l31, row = row0 + ii; const float bias = bs[ii];
#pragma unroll
        for (int rg = 0; rg < 4; ++rg) { const int d = dq * 32 + rg * 8 + lh * 4, c = head * 128 + d; const u32x2 uu = *(const u32x2*)(proj + (size_t)row * NE + c);
            u32x2 w; w.x = cvt_pk_bf16(bf_lo(uu.x) * (acc[i][rg * 4] + bias), bf_hi(uu.x) * (acc[i][rg * 4 + 1] + bias)); w.y = cvt_pk_bf16(bf_lo(uu.y) * (acc[i][rg * 4 + 2] + bias), bf_hi(uu.y) * (acc[i][rg * 4 + 3] + bias));
            *(u32x2*)(mix + (size_t)row * HLD + c) = w; } }
    __syncthreads();
}

__device__ __forceinline__ void gla_item_decode(int it, int& s, int& h, int& row0, int& L) {
    if (it < 512) { s = it >> 8; h = (it >> 6) & 3; row0 = s * 4096 + (it & 63) * 64; L = 64; } else { const int q = it - 512; s = q >> 2; h = q & 3; row0 = TP + s * 32; L = 32; }
}
template <int L>
__device__ __forceinline__ void glau_item(const Params& p, LAS unsigned char* lds, int it) {
    const int tid = threadIdx.x, wid = tid >> 6, lane = tid & 63;
    const bf16_t* proj = (const bf16_t*)(p.ws + OFF_PROJ); const float* glr = (const float*)(p.ws + OFF_GLR);
    int s, h, row0, Lrt; gla_item_decode(it, s, h, row0, Lrt); constexpr bool smp = (L == 32);
    constexpr int KROW = 144;
    LAS unsigned char* kdT = lds;
    LAS unsigned char* vT = lds + 128 * KROW;
    LAS float* glt = (LAS float*)(lds + 384 * KROW);
    LAS float* part = glt + 64 * 16;
    LAS float* totl = part + 4 * 128;
    if (tid < L * 4) *(LAS f32x4*)(glt + tid * 4) = *(const f32x4*)(glr + (size_t)row0 * 16 + tid * 4);
    __syncthreads();
    const int d = tid & 127, lq = tid >> 7; constexpr int Lq = L >> 2;
    float wg[16];
#pragma unroll
    for (int r = 0; r < 16; ++r) wg[r] = p.in[15][r * 512 + h * 128 + d];
    const float gb = p.in[16][h * 128 + d];
    float cum[16]; float run = 0.f;
#pragma unroll
    for (int i = 0; i < 16; ++i) { cum[i] = 0.f; if (i < Lq) { const int l = lq * Lq + i; float x = gb;
#pragma unroll
            for (int r4 = 0; r4 < 4; ++r4) { const f32x4 gg = *(const LAS f32x4*)(glt + l * 16 + r4 * 4); x += gg[0] * wg[r4 * 4] + gg[1] * wg[r4 * 4 + 1] + gg[2] * wg[r4 * 4 + 2] + gg[3] * wg[r4 * 4 + 3]; }
            const float ls = fminf(x, 0.f) - __logf(1.0f + __expf(-fabsf(x)));
            run += ls * (1.0f / 16.0f); cum[i] = run; } }
    part[lq * 128 + d] = run;
    __syncthreads();
    float offs = 0.f, tot = 0.f;
#pragma unroll
    for (int q = 0; q < 4; ++q) { const float pv = part[q * 128 + d]; tot += pv; if (q < lq) offs += pv; }
    if (lq == 0) { totl[d] = tot; ((float*)(p.ws + OFF_DECAY))[(size_t)it * 128 + d] = __expf(tot); }
    { unsigned pk[8];
#pragma unroll
      for (int i = 0; i < 16; i += 2) { float v0 = 0.f, v1 = 0.f;
          if (i < Lq) { const int l = lq * Lq + i; v0 = bf1(proj[(size_t)(row0 + l) * NE + 2560 + h * 128 + d]) * __expf(tot - offs - cum[i]); v1 = bf1(proj[(size_t)(row0 + l + 1) * NE + 2560 + h * 128 + d]) * __expf(tot - offs - cum[i + 1]); }
          pk[i >> 1] = cvt_pk_bf16(v0, v1); }
      LAS unsigned char* dstp = kdT + d * KROW + lq * Lq * 2;
      *(LAS u32x4*)dstp = (u32x4){pk[0], pk[1], pk[2], pk[3]};
      if (Lq == 16) *(LAS u32x4*)(dstp + 16) = (u32x4){pk[4], pk[5], pk[6], pk[7]}; }
    { const int v = tid & 255, hf = tid >> 8; constexpr int Lh = L >> 1; unsigned pk[16];
#pragma unroll
      for (int i = 0; i < 32; i += 2) { unsigned a = 0, b = 0; if (i < Lh) { const int l = hf * Lh + i; a = proj[(size_t)(row0 + l) * NE + 3072 + h * 256 + v]; b = proj[(size_t)(row0 + l + 1) * NE + 3072 + h * 256 + v]; } pk[i >> 1] = a | (b << 16); }
      LAS unsigned char* dstp = vT + v * KROW + hf * Lh * 2;
      *(LAS u32x4*)dstp = (u32x4){pk[0], pk[1], pk[2], pk[3]}; *(LAS u32x4*)(dstp + 16) = (u32x4){pk[4], pk[5], pk[6], pk[7]};
      if (Lh == 32) { *(LAS u32x4*)(dstp + 32) = (u32x4){pk[8], pk[9], pk[10], pk[11]}; *(LAS u32x4*)(dstp + 48) = (u32x4){pk[12], pk[13], pk[14], pk[15]}; } }
    __syncthreads();
    const int l31 = lane & 31, lh = lane >> 5, vs = wid * 32; constexpr int nks = L >> 4;
    f32x16 acc[4];
#pragma unroll
    for (int i = 0; i < 4; ++i)
#pragma unroll
        for (int r = 0; r < 16; ++r) acc[i][r] = 0.f;
#pragma unroll
    for (int ks = 0; ks < nks; ++ks) { const bf16x8 b = *(const LAS bf16x8*)(vT + (vs + l31) * KROW + ks * 32 + lh * 16);
#pragma unroll
        for (int dt = 0; dt < 4; ++dt) { const bf16x8 a = *(const LAS bf16x8*)(kdT + (dt * 32 + l31) * KROW + ks * 32 + lh * 16); acc[dt] = __builtin_amdgcn_mfma_f32_32x32x16_bf16(a, b, acc[dt], 0, 0, 0); } }
    const int v = vs + l31;
    if (!smp) { float* ut = (float*)(p.ws + OFF_UT) + ((size_t)it * 256 + v) * 128;
#pragma unroll
        for (int dt = 0; dt < 4; ++dt)
#pragma unroll
            for (int rg = 0; rg < 4; ++rg) *(f32x4*)(ut + dt * 32 + rg * 8 + lh * 4) = (f32x4){acc[dt][rg * 4], acc[dt][rg * 4 + 1], acc[dt][rg * 4 + 2], acc[dt][rg * 4 + 3]};
    } else { const float* s0 = p.in[2] + ((size_t)s * 4 + h) * 128 * 256; float* so = p.out + O_GLA_S + ((size_t)s * 4 + h) * 128 * 256; bf16_t* st = (bf16_t*)(p.ws + OFF_ST) + ((size_t)it * 256 + v) * 128;
#pragma unroll
        for (int dt = 0; dt < 4; ++dt)
#pragma unroll
            for (int rg = 0; rg < 4; ++rg) { const int dd = dt * 32 + rg * 8 + lh * 4; float sv[4];
#pragma unroll
                for (int e = 0; e < 4; ++e) { sv[e] = __expf(totl[dd + e]) * s0[(size_t)(dd + e) * 256 + v] + acc[dt][rg * 4 + e]; so[(size_t)(dd + e) * 256 + v] = sv[e]; }
                u32x2 w; w.x = cvt_pk_bf16(sv[0], sv[1]); w.y = cvt_pk_bf16(sv[2], sv[3]); *(u32x2*)(st + dd) = w; } }
    __syncthreads();
}

__device__ __forceinline__ void phase_gla_scan(const Params& p) {
    for (int gtid = blockIdx.x * 512 + threadIdx.x; gtid < 2 * 4 * 256 * 64; gtid += gridDim.x * 512) {
    const int dq = gtid & 63, v = (gtid >> 6) & 255, sh = gtid >> 14;
    const float* ut = (const float*)(p.ws + OFF_UT); const float* dec = (const float*)(p.ws + OFF_DECAY); bf16_t* st = (bf16_t*)(p.ws + OFF_ST);
    f32x2 S = (f32x2){0.f, 0.f};
#pragma unroll 16
    for (int c = 0; c < 64; ++c) { const int it = sh * 64 + c; const f32x2 u = *(const f32x2*)(ut + ((size_t)it * 256 + v) * 128 + dq * 2), dc = *(const f32x2*)(dec + (size_t)it * 128 + dq * 2);
        S = S * dc + u; *(unsigned*)(st + ((size_t)it * 256 + v) * 128 + dq * 2) = cvt_pk_bf16(S[0], S[1]); }
    float* o = p.out + O_GLA_P + (size_t)sh * 128 * 256;
    o[(size_t)(dq * 2) * 256 + v] = S[0]; o[(size_t)(dq * 2 + 1) * 256 + v] = S[1];
    }
}

template <int L>
__device__ __forceinline__ void glao_item(const Params& p, LAS unsigned char* lds, int it) {
    const int tid = threadIdx.x, wid = tid >> 6, lane = tid & 63, l31 = lane & 31, lh = lane >> 5;
    const bf16_t* proj = (const bf16_t*)(p.ws + OFF_PROJ); bf16_t* mix = (bf16_t*)(p.ws + OFF_MIX);
    int s, h, row0, Lrt; gla_item_decode(it, s, h, row0, Lrt);
    constexpr int nlt = L >> 5; const int vs = wid * 32;
    LAS float* red = (LAS float*)lds;
    const bf16_t* ap = (const bf16_t*)(p.ws + OFF_ST) + ((size_t)it * 256 + vs + l31) * 128 + lh * 8;
    const bf16_t* bp = proj + (size_t)(row0 + l31) * NE + 2048 + h * 128 + lh * 8;
    f32x16 acc[2];
#pragma unroll
    for (int i = 0; i < 2; ++i)
#pragma unroll
        for (int r = 0; r < 16; ++r) acc[i][r] = 0.f;
#pragma unroll
    for (int ks = 0; ks < 8; ++ks) { const bf16x8 a = *(const bf16x8*)(ap + ks * 16);
#pragma unroll
        for (int lt = 0; lt < 2; ++lt) if (lt < nlt) { const bf16x8 b = *(const bf16x8*)(bp + (size_t)lt * 32 * NE + ks * 16); acc[lt] = __builtin_amdgcn_mfma_f32_32x32x16_bf16(a, b, acc[lt], 0, 0, 0); } }
    const float qs = 0.08838834764831845f;
#pragma unroll
    for (int lt = 0; lt < 2; ++lt) { float ss = 0.f;
#pragma unroll
        for (int r = 0; r < 16; ++r) { acc[lt][r] *= qs; ss += acc[lt][r] * acc[lt][r]; }
        ss += __shfl_xor(ss, 32);
        if (lh == 0) red[wid * 64 + lt * 32 + l31] = ss; }
    __syncthreads();
    const float* og = p.in[17] + h * 256;
#pragma unroll
    for (int lt = 0; lt < 2; ++lt) if (lt < nlt) { float tot = 0.f;
#pragma unroll
        for (int w = 0; w < 8; ++w) tot += red[w * 64 + lt * 32 + l31];
        const float rstd = rsqrtf(tot * (1.0f / 256.f) + EPS); const int row = row0 + lt * 32 + l31;
#pragma unroll
        for (int rg = 0; rg < 4; ++rg) { const int vv = vs + rg * 8 + lh * 4; const u32x2 rr = *(const u32x2*)(proj + (size_t)row * NE + 4096 + h * 256 + vv); const f32x4 gg = *(const f32x4*)(og + vv);
            const float r0 = bf_lo(rr.x), r1 = bf_hi(rr.x), r2 = bf_lo(rr.y), r3 = bf_hi(rr.y);
            u32x2 w; w.x = cvt_pk_bf16(acc[lt][rg * 4] * rstd * gg[0] * r0 * sigmoidf(r0), acc[lt][rg * 4 + 1] * rstd * gg[1] * r1 * sigmoidf(r1));
            w.y = cvt_pk_bf16(acc[lt][rg * 4 + 2] * rstd * gg[2] * r2 * sigmoidf(r2), acc[lt][rg * 4 + 3] * rstd * gg[3] * r3 * sigmoidf(r3));
            *(u32x2*)(mix + (size_t)row * HLD + 1024 + h * 256 + vv) = w; } }
    __syncthreads();
}

__device__ __forceinline__ void phase_convfix(const Params& p, int layer) {
    bf16_t* ACT = (bf16_t*)(p.ws + OFF_VAL); const bf16_t* GF = (const bf16_t*)(p.ws + OFF_GF); const bf16_t* VF = (const bf16_t*)(p.ws + OFF_VF); const bf16_t* GL = (const bf16_t*)(p.ws + OFF_GL);
    const float* cw = p.in[33] + (size_t)layer * 3 * DFF; const float* cb = p.in[34] + (size_t)layer * DFF; const float* st = p.in[6] + (size_t)layer * 32 * 2 * DFF;
    for (int idx = blockIdx.x * 512 + threadIdx.x; idx < 160 * 704; idx += gridDim.x * 512) {
        const int pr = idx / 704, c = (idx - pr * 704) * 8;
        const int ra = pr < 128 ? pr * 64 : TP + (pr - 128) * 32, hb = ra >> 5;
        float w0[8], w1[8], w2[8], bb[8], h0[8], h1[8], ga[8], gb[8], va[8], vb[8];
#pragma unroll
        for (int e = 0; e < 8; e += 4) { const f32x4 a = *(const f32x4*)(cw + c + e), b = *(const f32x4*)(cw + DFF + c + e), d = *(const f32x4*)(cw + 2 * DFF + c + e), f = *(const f32x4*)(cb + c + e);
#pragma unroll
            for (int j = 0; j < 4; ++j) { w0[e + j] = a[j]; w1[e + j] = b[j]; w2[e + j] = d[j]; bb[e + j] = f[j]; } }
        if (ra >= TP) { const float* sp = st + (size_t)(pr - 128) * 2 * DFF + c;
#pragma unroll
            for (int e = 0; e < 8; e += 4) { const f32x4 a = *(const f32x4*)(sp + e), b = *(const f32x4*)(sp + DFF + e);
#pragma unroll
                for (int j = 0; j < 4; ++j) { h0[e + j] = a[j]; h1[e + j] = b[j]; } } }
        else if ((ra & 4095) == 0) {
#pragma unroll
            for (int e = 0; e < 8; ++e) { h0[e] = 0.f; h1[e] = 0.f; } }
        else { const u32x4 a = *(const u32x4*)(GL + ((size_t)((ra >> 6) - 1) * 2) * DFF + c), b = *(const u32x4*)(GL + ((size_t)((ra >> 6) - 1) * 2 + 1) * DFF + c);
#pragma unroll
            for (int e = 0; e < 4; ++e) { h0[2 * e] = bf_lo(a[e]); h0[2 * e + 1] = bf_hi(a[e]); h1[2 * e] = bf_lo(b[e]); h1[2 * e + 1] = bf_hi(b[e]); } }
        { const u32x4 a = *(const u32x4*)(GF + ((size_t)hb * 2) * DFF + c), b = *(const u32x4*)(GF + ((size_t)hb * 2 + 1) * DFF + c), d = *(const u32x4*)(VF + ((size_t)hb * 2) * DFF + c), f = *(const u32x4*)(VF + ((size_t)hb * 2 + 1) * DFF + c);
#pragma unroll
          for (int e = 0; e < 4; ++e) { ga[2 * e] = bf_lo(a[e]); ga[2 * e + 1] = bf_hi(a[e]); gb[2 * e] = bf_lo(b[e]); gb[2 * e + 1] = bf_hi(b[e]); va[2 * e] = bf_lo(d[e]); va[2 * e + 1] = bf_hi(d[e]); vb[2 * e] = bf_lo(f[e]); vb[2 * e + 1] = bf_hi(f[e]); } }
        float oa[8], ob[8];
#pragma unroll
        for (int e = 0; e < 8; ++e) { oa[e] = gelu_t(bb[e] + w0[e] * h0[e] + w1[e] * h1[e] + w2[e] * ga[e]) * va[e]; ob[e] = gelu_t(bb[e] + w0[e] * h1[e] + w1[e] * ga[e] + w2[e] * gb[e]) * vb[e]; }
        *(u32x4*)(ACT + (size_t)ra * ALD + c) = (u32x4){cvt_pk_bf16(oa[0], oa[1]), cvt_pk_bf16(oa[2], oa[3]), cvt_pk_bf16(oa[4], oa[5]), cvt_pk_bf16(oa[6], oa[7])};
        *(u32x4*)(ACT + (size_t)(ra + 1) * ALD + c) = (u32x4){cvt_pk_bf16(ob[0], ob[1]), cvt_pk_bf16(ob[2], ob[3]), cvt_pk_bf16(ob[4], ob[5]), cvt_pk_bf16(ob[6], ob[7])};
    }
}

template <int W>
__device__ __forceinline__ void pool_item(const Params& p, const float* proj2, bf16_t* delta, int r8, int c) {
    const int row0 = r8 * 8; const bool smp = row0 >= TP;
    const int seq = smp ? (row0 - TP) >> 5 : row0 >> 12, t0 = smp ? (row0 - TP) & 31 : row0 & 4095, rowbase = row0 - t0;
    const float* spool = p.in[3] + (size_t)seq * 15 * 1024 + c;
    f32x4 xs[W + 7];
#pragma unroll
    for (int j = 0; j < W + 7; ++j) { const int t = t0 - (W - 1) + j; const bool hist = smp && t < 0; const bool ok = t >= 0 || hist;
        const float* ptr = hist ? spool + (size_t)(15 + t) * 1024 : proj2 + (size_t)(rowbase + (t >= 0 ? t : 0)) * DM + c;
        const f32x4 v = *(const f32x4*)ptr; xs[j] = ok ? v : (f32x4){0.f, 0.f, 0.f, 0.f}; }
    f32x4 Wd = xs[0];
#pragma unroll
    for (int j = 1; j < W; ++j) Wd = Wd + xs[j];
#pragma unroll
    for (int u = 0; u < 8; ++u) { const int t = t0 + u; const f32x4 x = xs[u + W - 1];
        const float cnt = smp ? (float)W : (float)((t + 1) < W ? (t + 1) : W); const f32x4 dl = Wd * (1.0f / cnt) - x;
        u32x2 o; o.x = cvt_pk_bf16(dl[0], dl[1]); o.y = cvt_pk_bf16(dl[2], dl[3]); *(u32x2*)(delta + (size_t)(row0 + u) * YLD + c) = o;
        if (!smp && t >= 4081) *(f32x4*)(p.out + O_POOL_P + ((size_t)seq * 15 + (t - 4081)) * 1024 + c) = x;
        if (smp && t >= 17) *(f32x4*)(p.out + O_POOL_S + ((size_t)seq * 15 + (t - 17)) * 1024 + c) = x;
        if (u < 7) Wd = Wd + xs[u + W] - xs[u]; }
}
__device__ __forceinline__ void phase_pool(const Params& p) {
    const float* proj2 = (const float*)(p.ws + OFF_PROJ2); bf16_t* delta = (bf16_t*)(p.ws + OFF_DELTA);
    for (int idx = blockIdx.x * 512 + threadIdx.x; idx < (T / 8) * 256; idx += gridDim.x * 512) {
        const int r8 = idx >> 8, c = (idx & 255) * 4, g = c >> 8;
        if (g == 0) pool_item<2>(p, proj2, delta, r8, c); else if (g == 1) pool_item<4>(p, proj2, delta, r8, c);
        else if (g == 2) pool_item<8>(p, proj2, delta, r8, c); else pool_item<16>(p, proj2, delta, r8, c);
    }
}

template <int PASS>
__device__ __forceinline__ void phase_s5(const Params& p, LAS unsigned char* lds, int nitems) {
    const int tid = threadIdx.x, wid = tid >> 6, lane = tid & 63, hcol = lane & 15, q4 = lane >> 4;
    const float* proj2 = (const float*)(p.ws + OFF_PROJ2); float* Eb = (float*)(p.ws + OFF_E); bf16_t* yb = (bf16_t*)(p.ws + OFF_YB);
    LAS float* ut = (LAS float*)lds;
    constexpr int SROW = 272;
    LAS unsigned char* sb = lds + 32768 + wid * 32 * SROW;
    int oct_cur = -1;
    float lbr = 0.f, lbi = 0.f, p64r = 0.f, p64i = 0.f, dsk = 0.f; f32x2 bb[16]; bf16x8 Bc[4];
#pragma unroll
    for (int i = 0; i < 16; ++i) bb[i] = (f32x2){0.f, 0.f};
#pragma unroll
    for (int i = 0; i < 4; ++i) Bc[i] = (bf16x8){0, 0, 0, 0, 0, 0, 0, 0};
    f32x4 un[4];
    auto issue_u = [&](int item) {
        const int cs = item >> 3, oct = item & 7; const bool smp = cs >= 128;
        const int b = smp ? cs - 128 : cs >> 6, ch = smp ? 0 : cs & 63, L = smp ? 32 : 64, row0 = smp ? TP + b * 32 : b * 4096 + ch * 64;
#pragma unroll
        for (int k = 0; k < 4; ++k) { const int i = tid + k * 512; un[k] = (f32x4){0.f, 0.f, 0.f, 0.f}; if (i < L * 32) un[k] = *(const f32x4*)(proj2 + (size_t)(row0 + (i >> 5)) * DM + 1024 + oct * 128 + (i & 31) * 4); }
    };
    if ((int)blockIdx.x < nitems) issue_u((int)blockIdx.x);
    for (int item = blockIdx.x; item < nitems; item += gridDim.x) {
        const int cs = item >> 3, oct = item & 7, g = oct * 8 + wid; const bool smp = cs >= 128;
        const int b = smp ? cs - 128 : cs >> 6, ch = smp ? 0 : cs & 63, L = smp ? 32 : 64, row0 = smp ? TP + b * 32 : b * 4096 + ch * 64;
#pragma unroll
        for (int k = 0; k < 4; ++k) { const int i = tid + k * 512; if (i < L * 32) *(LAS f32x4*)(ut + (i >> 5) * 128 + (i & 31) * 4) = un[k]; }
        if (item + (int)gridDim.x < nitems) issue_u(item + (int)gridDim.x);
        if (oct != oct_cur) {
            oct_cur = oct;
            const float are = p.in[22][g * 64 + lane], aim = p.in[23][g * 64 + lane], dt = __expf(p.in[24][g]);
            const float er = __expf(are * dt); float rev = aim * dt * 0.15915494309189535f; rev -= floorf(rev);
            lbr = er * __builtin_amdgcn_cosf(rev); lbi = er * __builtin_amdgcn_sinf(rev);
            const float den = 1.0f / (are * are + aim * aim); const float nr = lbr - 1.0f, ni = lbi;
            const float cr = (nr * are + ni * aim) * den, ci = (ni * are - nr * aim) * den;
            const float* br = p.in[25] + ((size_t)g * 64 + lane) * 16; const float* bi = p.in[26] + ((size_t)g * 64 + lane) * 16;
#pragma unroll
            for (int q = 0; q < 4; ++q) { const f32x4 x = *(const f32x4*)(br + q * 4), y = *(const f32x4*)(bi + q * 4);
#pragma unroll
                for (int e = 0; e < 4; ++e) bb[q * 4 + e] = (f32x2){cr * x[e] - ci * y[e], cr * y[e] + ci * x[e]}; }
            if (PASS == 2) {
                p64r = lbr; p64i = lbi;
#pragma unroll
                for (int q = 0; q < 6; ++q) { const float t = p64r * p64r - p64i * p64i; p64i = 2.f * p64r * p64i; p64r = t; }
#pragma unroll
                for (int ks = 0; ks < 4; ++ks) { const float* src = (ks < 2 ? p.in[27] : p.in[28]) + ((size_t)g * 16 + hcol) * 64 + (ks & 1) * 32 + q4 * 8; const float sg = ks < 2 ? 1.f : -1.f;
                    const f32x4 x = *(const f32x4*)src, y = *(const f32x4*)(src + 4); u32x4 w; w.x = cvt_pk_bf16(sg * x[0], sg * x[1]); w.y = cvt_pk_bf16(sg * x[2], sg * x[3]); w.z = cvt_pk_bf16(sg * y[0], sg * y[1]); w.w = cvt_pk_bf16(sg * y[2], sg * y[3]);
                    Bc[ks] = __builtin_bit_cast(bf16x8, w); }
                dsk = p.in[29][g * 16 + hcol]; }
        }
        float sr = 0.f, si = 0.f;
        if (PASS == 2) {
            if (smp) { sr = p.in[4][((size_t)b * 64 + g) * 64 + lane]; si = p.in[5][((size_t)b * 64 + g) * 64 + lane]; }
            else { const float* e0 = Eb + (((size_t)b * 64) * 64 + g) * 128 + lane * 2;
                for (int j0 = 0; j0 < ch; j0 += 16) { f32x2 ev[16];
#pragma unroll
                    for (int jj = 0; jj < 16; ++jj) { const int j = (j0 + jj) < ch ? (j0 + jj) : (ch - 1); ev[jj] = *(const f32x2*)(e0 + (size_t)j * 64 * 128); }
#pragma unroll
                    for (int jj = 0; jj < 16; ++jj) { const bool on = (j0 + jj) < ch; const float t = p64r * sr - p64i * si + ev[jj].x, u2 = p64r * si + p64i * sr + ev[jj].y; sr = on ? t : sr; si = on ? u2 : si; } } }
        }
        __syncthreads();
        for (int sub = 0; sub < L; sub += 32) {
#pragma unroll 2
            for (int tt = 0; tt < 32; ++tt) { const int t = sub + tt; f32x2 bu0 = (f32x2){0.f, 0.f}, bu1 = (f32x2){0.f, 0.f};
#pragma unroll
                for (int q = 0; q < 4; ++q) { const f32x4 u = *(const LAS f32x4*)(ut + t * 128 + wid * 16 + q * 4);
                    bu0 = bu0 + bb[q * 4] * u[0]; bu1 = bu1 + bb[q * 4 + 1] * u[1]; bu0 = bu0 + bb[q * 4 + 2] * u[2]; bu1 = bu1 + bb[q * 4 + 3] * u[3]; }
                const float bur = bu0[0] + bu1[0], bui = bu0[1] + bu1[1];
                const float nr2 = lbr * sr - lbi * si + bur; si = lbr * si + lbi * sr + bui; sr = nr2;
                if (PASS == 2) { *(LAS bf16_t*)(sb + tt * SROW + lane * 2) = (bf16_t)(cvt_pk_bf16(sr, 0.f) & 0xffffu); *(LAS bf16_t*)(sb + tt * SROW + 128 + lane * 2) = (bf16_t)(cvt_pk_bf16(si, 0.f) & 0xffffu); } }
            if (PASS == 2) {
                __syncthreads();
#pragma unroll
                for (int mt = 0; mt < 2; ++mt) { f32x4 acc = (f32x4){0.f, 0.f, 0.f, 0.f};
#pragma unroll
                    for (int ks = 0; ks < 4; ++ks) { const bf16x8 a = *(const LAS bf16x8*)(sb + (mt * 16 + hcol) * SROW + ks * 64 + q4 * 16); acc = __builtin_amdgcn_mfma_f32_16x16x32_bf16(a, Bc[ks], acc, 0, 0, 0); }
#pragma unroll
                    for (int j = 0; j < 4; ++j) { const int t = sub + mt * 16 + q4 * 4 + j; const float y = acc[j] + dsk * ut[t * 128 + wid * 16 + hcol];
                        yb[(size_t)(row0 + t) * YLD + g * 16 + hcol] = (bf16_t)(cvt_pk_bf16(gelu_t(y), 0.f) & 0xffffu); } }
                __syncthreads();
            }
        }
        if (PASS == 1) { *(f32x2*)(Eb + ((((size_t)b * 64 + ch) * 64) + g) * 128 + lane * 2) = (f32x2){sr, si}; }
        else { if (smp) { p.out[O_S5RE_S + ((size_t)b * 64 + g) * 64 + lane] = sr; p.out[O_S5IM_S + ((size_t)b * 64 + g) * 64 + lane] = si; }
               else if (ch == 63) { p.out[O_S5RE_P + ((size_t)b * 64 + g) * 64 + lane] = sr; p.out[O_S5IM_P + ((size_t)b * 64 + g) * 64 + lane] = si; } }
        __syncthreads();
    }
}


__device__ __forceinline__ void phase_s5_ends(const Params& p, LAS unsigned char* lds, int nitems) {
    const int tid = threadIdx.x, wid = tid >> 6, lane = tid & 63, l31 = lane & 31, hh = lane >> 5;
    const float* proj2 = (const float*)(p.ws + OFF_PROJ2); float* Eb = (float*)(p.ws + OFF_E);
    constexpr int UROW = 272;
    int oct_cur = -1;
    float lr[2] = {0.f, 0.f}, li[2] = {0.f, 0.f}, l4r[2] = {0.f, 0.f}, l4i[2] = {0.f, 0.f}; bf16x8 Bre[2], Bim[2];
#pragma unroll
    for (int i = 0; i < 2; ++i) { Bre[i] = (bf16x8){0, 0, 0, 0, 0, 0, 0, 0}; Bim[i] = Bre[i]; }
    for (int item = blockIdx.x; item < nitems; item += gridDim.x) {
        const int cs = item >> 3, oct = item & 7, g = oct * 8 + wid, b = cs >> 6, ch = cs & 63, row0 = b * 4096 + ch * 64;
#pragma unroll
        for (int k = 0; k < 4; ++k) { const int i = tid + k * 512, t = i >> 5, q = i & 31; const f32x4 v = *(const f32x4*)(proj2 + (size_t)(row0 + t) * DM + 1024 + oct * 128 + q * 4);
            u32x2 w; w.x = cvt_pk_bf16(v[0], v[1]); w.y = cvt_pk_bf16(v[2], v[3]); *(LAS u32x2*)(lds + t * UROW + q * 8) = w; }
        if (oct != oct_cur) { oct_cur = oct;
            const float dt = __expf(p.in[24][g]);
#pragma unroll
            for (int sx = 0; sx < 2; ++sx) { const int st = l31 + 32 * sx;
                const float are = p.in[22][g * 64 + st], aim = p.in[23][g * 64 + st];
                const float er = __expf(are * dt); float rev = aim * dt * 0.15915494309189535f; rev -= floorf(rev);
                lr[sx] = er * __builtin_amdgcn_cosf(rev); li[sx] = er * __builtin_amdgcn_sinf(rev);
                const float den = 1.0f / (are * are + aim * aim); const float nr = lr[sx] - 1.0f, ni = li[sx];
                const float cr = (nr * are + ni * aim) * den, ci = (ni * are - nr * aim) * den;
                const float* br = p.in[25] + ((size_t)g * 64 + st) * 16 + hh * 8; const float* bi = p.in[26] + ((size_t)g * 64 + st) * 16 + hh * 8;
                const f32x4 x0 = *(const f32x4*)br, x1 = *(const f32x4*)(br + 4), y0 = *(const f32x4*)bi, y1 = *(const f32x4*)(bi + 4);
                u32x4 wr, wi;
                wr.x = cvt_pk_bf16(cr * x0[0] - ci * y0[0], cr * x0[1] - ci * y0[1]); wr.y = cvt_pk_bf16(cr * x0[2] - ci * y0[2], cr * x0[3] - ci * y0[3]);
                wr.z = cvt_pk_bf16(cr * x1[0] - ci * y1[0], cr * x1[1] - ci * y1[1]); wr.w = cvt_pk_bf16(cr * x1[2] - ci * y1[2], cr * x1[3] - ci * y1[3]);
                wi.x = cvt_pk_bf16(cr * y0[0] + ci * x0[0], cr * y0[1] + ci * x0[1]); wi.y = cvt_pk_bf16(cr * y0[2] + ci * x0[2], cr * y0[3] + ci * x0[3]);
                wi.z = cvt_pk_bf16(cr * y1[0] + ci * x1[0], cr * y1[1] + ci * x1[1]); wi.w = cvt_pk_bf16(cr * y1[2] + ci * x1[2], cr * y1[3] + ci * x1[3]);
                Bre[sx] = __builtin_bit_cast(bf16x8, wr); Bim[sx] = __builtin_bit_cast(bf16x8, wi);
                const float t2r = lr[sx] * lr[sx] - li[sx] * li[sx], t2i = 2.f * lr[sx] * li[sx]; l4r[sx] = t2r * t2r - t2i * t2i; l4i[sx] = 2.f * t2r * t2i; } }
        __syncthreads();
        float sr[2] = {0.f, 0.f}, si[2] = {0.f, 0.f};
#pragma unroll
        for (int sub = 0; sub < 2; ++sub) {
            const bf16x8 a = *(const LAS bf16x8*)(lds + (sub * 32 + l31) * UROW + (wid * 16 + hh * 8) * 2);
            f32x16 z;
#pragma unroll
            for (int r = 0; r < 16; ++r) z[r] = 0.f;
#pragma unroll
            for (int sx = 0; sx < 2; ++sx) { const f32x16 ar = __builtin_amdgcn_mfma_f32_32x32x16_bf16(a, Bre[sx], z, 0, 0, 0), ai = __builtin_amdgcn_mfma_f32_32x32x16_bf16(a, Bim[sx], z, 0, 0, 0);
#pragma unroll
                for (int ag = 0; ag < 4; ++ag) {
#pragma unroll
                    for (int bq = 0; bq < 4; ++bq) { const float t = lr[sx] * sr[sx] - li[sx] * si[sx] + ar[ag * 4 + bq]; si[sx] = lr[sx] * si[sx] + li[sx] * sr[sx] + ai[ag * 4 + bq]; sr[sx] = t; }
                    if (!(sub == 1 && ag == 3)) { const float t = l4r[sx] * sr[sx] - l4i[sx] * si[sx]; si[sx] = l4r[sx] * si[sx] + l4i[sx] * sr[sx]; sr[sx] = t; } } }
        }
#pragma unroll
        for (int sx = 0; sx < 2; ++sx) { if (hh == 0) { const float t = l4r[sx] * sr[sx] - l4i[sx] * si[sx]; si[sx] = l4r[sx] * si[sx] + l4i[sx] * sr[sx]; sr[sx] = t; }
            const float tr = sr[sx] + __shfl_xor(sr[sx], 32), ti = si[sx] + __shfl_xor(si[sx], 32);
            if (hh == 0) *(f32x2*)(Eb + ((((size_t)b * 64 + ch) * 64) + g) * 128 + (l31 + 32 * sx) * 2) = (f32x2){tr, ti}; }
        __syncthreads();
    }
}

__device__ __forceinline__ void phase_s5_out(const Params& p, LAS unsigned char* lds, int nitems) {
    const int tid = threadIdx.x, wid = tid >> 6, lane = tid & 63, l31 = lane & 31, hh = lane >> 5, hcol = lane & 15, q4 = lane >> 4;
    const float* proj2 = (const float*)(p.ws + OFF_PROJ2); const float* Eb = (const float*)(p.ws + OFF_E); bf16_t* yb = (bf16_t*)(p.ws + OFF_YB);
    constexpr int UROW = 272, SROW = 272;
    LAS unsigned char* sb = lds + 64 * UROW + wid * 32 * SROW;
    int oct_cur = -1;
    float lr[2] = {0.f, 0.f}, li[2] = {0.f, 0.f}, p64r[2] = {0.f, 0.f}, p64i[2] = {0.f, 0.f}; f32x4 dsk4 = (f32x4){0.f, 0.f, 0.f, 0.f}; bf16x8 Bre[2], Bim[2], Bc[4];
#pragma unroll
    for (int i = 0; i < 2; ++i) { Bre[i] = (bf16x8){0, 0, 0, 0, 0, 0, 0, 0}; Bim[i] = Bre[i]; }
#pragma unroll
    for (int i = 0; i < 4; ++i) Bc[i] = (bf16x8){0, 0, 0, 0, 0, 0, 0, 0};
    for (int item = blockIdx.x; item < nitems; item += gridDim.x) {
        const int cs = item >> 3, oct = item & 7, g = oct * 8 + wid; const bool smp = cs >= 128;
        const int b = smp ? cs - 128 : cs >> 6, ch = smp ? 0 : cs & 63, L = smp ? 32 : 64, row0 = smp ? TP + b * 32 : b * 4096 + ch * 64;
#pragma unroll
        for (int k = 0; k < 4; ++k) { const int i = tid + k * 512, t = i >> 5, q = i & 31; if (i < L * 32) { const f32x4 v = *(const f32x4*)(proj2 + (size_t)(row0 + t) * DM + 1024 + oct * 128 + q * 4);
            u32x2 w; w.x = cvt_pk_bf16(v[0], v[1]); w.y = cvt_pk_bf16(v[2], v[3]); *(LAS u32x2*)(lds + t * UROW + q * 8) = w; } }
        if (oct != oct_cur) { oct_cur = oct;
            const float dt = __expf(p.in[24][g]);
#pragma unroll
            for (int sx = 0; sx < 2; ++sx) { const int st = l31 + 32 * sx;
                const float are = p.in[22][g * 64 + st], aim = p.in[23][g * 64 + st];
                const float er = __expf(are * dt); float rev = aim * dt * 0.15915494309189535f; rev -= floorf(rev);
                lr[sx] = er * __builtin_amdgcn_cosf(rev); li[sx] = er * __builtin_amdgcn_sinf(rev);
                const float den = 1.0f / (are * are + aim * aim); const float nr = lr[sx] - 1.0f, ni = li[sx];
                const float cr = (nr * are + ni * aim) * den, ci = (ni * are - nr * aim) * den;
                const float* br = p.in[25] + ((size_t)g * 64 + st) * 16 + hh * 8; const float* bi = p.in[26] + ((size_t)g * 64 + st) * 16 + hh * 8;
                const f32x4 x0 = *(const f32x4*)br, x1 = *(const f32x4*)(br + 4), y0 = *(const f32x4*)bi, y1 = *(const f32x4*)(bi + 4);
                u32x4 wr, wi;
                wr.x = cvt_pk_bf16(cr * x0[0] - ci * y0[0], cr * x0[1] - ci * y0[1]); wr.y = cvt_pk_bf16(cr * x0[2] - ci * y0[2], cr * x0[3] - ci * y0[3]);
                wr.z = cvt_pk_bf16(cr * x1[0] - ci * y1[0], cr * x1[1] - ci * y1[1]); wr.w = cvt_pk_bf16(cr * x1[2] - ci * y1[2], cr * x1[3] - ci * y1[3]);
                wi.x = cvt_pk_bf16(cr * y0[0] + ci * x0[0], cr * y0[1] + ci * x0[1]); wi.y = cvt_pk_bf16(cr * y0[2] + ci * x0[2], cr * y0[3] + ci * x0[3]);
                wi.z = cvt_pk_bf16(cr * y1[0] + ci * x1[0], cr * y1[1] + ci * x1[1]); wi.w = cvt_pk_bf16(cr * y1[2] + ci * x1[2], cr * y1[3] + ci * x1[3]);
                Bre[sx] = __builtin_bit_cast(bf16x8, wr); Bim[sx] = __builtin_bit_cast(bf16x8, wi);
                float pr = lr[sx], pi = li[sx];
#pragma unroll
                for (int q = 0; q < 6; ++q) { const float t = pr * pr - pi * pi; pi = 2.f * pr * pi; pr = t; }
                p64r[sx] = pr; p64i[sx] = pi; }
#pragma unroll
            for (int ks = 0; ks < 4; ++ks) { const float* src = (ks < 2 ? p.in[27] : p.in[28]) + ((size_t)g * 16 + hcol) * 64 + (ks & 1) * 32 + q4 * 8; const float sg = ks < 2 ? 1.f : -1.f;
                const f32x4 x = *(const f32x4*)src, y = *(const f32x4*)(src + 4); u32x4 w; w.x = cvt_pk_bf16(sg * x[0], sg * x[1]); w.y = cvt_pk_bf16(sg * x[2], sg * x[3]); w.z = cvt_pk_bf16(sg * y[0], sg * y[1]); w.w = cvt_pk_bf16(sg * y[2], sg * y[3]);
                Bc[ks] = __builtin_bit_cast(bf16x8, w); }
            dsk4 = *(const f32x4*)(p.in[29] + g * 16 + q4 * 4); }
        float sr[2] = {0.f, 0.f}, si[2] = {0.f, 0.f};
        if (smp) {
#pragma unroll
            for (int sx = 0; sx < 2; ++sx) { const int st = l31 + 32 * sx; sr[sx] = p.in[4][((size_t)b * 64 + g) * 64 + st]; si[sx] = p.in[5][((size_t)b * 64 + g) * 64 + st]; }
        } else { const float* e0 = Eb + (((size_t)b * 64) * 64 + g) * 128 + l31 * 2;
            for (int j0 = 0; j0 < ch; j0 += 16) { f32x2 ev[2][16];
#pragma unroll
                for (int jj = 0; jj < 16; ++jj) { const int j = (j0 + jj) < ch ? (j0 + jj) : (ch - 1); ev[0][jj] = *(const f32x2*)(e0 + (size_t)j * 64 * 128); ev[1][jj] = *(const f32x2*)(e0 + (size_t)j * 64 * 128 + 64); }
#pragma unroll
                for (int jj = 0; jj < 16; ++jj) { const bool on = (j0 + jj) < ch;
#pragma unroll
                    for (int sx = 0; sx < 2; ++sx) { const float t = p64r[sx] * sr[sx] - p64i[sx] * si[sx] + ev[sx][jj].x, u2 = p64r[sx] * si[sx] + p64i[sx] * sr[sx] + ev[sx][jj].y; sr[sx] = on ? t : sr[sx]; si[sx] = on ? u2 : si[sx]; } } } }
        __syncthreads();
        for (int sub = 0; sub < L; sub += 32) {
            const bf16x8 a = *(const LAS bf16x8*)(lds + (sub + l31) * UROW + (wid * 16 + hh * 8) * 2);
            f32x16 z;
#pragma unroll
            for (int r = 0; r < 16; ++r) z[r] = 0.f;
#pragma unroll
            for (int sx = 0; sx < 2; ++sx) {
                const f32x16 ar = __builtin_amdgcn_mfma_f32_32x32x16_bf16(a, Bre[sx], z, 0, 0, 0), ai = __builtin_amdgcn_mfma_f32_32x32x16_bf16(a, Bim[sx], z, 0, 0, 0);
                const float lrs = lr[sx], lis = li[sx]; float s_r = sr[sx], s_i = si[sx];
#pragma unroll
                for (int ag = 0; ag < 4; ++ag) {
                    float c1r[4], c1i[4], c2r[4], c2i[4]; float tr = s_r, ti = s_i;
#pragma unroll
                    for (int bq = 0; bq < 4; ++bq) { const float t = lrs * tr - lis * ti + ar[ag * 4 + bq]; ti = lrs * ti + lis * tr + ai[ag * 4 + bq]; tr = t; c1r[bq] = tr; c1i[bq] = ti; }
                    float xr = __shfl_xor(tr, 32), xi = __shfl_xor(ti, 32);
#pragma unroll
                    for (int bq = 0; bq < 4; ++bq) { const float t = lrs * xr - lis * xi + ar[ag * 4 + bq]; xi = lrs * xi + lis * xr + ai[ag * 4 + bq]; xr = t; c2r[bq] = xr; c2i[bq] = xi; }
                    s_r = __shfl_xor(xr, 32); s_i = __shfl_xor(xi, 32);
#pragma unroll
                    for (int bq = 0; bq < 4; ++bq) { const int tt = ag * 8 + hh * 4 + bq; const float vr = hh ? c2r[bq] : c1r[bq], vi = hh ? c2i[bq] : c1i[bq];
                        *(LAS bf16_t*)(sb + tt * SROW + (l31 + 32 * sx) * 2) = (bf16_t)(cvt_pk_bf16(vr, 0.f) & 0xffffu); *(LAS bf16_t*)(sb + tt * SROW + 128 + (l31 + 32 * sx) * 2) = (bf16_t)(cvt_pk_bf16(vi, 0.f) & 0xffffu); }
                }
                sr[sx] = s_r; si[sx] = s_i; __builtin_amdgcn_sched_barrier(0); }
            __syncthreads();
#pragma unroll
            for (int mt = 0; mt < 2; ++mt) { f32x4 acc = (f32x4){0.f, 0.f, 0.f, 0.f};
#pragma unroll
                for (int ks = 0; ks < 4; ++ks) { const bf16x8 af = *(const LAS bf16x8*)(sb + (mt * 16 + hcol) * SROW + ks * 64 + q4 * 16); acc = __builtin_amdgcn_mfma_f32_16x16x32_bf16(Bc[ks], af, acc, 0, 0, 0); }
                const int t = sub + mt * 16 + hcol; const u32x2 uw = *(const LAS u32x2*)(lds + t * UROW + (wid * 16 + q4 * 4) * 2);
                const float y0 = acc[0] + dsk4[0] * bf_lo(uw.x), y1 = acc[1] + dsk4[1] * bf_hi(uw.x), y2 = acc[2] + dsk4[2] * bf_lo(uw.y), y3 = acc[3] + dsk4[3] * bf_hi(uw.y);
                u32x2 w; w.x = cvt_pk_bf16(gelu_t(y0), gelu_t(y1)); w.y = cvt_pk_bf16(gelu_t(y2), gelu_t(y3));
                *(u32x2*)(yb + (size_t)(row0 + t) * YLD + g * 16 + q4 * 4) = w; }
            __syncthreads();
        }
        if (hh == 0 && (smp || ch == 63)) { float* ore = p.out + (smp ? O_S5RE_S : O_S5RE_P) + ((size_t)b * 64 + g) * 64; float* oim = p.out + (smp ? O_S5IM_S : O_S5IM_P) + ((size_t)b * 64 + g) * 64;
#pragma unroll
            for (int sx = 0; sx < 2; ++sx) { ore[l31 + 32 * sx] = sr[sx]; oim[l31 + 32 * sx] = si[sx]; } }
        __syncthreads();
    }
}

#define XB_TMO      128
#define XB_XCNT(j)  (256  + 64 * (j))
#define XB_XSUB(j)  (1280 + 64 * (j))
#define XB_XGEN(j)  (2304 + 64 * (j))
#define XB_TOP      3328
#define XB_TOPGEN   3392
#define XCD_BAR_WORDS 3456
#define XB_SPIN_CAP (1u << 20)
__device__ __forceinline__ unsigned xb_ld(unsigned* p)              { return __hip_atomic_load(p, __ATOMIC_RELAXED, __HIP_MEMORY_SCOPE_AGENT); }
__device__ __forceinline__ unsigned xb_add(unsigned* p, unsigned v) { return __hip_atomic_fetch_add(p, v, __ATOMIC_RELAXED, __HIP_MEMORY_SCOPE_AGENT); }
__device__ __forceinline__ unsigned xb_xcc_id() { return (unsigned)__builtin_amdgcn_s_getreg((3 << 11) | 20) & 0xFu; }
#define XB_SPIN(cond, bar) do { unsigned _sp = 0; while (cond) { __builtin_amdgcn_s_sleep(1); \
    if ((++_sp & 255u) == 0u) { if (xb_ld(&(bar)[XB_TMO])) break; if (_sp > XB_SPIN_CAP) { atomicAdd(&(bar)[XB_TMO], 1u); break; } } } } while (0)
struct XcdBarrier { unsigned* bar; unsigned x; volatile LAS unsigned* st; };
__device__ __forceinline__ XcdBarrier xcd_barrier_post(unsigned* bar, volatile LAS unsigned* st) {
    XcdBarrier b; b.bar = bar; b.x = xb_xcc_id(); b.st = st;
    if (threadIdx.x == 0) (void)xb_add(&bar[XB_XCNT(b.x)], 1u);
    return b;
}
__device__ __forceinline__ void xcd_barrier_complete(unsigned* bar, unsigned x, unsigned& nloc, unsigned& nx) {
    const unsigned G = gridDim.x * gridDim.y * gridDim.z;
    unsigned sum, cnt, mine, sp = 0u;
    for (;;) {
        sum = 0u; cnt = 0u; mine = 0u;
#pragma unroll
        for (unsigned j = 0; j < 16; ++j) { const unsigned c = xb_ld(&bar[XB_XCNT(j)]); sum += c; cnt += (c > 0u) ? 1u : 0u; mine = (j == x) ? c : mine; }
        if (sum == G) break;
        __builtin_amdgcn_s_sleep(1);
        if ((++sp & 255u) == 0u) { if (xb_ld(&bar[XB_TMO])) break; if (sp > XB_SPIN_CAP) { atomicAdd(&bar[XB_TMO], 1u); break; } }
    }
    nloc = mine > 0u ? mine : 1u; nx = cnt > 0u ? cnt : 1u;
}
__device__ __forceinline__ void xcd_barrier(const XcdBarrier& b) {
    asm volatile("s_waitcnt vmcnt(0)" ::: "memory");
    __syncthreads();
    if (threadIdx.x == 0) {
        unsigned* bar = b.bar;
        __builtin_amdgcn_s_waitcnt(0);
        unsigned nloc = b.st[0], nx = b.st[1];
        if (nloc == 0u) { xcd_barrier_complete(bar, b.x, nloc, nx); b.st[0] = nloc; b.st[1] = nx; }
        const unsigned old = xb_add(&bar[XB_XSUB(b.x)], 1u);
        const unsigned gen = old / nloc;
        if (old + 1u == (gen + 1u) * nloc) {
            __builtin_amdgcn_fence(__ATOMIC_RELEASE, "agent");
            asm volatile("s_waitcnt vmcnt(0)" ::: "memory");
            const unsigned og = xb_add(&bar[XB_TOP], 1u);
            const unsigned tg = og / nx;
            if (og + 1u == (tg + 1u) * nx) xb_add(&bar[XB_TOPGEN], 1u);
            else XB_SPIN(xb_ld(&bar[XB_TOPGEN]) == tg, bar);
            __builtin_amdgcn_fence(__ATOMIC_ACQUIRE, "agent");
            xb_add(&bar[XB_XGEN(b.x)], 1u);
            asm volatile("s_waitcnt vmcnt(0)" ::: "memory");
        } else {
            XB_SPIN(xb_ld(&bar[XB_XGEN(b.x)]) == gen, bar);
            __builtin_amdgcn_fence(__ATOMIC_ACQUIRE, "agent");
            asm volatile("s_waitcnt vmcnt(0)" ::: "memory");
        }
    }
    __syncthreads();
}

__device__ __forceinline__ void run_phase(const Params& p, LAS unsigned char* lds, const int ph, const int vb) {
#ifdef ONLY_PH
    if (ph != ONLY_PH) return;
#endif
    unsigned char* ws = p.ws; const int nb = gridDim.x;
    switch (ph) {
    case 0: phase_prep(p, lds); break;
    case 1: { pg8::EpiBf16<1> E; E.O = (bf16_t*)(ws + OFF_PROJ); E.ldc = NE; E.gelu_tiles = 8; E.scale = nullptr; E.slab = 0;
              run_gemm(lds, (const bf16_t*)(ws + OFF_H), (const bf16_t*)(ws + OFF_WIN_E), NE, DM, HLD, HLD, 0, E, vb);
              phase_glr(p, vb);
              if (nb == 256 && vb >= 208) prep_run<1>(p, lds, vb - 208, 48, NL1); } break;
    case 2: { for (int it = blockIdx.x; it < 640; it += nb) { if (it < 512) glau_item<64>(p, lds, it); else glau_item<32>(p, lds, it); }
              for (int it = nb - 1 - (int)blockIdx.x; it < 384; it += nb) { if (it < 256) amix_item<128>(p, lds, it); else amix_item<32>(p, lds, it); } } break;
    case 3: phase_gla_scan(p); break;
    case 4: for (int it = blockIdx.x; it < 640; it += nb) { if (it < 512) glao_item<64>(p, lds, it); else glao_item<32>(p, lds, it); } break;
    case 5: case 15: { pg8::EpiBf16<1> E; E.O = (bf16_t*)(ws + OFF_M); E.ldc = DM; E.gelu_tiles = 0; E.scale = nullptr; E.slab = 0;
              const bf16_t* W = (const bf16_t*)(ws + (ph == 5 ? OFF_WOUT_E : OFF_WOUT_O));
              run_gemm(lds, (const bf16_t*)(ws + OFF_MIX), W, DM, DM, HLD, HLD, 0, E, vb, TP);
              run_gemm_split(lds, (const bf16_t*)(ws + OFF_MIX), W, DM, HLD, 8, (bf16_t*)(ws + OFF_SLAB_A), vb); } break;
    case 6: phase_norm(p, true, nullptr, p.in[8], p.in[9], (const bf16_t*)(ws + OFF_SLAB_A), 8); break;
    case 7: case 17: { const int layer = ph == 7 ? 0 : 1; pg8::EpiGateVal E; E.ACT = (bf16_t*)(ws + OFF_VAL); E.GF = (bf16_t*)(ws + OFF_GF); E.VF = (bf16_t*)(ws + OFF_VF); E.GL = (bf16_t*)(ws + OFF_GL);
              E.ffn_p = p.out + O_FFN_P + (size_t)layer * 2 * 2 * DFF; E.ffn_s = p.out + O_FFN_S + (size_t)layer * 32 * 2 * DFF;
              E.cw = p.in[33] + (size_t)layer * 3 * DFF; E.cb = p.in[34] + (size_t)layer * DFF;
              run_gemm(lds, (const bf16_t*)(ws + OFF_H), (const bf16_t*)(ws + (layer ? OFF_WUP1 : OFF_WUP0)), 2 * DFF, DM, HLD, HLD, 0, E, vb);
              if (nb == 256 && vb >= 48) { if (layer == 0) prep_run<2>(p, lds, vb - 48, 208, NL2); else prep_run<5>(p, lds, vb - 48, 208, NL5); } } break;
    case 8: phase_convfix(p, 0); break;
    case 18: phase_convfix(p, 1); break;
    case 9: case 19: { pg8::EpiBf16<1> E; E.O = (bf16_t*)(ws + OFF_M); E.ldc = DM; E.gelu_tiles = 0; E.scale = nullptr; E.slab = 0;
              const bf16_t* W = (const bf16_t*)(ws + (ph == 9 ? OFF_WDN0 : OFF_WDN1));
              run_gemm(lds, (const bf16_t*)(ws + OFF_VAL), W, DM, DFF, ALD, ALD, 0, E, vb, TP);
              run_gemm_split(lds, (const bf16_t*)(ws + OFF_VAL), W, DFF, ALD, 4, (bf16_t*)(ws + OFF_SLAB_B), vb);
              if (ph == 9 && nb == 256 && vb >= 128) prep_run<3>(p, lds, vb - 128, 128, NL3); } break;
    case 10: phase_norm(p, false, nullptr, p.in[10], p.in[7] + DM, (const bf16_t*)(ws + OFF_SLAB_B), 4); break;
    case 11: { pg8::EpiF32 E; E.C = (float*)(ws + OFF_PROJ2); E.ldc = DM; E.slab = 0;
              run_gemm(lds, (const bf16_t*)(ws + OFF_H), (const bf16_t*)(ws + OFF_WIN_O), DM, DM, HLD, HLD, 0, E, vb);
              if (nb == 256 && vb >= 32) prep_run<4>(p, lds, vb - 32, 224, NL4); } break;
    case 12: { phase_pool(p); phase_s5_ends(p, lds, 1024); } break;
    case 13: phase_s5_out(p, lds, 1280); break;
    case 14: { pg8::EpiGlu E; E.O = (bf16_t*)(ws + OFF_MIX) + 1024; E.ldc = HLD;
              run_gemm(lds, (const bf16_t*)(ws + OFF_YB), (const bf16_t*)(ws + OFF_WGLU), 2048, 1024, YLD, YLD, 0, E, vb); }
             { pg8::EpiBf16<1> E2; E2.O = (bf16_t*)(ws + OFF_MIX); E2.ldc = HLD; E2.gelu_tiles = 0; E2.scale = nullptr; E2.slab = 0;
              run_gemm(lds, (const bf16_t*)(ws + OFF_DELTA), (const bf16_t*)(ws + OFF_CMAP), 1024, 256, YLD, CLD, 256, E2, vb, T, nb >= 64 ? 32 : 0); } break;
    case 16: phase_norm(p, false, nullptr, p.in[8] + DM, p.in[9] + DM, (const bf16_t*)(ws + OFF_SLAB_A), 8); break;
    case 20: phase_norm(p, false, p.out + O_Y, p.in[10] + DM, nullptr, (const bf16_t*)(ws + OFF_SLAB_B), 4); break;
    default: break;
    }
}

__global__ void __launch_bounds__(512, 2) fwd_megakernel(Params p) {
    extern __shared__ __attribute__((aligned(16))) unsigned char shm[];
    LAS unsigned char* lds = (LAS unsigned char*)shm;
    cg::grid_group grid = cg::this_grid();
    volatile LAS unsigned* xst = (volatile LAS unsigned*)(lds + 131072);
    if (threadIdx.x == 0) { xst[0] = 0u; xst[1] = 0u; }
    __syncthreads();
    const XcdBarrier xb = xcd_barrier_post((unsigned*)(p.ws + OFF_BAR), xst);
    const int vb = (int)blockIdx.x;
    if (p.ph_hi > NPHASE) grid.sync();
#define GSYNC() xcd_barrier(xb)
#ifndef DUP_MASK
#define DUP_MASK 0u
#endif
#ifndef EXTRA_SYNC
#define EXTRA_SYNC 0
#endif
#define PH(n) if (p.ph_lo <= (n) && (n) < p.ph_hi) { run_phase(p, lds, SEQ[n], vb); if ((DUP_MASK >> (n)) & 1u) { GSYNC(); run_phase(p, lds, SEQ[n], vb); } \
        if ((n) + 1 < p.ph_hi) { GSYNC(); for (int _e = 0; _e < EXTRA_SYNC; ++_e) GSYNC(); } }
    PH(0) PH(1) PH(2) PH(3) PH(4) PH(5) PH(6) PH(7) PH(8) PH(9) PH(10) PH(11) PH(12) PH(13) PH(14) PH(15) PH(16) PH(17) PH(18) PH(19) PH(20)
#undef PH
}

extern "C" void kernel_launch(void* const* d_in, const int* in_sizes, int n_in, void* d_out, int out_size, void* d_ws, size_t ws_size, hipStream_t stream) {
    static int grid_blocks = 0;
    if (grid_blocks == 0) {
        if (n_in != 36 || (size_t)out_size != O_END || ws_size < WS_END) { fprintf(stderr, "kernel_launch: unexpected sizes n_in %d out %d ws %zu (need %zu)\n", n_in, out_size, ws_size, (size_t)WS_END); grid_blocks = -1; return; }
        int dev = 0, cus = 0, per_cu = 0;
        hipGetDevice(&dev); hipDeviceGetAttribute(&cus, hipDeviceAttributeMultiprocessorCount, dev);
        if (hipFuncSetAttribute((const void*)fwd_megakernel, hipFuncAttributeMaxDynamicSharedMemorySize, LDS_BYTES) != hipSuccess) { fprintf(stderr, "kernel_launch: hipFuncSetAttribute failed\n"); grid_blocks = -1; return; }
        hipOccupancyMaxActiveBlocksPerMultiprocessor(&per_cu, (const void*)fwd_megakernel, 512, LDS_BYTES);
        if (per_cu < 1) { fprintf(stderr, "kernel_launch: occupancy query says %d blocks per CU\n", per_cu); per_cu = 1; }
        (void)hipGetLastError();
        grid_blocks = cus;
    }
    if (grid_blocks < 0) return;
    Params p{};
    for (int i = 0; i < 36; ++i) p.in[i] = (const float*)d_in[i];
    p.out = (float*)d_out; p.ws = (unsigned char*)d_ws;
#if MULTI_LAUNCH
    for (int ph = 0; ph < NPHASE; ++ph) { p.ph_lo = ph; p.ph_hi = ph + 1; hipLaunchKernelGGL(fwd_megakernel, dim3(grid_blocks), dim3(512), LDS_BYTES, stream, p); }
#else
    p.ph_lo = 0; p.ph_hi = NPHASE;
    if (hipMemsetAsync((unsigned char*)d_ws + OFF_BAR, 0, 16384, stream) != hipSuccess) { fprintf(stderr, "kernel_launch: barrier memset failed\n"); return; }
    void* args[] = {&p};
    hipError_t e = hipLaunchCooperativeKernel((const void*)fwd_megakernel, dim3(grid_blocks), dim3(512), args, LDS_BYTES, stream);
    if (e != hipSuccess) fprintf(stderr, "cooperative launch failed: %s (grid %d)\n", hipGetErrorString(e), grid_blocks);
#endif
}
```

```cpp
#include <hip/hip_runtime.h>
#include <hip/hip_cooperative_groups.h>
#include <cstdio>
namespace cg = cooperative_groups;

#define LAS __attribute__((address_space(3)))
typedef unsigned short bf16_t;
typedef short bf16x8 __attribute__((ext_vector_type(8)));
typedef float f32x4 __attribute__((ext_vector_type(4)));
typedef float f32x2 __attribute__((ext_vector_type(2)));
typedef float f32x16 __attribute__((ext_vector_type(16)));
typedef unsigned u32x4 __attribute__((ext_vector_type(4)));
typedef unsigned u32x2 __attribute__((ext_vector_type(2)));

#ifndef MULTI_LAUNCH
#define MULTI_LAUNCH 0
#endif

constexpr int T = 9216, TP = 8192, DM = 2048, DFF = 5632, NE = 5120, NE_SRC = 5136;
constexpr float EPS = 1e-6f;
constexpr int PADK = 64, HLD = DM + PADK, ALD = DFF + PADK, YLD = 1024 + PADK, CLD = 256 + PADK;
constexpr int NPHASE = 21;
__device__ constexpr int SEQ[NPHASE] = {0, 1, 2, 3, 4, 5, 6, 7, 8, 9, 10, 11, 12, 13, 14, 15, 16, 17, 18, 19, 20};
constexpr int LDS_BYTES = 131072 + 16;

constexpr size_t al256(size_t x) { return (x + 255) & ~(size_t)255; }
constexpr size_t SZ_WIN_E = (size_t)NE * HLD * 2, SZ_WG = 16 * DM * 2, SZ_W22 = (size_t)DM * HLD * 2, SZ_WUP = (size_t)2 * DFF * HLD * 2,
                 SZ_WDN = (size_t)DM * ALD * 2, SZ_CMAP = 1024 * CLD * 2, SZ_WGLU = (size_t)2048 * YLD * 2, SZ_WSM = 8 * 128 * 128 * 2;
constexpr size_t OFF_WIN_E = 0;
constexpr size_t OFF_WG = OFF_WIN_E + SZ_WIN_E;
constexpr size_t OFF_WOUT_E = OFF_WG + SZ_WG;
constexpr size_t OFF_WUP0 = OFF_WOUT_E + SZ_W22;
constexpr size_t OFF_WUP1 = OFF_WUP0 + SZ_WUP;
constexpr size_t OFF_WDN0 = OFF_WUP1 + SZ_WUP;
constexpr size_t OFF_WDN1 = OFF_WDN0 + SZ_WDN;
constexpr size_t OFF_WIN_O = OFF_WDN1 + SZ_WDN;
constexpr size_t OFF_CMAP = OFF_WIN_O + SZ_W22;
constexpr size_t OFF_WGLU = OFF_CMAP + SZ_CMAP;
constexpr size_t OFF_WOUT_O = OFF_WGLU + SZ_WGLU;
constexpr size_t OFF_WSM = OFF_WOUT_O + SZ_W22;
constexpr size_t OFF_H = OFF_WSM + SZ_WSM;
constexpr size_t OFF_MIX = OFF_H + (size_t)T * HLD * 2;
constexpr size_t OFF_M = OFF_MIX + (size_t)T * HLD * 2;
constexpr size_t OFF_XA = OFF_M + (size_t)T * DM * 4;
constexpr size_t OFF_R1 = OFF_XA + (size_t)T * DM * 4;
constexpr size_t SZ_R1 = (size_t)T * DFF * 2 + (size_t)T * ALD * 2;
constexpr size_t OFF_PROJ = OFF_R1;
constexpr size_t OFF_UT = OFF_PROJ + (size_t)T * NE * 2;
constexpr size_t OFF_ST = OFF_UT + (size_t)512 * 256 * 128 * 4;
constexpr size_t OFF_DECAY = OFF_ST + (size_t)640 * 256 * 128 * 2;
constexpr size_t OFF_GLR = OFF_DECAY + (size_t)640 * 128 * 4;
static_assert(OFF_GLR + (size_t)T * 16 * 4 <= OFF_R1 + SZ_R1, "arena");
constexpr size_t OFF_GATE = OFF_R1;
constexpr size_t OFF_VAL = OFF_R1 + (size_t)T * DFF * 2;
constexpr size_t OFF_GF = OFF_R1;
constexpr size_t OFF_VF = OFF_GF + (size_t)576 * DFF * 2;
constexpr size_t OFF_GL = OFF_VF + (size_t)576 * DFF * 2;
constexpr size_t OFF_PROJ2 = OFF_R1;
constexpr size_t OFF_DELTA = OFF_PROJ2 + (size_t)T * DM * 4;
constexpr size_t OFF_YB = OFF_DELTA + (size_t)T * YLD * 2;
constexpr size_t OFF_E = OFF_YB + (size_t)T * YLD * 2;
constexpr size_t OFF_SLAB_A = OFF_R1;
constexpr size_t OFF_SLAB_B = OFF_MIX;
constexpr size_t OFF_BAR = OFF_R1 + SZ_R1;
constexpr size_t WS_END = OFF_BAR + 16384;

constexpr size_t O_Y = 0;
constexpr size_t O_GLA_P = O_Y + (size_t)T * DM;
constexpr size_t O_GLA_S = O_GLA_P + 2 * 4 * 128 * 256;
constexpr size_t O_AV = O_GLA_S + (size_t)32 * 4 * 128 * 256;
constexpr size_t O_POOL_P = O_AV + (size_t)32 * 32 * 1024;
constexpr size_t O_POOL_S = O_POOL_P + 2 * 15 * 1024;
constexpr size_t O_S5RE_P = O_POOL_S + 32 * 15 * 1024;
constexpr size_t O_S5IM_P = O_S5RE_P + 2 * 64 * 64;
constexpr size_t O_S5RE_S = O_S5IM_P + 2 * 64 * 64;
constexpr size_t O_S5IM_S = O_S5RE_S + 32 * 64 * 64;
constexpr size_t O_FFN_P = O_S5IM_S + 32 * 64 * 64;
constexpr size_t O_FFN_S = O_FFN_P + 2 * 2 * 2 * DFF;
constexpr size_t O_END = O_FFN_S + (size_t)2 * 32 * 2 * DFF;

struct Params {
    const float* in[36];
    float* out;
    unsigned char* ws;
    int ph_lo, ph_hi;
};

__device__ __forceinline__ unsigned cvt_pk_bf16(float lo, float hi) { unsigned r; asm volatile("v_cvt_pk_bf16_f32 %0, %1, %2" : "=v"(r) : "v"(lo), "v"(hi)); return r; }
__device__ __forceinline__ float bf_lo(unsigned w) { return __uint_as_float(w << 16); }
__device__ __forceinline__ float bf_hi(unsigned w) { return __uint_as_float(w & 0xffff0000u); }
__device__ __forceinline__ float bf1(bf16_t b) { return __uint_as_float(((unsigned)b) << 16); }
__device__ __forceinline__ float fast_rcp(float x) { return __builtin_amdgcn_rcpf(x); }
__device__ __forceinline__ float sigmoidf(float x) { return fast_rcp(1.0f + __builtin_amdgcn_exp2f(-1.4426950409f * x)); }
__device__ __forceinline__ float gelu_t(float x) { const float u = x * (1.5957691216f + 0.0713548163f * x * x); return x * fast_rcp(1.0f + __builtin_amdgcn_exp2f(-1.4426950409f * u)); }
__device__ __forceinline__ float wave_sum(float v) {
#pragma unroll
    for (int o = 32; o >= 1; o >>= 1) v += __shfl_xor(v, o);
    return v;
}
__device__ __forceinline__ const float* xrow_in(const Params& p, int row) { return row < TP ? p.in[0] + (size_t)row * DM : p.in[1] + (size_t)(row - TP) * DM; }

namespace pg8 {
constexpr int BM = 256, BK = 64, HALF = 128, HTB = HALF * BK * 2, STAGE_BYTES = 8 * HTB, NXCD = 8, WGM = 8;
__device__ __forceinline__ int lds_byte(int r, int c) { const int st = (r >> 4) * 2 + (c >> 5), rr = r & 15, cc = c & 31, ob = rr * 64 + cc * 2; return st * 1024 + (ob ^ (((ob >> 9) & 1) << 5)); }
__device__ __forceinline__ void stage_rc(int b, int& R, int& C) { const int st = b / 1024, sb = b % 1024, swz = sb ^ (((sb >> 9) & 1) << 5); R = (st >> 1) * 16 + swz / 64; C = (st & 1) * 32 + (swz % 64) / 2; }
__device__ __forceinline__ int perm32(int rho) { const int n = rho >> 4, i = rho & 15; return 8 * (i >> 2) + 4 * n + (i & 3); }
struct Unit { int pm, pn, ks; };
struct Gemm { const bf16_t* A; const bf16_t* Bt; int M, N, K, lda, ldb, a_pn_off; };
struct StaticOrder {
    int nM, nN, nwg, G, c;
    __device__ void init(int M, int N, int G_, int c_) { nM = M / BM; nN = N / BM; nwg = nM * nN; G = G_; c = c_; }
    __device__ bool next(int i, Unit& u) const {
        const long L = (long)i * G + c; if (L >= nwg) return false;
        int wgid = (int)L; { const int q = nwg / NXCD, r = nwg % NXCD, xcd = wgid % NXCD, off = wgid / NXCD; wgid = (xcd < r ? xcd * (q + 1) : r * (q + 1) + (xcd - r) * q) + off; }
        const int nig = WGM * nN, gid = wgid / nig, fm = gid * WGM, gsz = (nM - fm) < WGM ? (nM - fm) : WGM;
        u.pm = fm + ((wgid % nig) % gsz); u.pn = (wgid % nig) / gsz; u.ks = 0; return true;
    }
};
struct SplitOrder {
    int S, nsub, G, c;
    __device__ void init(int nN, int S_, int G_, int c_) { S = S_; nsub = 4 * nN * S_; G = G_; c = c_; }
    __device__ bool next(int i, Unit& u) const {
        const long L = (long)i * G + c; if (L >= nsub) return false;
        const int l = (int)L, tile = l / S; u.ks = l - tile * S; u.pm = tile & 3; u.pn = tile >> 2; return true;
    }
};

struct EpiF32 {
    static constexpr bool PERM = false;
    float* C; int ldc; size_t slab;
    __device__ __forceinline__ void operator()(const f32x4 (&acc)[2][2][4][2], const Unit& u, int wr, int wc, int fr, int fq) const {
        const int row0 = u.pm * BM + wr * 64 + fr, col0 = u.pn * BM + wc * 32 + 4 * fq;
#pragma unroll
        for (int ai = 0; ai < 2; ++ai)
#pragma unroll
            for (int m = 0; m < 4; ++m) { float* rowp = C + (size_t)u.ks * slab + (size_t)(row0 + ai * HALF + m * 16) * ldc + col0;
#pragma unroll
                for (int bj = 0; bj < 2; ++bj)
#pragma unroll
                    for (int n = 0; n < 2; ++n) *(f32x4*)(rowp + bj * HALF + n * 16) = acc[ai][bj][m][n]; }
    }
};
template <int MODE> struct EpiBf16 {
    static constexpr bool PERM = true;
    bf16_t* O; int ldc; int gelu_tiles; const float* scale; size_t slab;
    __device__ __forceinline__ void operator()(const f32x4 (&acc)[2][2][4][2], const Unit& u, int wr, int wc, int fr, int fq) const {
        const int row0 = u.pm * BM + wr * 64 + fr, col0 = u.pn * BM + wc * 32 + 8 * fq;
        bf16_t* Ob = O + (size_t)u.ks * slab;
        const bool dog = (MODE == 1) && (u.pn < gelu_tiles);
#pragma unroll
        for (int ai = 0; ai < 2; ++ai)
#pragma unroll
            for (int m = 0; m < 4; ++m) { bf16_t* rowp = Ob + (size_t)(row0 + ai * HALF + m * 16) * ldc + col0;
#pragma unroll
                for (int bj = 0; bj < 2; ++bj) { f32x4 v0 = acc[ai][bj][m][0], v1 = acc[ai][bj][m][1];
                    if (MODE == 2) { v0 = v0 * *(const f32x4*)(scale + col0 + bj * HALF); v1 = v1 * *(const f32x4*)(scale + col0 + bj * HALF + 4); }
                    if (dog) {
#pragma unroll
                        for (int j = 0; j < 4; ++j) { v0[j] = gelu_t(v0[j]); v1[j] = gelu_t(v1[j]); } }
                    u32x4 w; w.x = cvt_pk_bf16(v0[0], v0[1]); w.y = cvt_pk_bf16(v0[2], v0[3]); w.z = cvt_pk_bf16(v1[0], v1[1]); w.w = cvt_pk_bf16(v1[2], v1[3]);
                    *(u32x4*)(rowp + bj * HALF) = w; } }
    }
};
struct EpiGateVal {
    static constexpr bool PERM = true;
    bf16_t* ACT; bf16_t* GF; bf16_t* VF; bf16_t* GL; float* ffn_p; float* ffn_s; const float* cw; const float* cb;
    __device__ __forceinline__ void operator()(const f32x4 (&acc)[2][2][4][2], const Unit& u, int wr, int wc, int fr, int fq) const {
        const int lane = threadIdx.x & 63, row0 = u.pm * BM + wr * 64 + fr, col0 = u.pn * HALF + wc * 32 + 8 * fq;
        const int src1 = (lane & 48) | ((fr - 1) & 15), src2 = (lane & 48) | ((fr - 2) & 15);
        f32x4 w0[2], w1[2], w2[2], bb[2];
#pragma unroll
        for (int n = 0; n < 2; ++n) { w0[n] = *(const f32x4*)(cw + col0 + 4 * n); w1[n] = *(const f32x4*)(cw + DFF + col0 + 4 * n); w2[n] = *(const f32x4*)(cw + 2 * DFF + col0 + 4 * n); bb[n] = *(const f32x4*)(cb + col0 + 4 * n); }
#pragma unroll
        for (int ai = 0; ai < 2; ++ai) {
            f32x4 pP1[2], pP2[2];
#pragma unroll
            for (int n = 0; n < 2; ++n) { pP1[n] = (f32x4){0.f, 0.f, 0.f, 0.f}; pP2[n] = (f32x4){0.f, 0.f, 0.f, 0.f}; }
#pragma unroll
            for (int m = 0; m < 4; ++m) { const int row = row0 + ai * HALF + m * 16; const size_t off = (size_t)row * ALD + col0;
                const f32x4 g0 = acc[ai][0][m][0], g1v = acc[ai][0][m][1], v0 = acc[ai][1][m][0], v1 = acc[ai][1][m][1];
                u32x2 a2[2];
#pragma unroll
                for (int n = 0; n < 2; ++n) { const f32x4 g = n ? g1v : g0, v = n ? v1 : v0; f32x4 P1, P2;
#pragma unroll
                    for (int j = 0; j < 4; ++j) { P1[j] = __shfl(g[j], src1); P2[j] = __shfl(g[j], src2); }
                    const f32x4 h1 = fr >= 1 ? P1 : pP1[n], h2 = fr >= 2 ? P2 : pP2[n]; pP1[n] = P1; pP2[n] = P2;
                    const f32x4 cv = bb[n] + w0[n] * h2 + w1[n] * h1 + w2[n] * g; f32x4 o;
#pragma unroll
                    for (int j = 0; j < 4; ++j) o[j] = gelu_t(cv[j]) * v[j];
                    a2[n].x = cvt_pk_bf16(o[0], o[1]); a2[n].y = cvt_pk_bf16(o[2], o[3]); }
                const bool deferred = (fr < 2) && (m == 0 || (m == 2 && row >= TP));
                if (!deferred) { *(u32x4*)(ACT + off) = (u32x4){a2[0].x, a2[0].y, a2[1].x, a2[1].y}; }
                else { const size_t so = ((size_t)(row >> 5) * 2 + (row & 1)) * DFF + col0;
                    *(u32x4*)(GF + so) = (u32x4){cvt_pk_bf16(g0[0], g0[1]), cvt_pk_bf16(g0[2], g0[3]), cvt_pk_bf16(g1v[0], g1v[1]), cvt_pk_bf16(g1v[2], g1v[3])};
                    *(u32x4*)(VF + so) = (u32x4){cvt_pk_bf16(v0[0], v0[1]), cvt_pk_bf16(v0[2], v0[3]), cvt_pk_bf16(v1[0], v1[1]), cvt_pk_bf16(v1[2], v1[3])}; }
                if (m == 3 && fr >= 14 && row < TP) { const size_t so = ((size_t)(row >> 6) * 2 + (fr - 14)) * DFF + col0;
                    *(u32x4*)(GL + so) = (u32x4){cvt_pk_bf16(g0[0], g0[1]), cvt_pk_bf16(g0[2], g0[3]), cvt_pk_bf16(g1v[0], g1v[1]), cvt_pk_bf16(g1v[2], g1v[3])}; }
                float* sp = nullptr;
                if (row < TP) { const int t = row & 4095; if (t >= 4094) sp = ffn_p + ((size_t)(row >> 12) * 2 + (t - 4094)) * DFF + col0; }
                else { const int rr = row - TP, t = rr & 31; if (t >= 30) sp = ffn_s + ((size_t)(rr >> 5) * 2 + (t - 30)) * DFF + col0; }
                if (sp) { *(f32x4*)sp = g0; *(f32x4*)(sp + 4) = g1v; } }
        }
    }
};
struct EpiGlu {
    static constexpr bool PERM = true;
    bf16_t* O; int ldc;
    __device__ __forceinline__ void operator()(const f32x4 (&acc)[2][2][4][2], const Unit& u, int wr, int wc, int fr, int fq) const {
        const int row0 = u.pm * BM + wr * 64 + fr, col0 = u.pn * HALF + wc * 32 + 8 * fq;
#pragma unroll
        for (int ai = 0; ai < 2; ++ai)
#pragma unroll
            for (int m = 0; m < 4; ++m) { const int row = row0 + ai * HALF + m * 16;
                f32x4 a0 = acc[ai][0][m][0], a1 = acc[ai][0][m][1]; const f32x4 b0 = acc[ai][1][m][0], b1 = acc[ai][1][m][1];
#pragma unroll
                for (int j = 0; j < 4; ++j) { a0[j] *= sigmoidf(b0[j]); a1[j] *= sigmoidf(b1[j]); }
                u32x4 w; w.x = cvt_pk_bf16(a0[0], a0[1]); w.y = cvt_pk_bf16(a0[2], a0[3]); w.z = cvt_pk_bf16(a1[0], a1[1]); w.w = cvt_pk_bf16(a1[2], a1[3]);
                *(u32x4*)(O + (size_t)row * ldc + col0) = w; }
    }
};

template <class Epi, class Sched>
__device__ __forceinline__ void gemm_phase(LAS unsigned char* lds, const Gemm g, const Sched& S, const Epi& E) {
    const int tid = threadIdx.x, wid = __builtin_amdgcn_readfirstlane(tid >> 6), lane = tid & 63, wr = wid >> 2, wc = wid & 3, fr = lane & 15, fq = lane >> 4;
    const int K = g.K, nt = K / BK;
    unsigned voffA[2], voffB[2];
#pragma unroll
    for (int i = 0; i < 2; ++i) { int R, C; stage_rc(tid * 16 + i * 8192, R, C); const int Rb = Epi::PERM ? ((R & ~31) + perm32(R & 31)) : R;
        voffA[i] = (unsigned)(R * g.lda + C) * 2u; voffB[i] = (unsigned)(Rb * g.ldb + C) * 2u; }
    const size_t kstep = (size_t)(BK * 2);
    const size_t hstepA = (size_t)HALF * g.lda * 2, hstepB = (size_t)HALF * g.ldb * 2;
    const size_t tstepA = 2 * hstepA, tstepB = 2 * hstepB;
    const size_t pnoff = (size_t)g.a_pn_off * 2, ksb = (size_t)g.K * 2;
    const unsigned ldsw = (unsigned)wid * 1024u;
    const int aoff = lds_byte(wr * 64 + fr, fq * 8), boff = lds_byte(wc * 32 + fr, fq * 8);
#define PG8_SA(b, h) (((b) * 2 + (h)) * HTB)
#define PG8_SB(b, h) ((4 + (b) * 2 + (h)) * HTB)
#define PG8_STAGE(bufoff, gbase, voff) do { _Pragma("unroll") for (int _i = 0; _i < 2; ++_i) \
        __builtin_amdgcn_global_load_lds((const unsigned*)((const char*)(gbase) + (voff)[_i]), (LAS unsigned*)(lds + (bufoff) + ldsw + _i * 8192), 16, 0, 0); } while (0)
#define PG8_LDA(dst, b, h) do { _Pragma("unroll") for (int m = 0; m < 4; ++m) _Pragma("unroll") for (int k = 0; k < 2; ++k) dst[m][k] = *(const LAS bf16x8*)(lds + PG8_SA(b, h) + aoff + m * 2048 + k * 1024); } while (0)
#define PG8_LDB(dst, b, h) do { _Pragma("unroll") for (int n = 0; n < 2; ++n) _Pragma("unroll") for (int k = 0; k < 2; ++k) dst[n][k] = *(const LAS bf16x8*)(lds + PG8_SB(b, h) + boff + n * 2048 + k * 1024); } while (0)
#define PG8_MMA(ai, bj, At, Bt) do { __builtin_amdgcn_s_setprio(1); _Pragma("unroll") for (int m = 0; m < 4; ++m) _Pragma("unroll") for (int n = 0; n < 2; ++n) _Pragma("unroll") for (int k = 0; k < 2; ++k) \
        acc[ai][bj][m][n] = __builtin_amdgcn_mfma_f32_16x16x32_bf16(Bt[n][k], At[m][k], acc[ai][bj][m][n], 0, 0, 0); __builtin_amdgcn_s_setprio(0); } while (0)
#define PG8_WAIT_V(n) asm volatile("s_waitcnt vmcnt(" #n ")" ::: "memory")
#define PG8_WAIT_L(n) asm volatile("s_waitcnt lgkmcnt(" #n ")" ::: "memory")
#define PG8_BAR __builtin_amdgcn_s_barrier()
#define PG8_SCHED __builtin_amdgcn_sched_barrier(0)
    Unit cur, nxt; int ui = 0;
    if (!S.next(0, cur)) return;
    f32x4 acc[2][2][4][2];
#pragma unroll
    for (int a = 0; a < 2; ++a)
#pragma unroll
        for (int b = 0; b < 2; ++b)
#pragma unroll
            for (int m = 0; m < 4; ++m)
#pragma unroll
                for (int n = 0; n < 2; ++n) acc[a][b][m][n] = (f32x4){0.f, 0.f, 0.f, 0.f};
    bf16x8 At[4][2], B0[2][2], B1[2][2];
    const char* cA = (const char*)g.A + (size_t)cur.pm * tstepA + (size_t)cur.pn * pnoff + (size_t)cur.ks * ksb; const char* cB = (const char*)g.Bt + (size_t)cur.pn * tstepB + (size_t)cur.ks * ksb;
    PG8_STAGE(PG8_SB(0, 0), cB, voffB); PG8_STAGE(PG8_SA(0, 0), cA, voffA); PG8_STAGE(PG8_SB(0, 1), cB + hstepB, voffB); PG8_STAGE(PG8_SA(0, 1), cA + hstepA, voffA);
    if (wr == 1) PG8_BAR;
    PG8_WAIT_V(4); PG8_BAR;
    PG8_STAGE(PG8_SB(1, 0), cB + kstep, voffB); PG8_STAGE(PG8_SA(1, 0), cA + kstep, voffA); PG8_STAGE(PG8_SB(1, 1), cB + hstepB + kstep, voffB);
    PG8_WAIT_V(6); PG8_BAR;
    for (;;) {
        const bool has_next = S.next(ui + 1, nxt);
        const char* nA = has_next ? (const char*)g.A + (size_t)nxt.pm * tstepA + (size_t)nxt.pn * pnoff + (size_t)nxt.ks * ksb : cA; const char* nB = has_next ? (const char*)g.Bt + (size_t)nxt.pn * tstepB + (size_t)nxt.ks * ksb : cB;
        for (int t = 0; t < nt; t += 2) {
            const bool last = (t == nt - 2);
            const char* a1 = cA + (size_t)(t + 1) * kstep;
            const char* a2 = last ? nA : cA + (size_t)(t + 2) * kstep; const char* b2 = last ? nB : cB + (size_t)(t + 2) * kstep;
            const char* a3 = a2 + kstep; const char* b3 = b2 + kstep;
            PG8_LDB(B0, 0, 0); PG8_SCHED; PG8_LDA(At, 0, 0); PG8_STAGE(PG8_SA(1, 1), a1 + hstepA, voffA);
            PG8_WAIT_L(8); PG8_BAR; PG8_WAIT_L(0); PG8_MMA(0, 0, At, B0); PG8_BAR; PG8_SCHED;
            PG8_LDB(B1, 0, 1); PG8_STAGE(PG8_SB(0, 0), b2, voffB);
            PG8_BAR; PG8_WAIT_L(0); PG8_MMA(0, 1, At, B1); PG8_BAR;
            PG8_LDA(At, 0, 1); PG8_STAGE(PG8_SA(0, 0), a2, voffA);
            PG8_BAR; PG8_WAIT_L(0); PG8_MMA(1, 0, At, B0); PG8_BAR; PG8_SCHED;
            PG8_STAGE(PG8_SB(0, 1), b2 + hstepB, voffB);
            PG8_WAIT_V(6); PG8_BAR; PG8_MMA(1, 1, At, B1); PG8_BAR;
            PG8_LDB(B0, 1, 0); PG8_SCHED; PG8_LDA(At, 1, 0); PG8_STAGE(PG8_SA(0, 1), a2 + hstepA, voffA);
            PG8_WAIT_L(8); PG8_BAR; PG8_WAIT_L(0); PG8_MMA(0, 0, At, B0); PG8_BAR; PG8_SCHED;
            PG8_LDB(B1, 1, 1); PG8_STAGE(PG8_SB(1, 0), b3, voffB);
            PG8_BAR; PG8_WAIT_L(0); PG8_MMA(0, 1, At, B1); PG8_BAR;
            PG8_LDA(At, 1, 1); PG8_STAGE(PG8_SA(1, 0), a3, voffA);
            PG8_BAR; PG8_WAIT_L(0); PG8_MMA(1, 0, At, B0); PG8_BAR; PG8_SCHED;
            PG8_STAGE(PG8_SB(1, 1), b3 + hstepB, voffB);
            PG8_WAIT_V(6); PG8_BAR; PG8_MMA(1, 1, At, B1); PG8_BAR;
        }
        E(acc, cur, wr, wc, fr, fq);
        if (!has_next) break;
#pragma unroll
        for (int a = 0; a < 2; ++a)
#pragma unroll
            for (int b = 0; b < 2; ++b)
#pragma unroll
                for (int m = 0; m < 4; ++m)
#pragma unroll
                    for (int n = 0; n < 2; ++n) acc[a][b][m][n] = (f32x4){0.f, 0.f, 0.f, 0.f};
        cur = nxt; cA = nA; cB = nB; ++ui;
    }
    PG8_WAIT_V(0);
    if (wr == 0) PG8_BAR;
    PG8_BAR;
#undef PG8_SA
#undef PG8_SB
#undef PG8_STAGE
#undef PG8_LDA
#undef PG8_LDB
#undef PG8_MMA
#undef PG8_WAIT_V
#undef PG8_WAIT_L
#undef PG8_BAR
#undef PG8_SCHED
}
}

template <class Epi>
__device__ __forceinline__ void run_gemm(LAS unsigned char* lds, const bf16_t* A, const bf16_t* Bt, int N, int K, int lda, int ldb, int a_pn_off, const Epi& E, int vb, int M = T, int cshift = 0) {
    pg8::Gemm g; g.A = A; g.Bt = Bt; g.M = M; g.N = N; g.K = K; g.lda = lda; g.ldb = ldb; g.a_pn_off = a_pn_off;
    int c = vb - cshift; if (c < 0) c += (int)gridDim.x;
    pg8::StaticOrder S; S.init(M, N, (int)gridDim.x, c);
    pg8::gemm_phase<Epi, pg8::StaticOrder>(lds, g, S, E);
}
__device__ __forceinline__ void run_gemm_split(LAS unsigned char* lds, const bf16_t* A, const bf16_t* Bt, int K, int ld, int S, bf16_t* slabs, int vb) {
    pg8::Gemm g; g.A = A + (size_t)TP * ld; g.Bt = Bt; g.M = 1024; g.N = DM; g.K = K / S; g.lda = ld; g.ldb = ld; g.a_pn_off = 0;
    pg8::SplitOrder O; O.init(8, S, (int)gridDim.x, vb);
    pg8::EpiBf16<1> E; E.O = slabs; E.ldc = DM; E.gelu_tiles = 0; E.scale = nullptr; E.slab = (size_t)1024 * DM;
    pg8::gemm_phase<pg8::EpiBf16<1>, pg8::SplitOrder>(lds, g, O, E);
}

__device__ __forceinline__ void get_job(const Params& p, int j, const float*& src, bf16_t*& dst, int& K, int& N, int& ld, int& half, const float*& nscale) {
    unsigned char* ws = p.ws; half = 0; nscale = nullptr;
    switch (j) {
        case 0: src = p.in[11]; dst = (bf16_t*)(ws + OFF_WIN_E); K = DM; N = NE; ld = NE_SRC; break;
        case 1: src = p.in[18]; dst = (bf16_t*)(ws + OFF_WOUT_E); K = DM; N = DM; ld = DM; break;
        case 2: src = p.in[32]; dst = (bf16_t*)(ws + OFF_WUP0); K = DM; N = 2 * DFF; ld = 2 * DFF; half = DFF; break;
        case 3: src = p.in[32] + (size_t)DM * 2 * DFF; dst = (bf16_t*)(ws + OFF_WUP1); K = DM; N = 2 * DFF; ld = 2 * DFF; half = DFF; break;
        case 4: src = p.in[35]; dst = (bf16_t*)(ws + OFF_WDN0); K = DFF; N = DM; ld = DM; break;
        case 5: src = p.in[35] + (size_t)DFF * DM; dst = (bf16_t*)(ws + OFF_WDN1); K = DFF; N = DM; ld = DM; break;
        case 6: src = p.in[19]; dst = (bf16_t*)(ws + OFF_WIN_O); K = DM; N = DM; ld = DM; break;
        case 7: case 8: case 9: case 10: src = p.in[20] + (size_t)(j - 7) * 65536; dst = (bf16_t*)(ws + OFF_CMAP) + (size_t)(j - 7) * 256 * CLD; K = 256; N = 256; ld = 256; nscale = p.in[21] + (j - 7) * 256; break;
        case 11: src = p.in[30]; dst = (bf16_t*)(ws + OFF_WGLU); K = 1024; N = 2048; ld = 2048; half = 1024; break;
        default: src = p.in[31]; dst = (bf16_t*)(ws + OFF_WOUT_O); K = DM; N = DM; ld = DM; break;
    }
}
struct TileInfo { const float* src; bf16_t* dst; const float* nscale; int K, ld, half, k0, n0; };
__device__ __forceinline__ void prep_decode(const Params& p, int tile, TileInfo& ti) {
    int j, t0;
    if (tile < 640) { j = 0; t0 = 0; } else if (tile < 896) { j = 1; t0 = 640; } else if (tile < 2304) { j = 2; t0 = 896; } else if (tile < 3712) { j = 3; t0 = 2304; }
    else if (tile < 4416) { j = 4; t0 = 3712; } else if (tile < 5120) { j = 5; t0 = 4416; } else if (tile < 5376) { j = 6; t0 = 5120; }
    else if (tile < 5392) { j = 7 + ((tile - 5376) >> 2); t0 = 5376 + ((tile - 5376) & ~3); } else if (tile < 5520) { j = 11; t0 = 5392; } else { j = 12; t0 = 5520; }
    int N; get_job(p, j, ti.src, ti.dst, ti.K, N, ti.ld, ti.half, ti.nscale);
    const int local = tile - t0, ntn = N >> 8, tk = local / ntn, tn = local - tk * ntn; ti.k0 = tk * 64; ti.n0 = tn * 256;
}
constexpr int NL0 = 2048, NL1 = 336, NL2 = 1456, NL3 = 640, NL4 = 592, NL5 = 704;
__device__ __forceinline__ int list_tile(int list, int q) {
    switch (list) {
        case 0: return q < 640 ? q : 896 + (q - 640);
        case 1: return q < 256 ? 640 + q : 3712 + (q - 256);
        case 2: return q < 624 ? 3792 + q : (q < 1280 ? 5120 + (q - 624) : 2304 + (q - 1280));
        case 3: return 2480 + q;
        case 4: return 3120 + q;
        default: return 4416 + q;
    }
}
template <int LIST>
__device__ __forceinline__ void prep_run(const Params& p, LAS unsigned char* lds, int q0, int qs, int qend) {
    const int tid = threadIdx.x, wid = tid >> 6, lane = tid & 63;
    constexpr int TROW = 144;
    int it = 0, q = q0;
    TileInfo cur; f32x4 v[8];
    if (q < qend) { prep_decode(p, list_tile(LIST, q), cur);
#pragma unroll
        for (int i = 0; i < 8; ++i) v[i] = *(const f32x4*)(cur.src + (size_t)(cur.k0 + wid * 8 + i) * cur.ld + cur.n0 + lane * 4); }
    while (q < qend) {
        LAS unsigned char* buf = lds + (it & 1) * (256 * TROW);
        if (cur.nscale) { const f32x4 sc = *(const f32x4*)(cur.nscale + cur.n0 + lane * 4);
#pragma unroll
            for (int i = 0; i < 8; ++i) v[i] = v[i] * sc; }
#pragma unroll
        for (int e = 0; e < 4; ++e) { u32x4 w; w.x = cvt_pk_bf16(v[0][e], v[1][e]); w.y = cvt_pk_bf16(v[2][e], v[3][e]); w.z = cvt_pk_bf16(v[4][e], v[5][e]); w.w = cvt_pk_bf16(v[6][e], v[7][e]);
            *(LAS u32x4*)(buf + (lane * 4 + e) * TROW + wid * 16) = w; }
        const int nq = q + qs; TileInfo nxt = cur;
        if (nq < qend) { prep_decode(p, list_tile(LIST, nq), nxt);
#pragma unroll
            for (int i = 0; i < 8; ++i) v[i] = *(const f32x4*)(nxt.src + (size_t)(nxt.k0 + wid * 8 + i) * nxt.ld + nxt.n0 + lane * 4); }
        __syncthreads();
#pragma unroll
        for (int i = 0; i < 4; ++i) { const int n = i * 64 + (tid >> 3), kq = (tid & 7) * 8; const int ns = cur.n0 + n;
            int drow = ns; if (cur.half) { const int which = ns >= cur.half ? 1 : 0, nn = ns - which * cur.half; drow = (nn >> 7) * 256 + which * 128 + (nn & 127); }
            *(u32x4*)(cur.dst + (size_t)drow * (cur.K + PADK) + cur.k0 + kq) = *(const LAS u32x4*)(buf + n * TROW + kq * 2); }
        cur = nxt; q = nq; ++it;
    }
    __syncthreads();
}
__device__ __forceinline__ void phase_prep(const Params& p, LAS unsigned char* lds) {
    const int tid = threadIdx.x, wid = tid >> 6, lane = tid & 63;
    prep_run<0>(p, lds, (int)blockIdx.x, (int)gridDim.x, NL0);
    if (gridDim.x != 256) {
        prep_run<1>(p, lds, (int)blockIdx.x, (int)gridDim.x, NL1); prep_run<2>(p, lds, (int)blockIdx.x, (int)gridDim.x, NL2); prep_run<3>(p, lds, (int)blockIdx.x, (int)gridDim.x, NL3);
        prep_run<4>(p, lds, (int)blockIdx.x, (int)gridDim.x, NL4); prep_run<5>(p, lds, (int)blockIdx.x, (int)gridDim.x, NL5); }
    const int gtid = blockIdx.x * 512 + tid, gstride = gridDim.x * 512;
    { bf16_t* wg = (bf16_t*)(p.ws + OFF_WG);
      for (int i = gtid; i < DM * 16; i += gstride) { const int k = i >> 4, r = i & 15; wg[r * DM + k] = (bf16_t)(cvt_pk_bf16(p.in[11][(size_t)k * NE_SRC + NE + r], 0.f) & 0xffffu); } }
    { bf16_t* wsm = (bf16_t*)(p.ws + OFF_WSM);
      for (int i = gtid; i < 8 * 128 * 128; i += gstride) { const int jj = i & 127, ii = (i >> 7) & 127; const float w = ((jj >> 6) <= (ii >> 6)) ? p.in[12][i] : 0.f; wsm[i] = (bf16_t)(cvt_pk_bf16(w, 0.f) & 0xffffu); } }
    { bf16_t* h = (bf16_t*)(p.ws + OFF_H); const float* g = p.in[7];
      for (int row = blockIdx.x * 8 + wid; row < T; row += gridDim.x * 8) {
          const float* x = xrow_in(p, row); f32x4 v[8]; float ss = 0.f;
#pragma unroll
          for (int q = 0; q < 4; ++q) { v[2 * q] = *(const f32x4*)(x + q * 512 + lane * 8); v[2 * q + 1] = *(const f32x4*)(x + q * 512 + lane * 8 + 4); }
#pragma unroll
          for (int q = 0; q < 8; ++q) ss += v[q][0] * v[q][0] + v[q][1] * v[q][1] + v[q][2] * v[q][2] + v[q][3] * v[q][3];
          ss = wave_sum(ss); const float rstd = rsqrtf(ss * (1.0f / DM) + EPS);
#pragma unroll
          for (int q = 0; q < 4; ++q) { const f32x4 ga = *(const f32x4*)(g + q * 512 + lane * 8), gb = *(const f32x4*)(g + q * 512 + lane * 8 + 4); const f32x4 a = v[2 * q] * rstd * ga, c = v[2 * q + 1] * rstd * gb;
              *(u32x4*)(h + (size_t)row * HLD + q * 512 + lane * 8) = (u32x4){cvt_pk_bf16(a[0], a[1]), cvt_pk_bf16(a[2], a[3]), cvt_pk_bf16(c[0], c[1]), cvt_pk_bf16(c[2], c[3])}; }
      } }
}

__device__ __forceinline__ void phase_norm(const Params& p, bool x_from_input, float* xout_f32, const float* g_post, const float* g_pre, const bf16_t* slabs, int nslab) {
    const int tid = threadIdx.x, wid = tid >> 6, lane = tid & 63;
    const bf16_t* m = (const bf16_t*)(p.ws + OFF_M); bf16_t* xa = (bf16_t*)(p.ws + OFF_XA); bf16_t* h = (bf16_t*)(p.ws + OFF_H);
    for (int row = blockIdx.x * 8 + wid; row < T; row += gridDim.x * 8) {
        float mv[4][8], xv[4][8]; float ss = 0.f;
        if (x_from_input) { const float* x = xrow_in(p, row);
#pragma unroll
            for (int q = 0; q < 4; ++q) { const f32x4 a = *(const f32x4*)(x + q * 512 + lane * 8), c = *(const f32x4*)(x + q * 512 + lane * 8 + 4);
#pragma unroll
                for (int e = 0; e < 4; ++e) { xv[q][e] = a[e]; xv[q][4 + e] = c[e]; } }
        } else { const bf16_t* x = xa + (size_t)row * DM;
#pragma unroll
            for (int q = 0; q < 4; ++q) { const u32x4 w = *(const u32x4*)(x + q * 512 + lane * 8);
#pragma unroll
                for (int e = 0; e < 4; ++e) { xv[q][2 * e] = bf_lo(w[e]); xv[q][2 * e + 1] = bf_hi(w[e]); } } }
        if (row < TP) { const bf16_t* mr = m + (size_t)row * DM;
#pragma unroll
            for (int q = 0; q < 4; ++q) { const u32x4 w = *(const u32x4*)(mr + q * 512 + lane * 8);
#pragma unroll
                for (int e = 0; e < 4; ++e) { mv[q][2 * e] = bf_lo(w[e]); mv[q][2 * e + 1] = bf_hi(w[e]); } }
        } else { const bf16_t* sr = slabs + (size_t)(row - TP) * DM;
#pragma unroll
            for (int q = 0; q < 4; ++q)
#pragma unroll
                for (int e = 0; e < 8; ++e) mv[q][e] = 0.f;
#pragma unroll 4
            for (int k = 0; k < nslab; ++k) {
#pragma unroll
                for (int q = 0; q < 4; ++q) { const u32x4 w = *(const u32x4*)(sr + (size_t)k * 1024 * DM + q * 512 + lane * 8);
#pragma unroll
                    for (int e = 0; e < 4; ++e) { mv[q][2 * e] += bf_lo(w[e]); mv[q][2 * e + 1] += bf_hi(w[e]); } } } }
#pragma unroll
        for (int q = 0; q < 4; ++q)
#pragma unroll
            for (int e = 0; e < 8; ++e) ss += mv[q][e] * mv[q][e];
        ss = wave_sum(ss); const float rstd = rsqrtf(ss * (1.0f / DM) + EPS); float s2 = 0.f;
#pragma unroll
        for (int q = 0; q < 4; ++q) { const f32x4 ga = *(const f32x4*)(g_post + q * 512 + lane * 8), gb = *(const f32x4*)(g_post + q * 512 + lane * 8 + 4);
#pragma unroll
            for (int e = 0; e < 8; ++e) { xv[q][e] += mv[q][e] * rstd * (e < 4 ? ga[e & 3] : gb[e & 3]); s2 += xv[q][e] * xv[q][e]; }
            if (xout_f32) { float* o = xout_f32 + (size_t)row * DM + q * 512 + lane * 8; *(f32x4*)o = (f32x4){xv[q][0], xv[q][1], xv[q][2], xv[q][3]}; *(f32x4*)(o + 4) = (f32x4){xv[q][4], xv[q][5], xv[q][6], xv[q][7]}; }
            else *(u32x4*)(xa + (size_t)row * DM + q * 512 + lane * 8) = (u32x4){cvt_pk_bf16(xv[q][0], xv[q][1]), cvt_pk_bf16(xv[q][2], xv[q][3]), cvt_pk_bf16(xv[q][4], xv[q][5]), cvt_pk_bf16(xv[q][6], xv[q][7])}; }
        if (g_pre) { s2 = wave_sum(s2); const float r2 = rsqrtf(s2 * (1.0f / DM) + EPS);
#pragma unroll
            for (int q = 0; q < 4; ++q) { const f32x4 ga = *(const f32x4*)(g_pre + q * 512 + lane * 8), gb = *(const f32x4*)(g_pre + q * 512 + lane * 8 + 4); float o[8];
#pragma unroll
                for (int e = 0; e < 8; ++e) o[e] = xv[q][e] * r2 * (e < 4 ? ga[e & 3] : gb[e & 3]);
                *(u32x4*)(h + (size_t)row * HLD + q * 512 + lane * 8) = (u32x4){cvt_pk_bf16(o[0], o[1]), cvt_pk_bf16(o[2], o[3]), cvt_pk_bf16(o[4], o[5]), cvt_pk_bf16(o[6], o[7])}; } }
    }
}

__device__ __forceinline__ void phase_glr(const Params& p, int vb) {
    const int tid = threadIdx.x, wid = tid >> 6, lane = tid & 63, fr = lane & 15, fq = lane >> 4;
    const bf16_t* h = (const bf16_t*)(p.ws + OFF_H); const bf16_t* wg = (const bf16_t*)(p.ws + OFF_WG); float* glr = (float*)(p.ws + OFF_GLR);
    for (int grp = ((int)gridDim.x - 1 - vb) * 8 + wid; grp < T / 16; grp += (int)gridDim.x * 8) {
        f32x4 acc = (f32x4){0.f, 0.f, 0.f, 0.f};
        const bf16_t* ap = h + (size_t)(grp * 16 + fr) * HLD + fq * 8; const bf16_t* bp = wg + (size_t)fr * DM + fq * 8;
#pragma unroll 8
        for (int ks = 0; ks < DM / 32; ++ks) { const bf16x8 a = *(const bf16x8*)(ap + ks * 32), b = *(const bf16x8*)(bp + ks * 32); acc = __builtin_amdgcn_mfma_f32_16x16x32_bf16(a, b, acc, 0, 0, 0); }
#pragma unroll
        for (int j = 0; j < 4; ++j) glr[(size_t)(grp * 16 + fq * 4 + j) * 16 + fr] = acc[j];
    }
}

template <int L>
__device__ __forceinline__ void amix_item(const Params& p, LAS unsigned char* lds, int item) {
    const int tid = threadIdx.x, wid = tid >> 6, lane = tid & 63;
    const bf16_t* proj = (const bf16_t*)(p.ws + OFF_PROJ); bf16_t* mix = (bf16_t*)(p.ws + OFF_MIX); const bf16_t* wsm = (const bf16_t*)(p.ws + OFF_WSM);
    const int tb = item >> 2, hp = item & 3; constexpr bool smp = (L == 32); const int row0 = smp ? TP + (tb - 64) * 32 : tb * 128;
    constexpr int VROW = 272;
    LAS float* stats = (LAS float*)(lds + 256 * VROW);
    for (int l0 = wid * 4; l0 < L; l0 += 32) {
        u32x4 a[4], b[4];
#pragma unroll
        for (int r4 = 0; r4 < 4; ++r4) { const bf16_t* r = proj + (size_t)(row0 + l0 + r4) * NE + 1024; a[r4] = *(const u32x4*)(r + lane * 8); b[r4] = *(const u32x4*)(r + 512 + lane * 8); }
#pragma unroll
        for (int r4 = 0; r4 < 4; ++r4) { float s = 0.f, q = 0.f;
#pragma unroll
            for (int e = 0; e < 4; ++e) { const float a0 = bf_lo(a[r4][e]), a1 = bf_hi(a[r4][e]), b0 = bf_lo(b[r4][e]), b1 = bf_hi(b[r4][e]); s += (a0 + a1) + (b0 + b1); q += (a0 * a0 + a1 * a1) + (b0 * b0 + b1 * b1); }
            s = wave_sum(s); q = wave_sum(q); const float mean = s * (1.0f / 1024.f), var = fmaxf(q * (1.0f / 1024.f) - mean * mean, 0.f);
            if (lane == 0) { stats[(l0 + r4) * 2] = mean; stats[(l0 + r4) * 2 + 1] = rsqrtf(var + EPS); } }
    }
    __syncthreads();
    const int c0 = hp * 256; const float* gain = p.in[14];
    for (int wi0 = tid; wi0 < L * 32; wi0 += 2048) {
        u32x4 av4[4];
#pragma unroll
        for (int u4 = 0; u4 < 4; ++u4) { const int wi = wi0 + u4 * 512; if (wi < L * 32) { const int j = wi % L, cg8 = wi / L; av4[u4] = *(const u32x4*)(proj + (size_t)(row0 + j) * NE + 1024 + c0 + cg8 * 8); } }
#pragma unroll
        for (int u4 = 0; u4 < 4; ++u4) { const int wi = wi0 + u4 * 512; if (wi < L * 32) { const int j = wi % L, cg8 = wi / L;
            const u32x4 a = av4[u4]; const float mean = stats[j * 2], rstd = stats[j * 2 + 1];
            const f32x4 g0 = *(const f32x4*)(gain + c0 + cg8 * 8), g1 = *(const f32x4*)(gain + c0 + cg8 * 8 + 4); float o[8];
#pragma unroll
            for (int e = 0; e < 4; ++e) { o[2 * e] = (bf_lo(a[e]) - mean) * rstd * (e < 2 ? g0[2 * e] : g1[2 * e - 4]); o[2 * e + 1] = (bf_hi(a[e]) - mean) * rstd * (e < 2 ? g0[2 * e + 1] : g1[2 * e - 3]); }
#pragma unroll
            for (int e = 0; e < 8; ++e) *(LAS bf16_t*)(lds + (cg8 * 8 + e) * VROW + j * 2) = (bf16_t)(cvt_pk_bf16(o[e], 0.f) & 0xffffu);
            if (smp) { float* av = p.out + O_AV + (size_t)(row0 - TP + j) * 1024 + c0 + cg8 * 8; *(f32x4*)av = (f32x4){o[0], o[1], o[2], o[3]}; *(f32x4*)(av + 4) = (f32x4){o[4], o[5], o[6], o[7]}; } } }
    }
    __syncthreads();
    const int hh = wid >> 2, dq = wid & 3, head = hp * 2 + hh, l31 = lane & 31, lh = lane >> 5;
    constexpr int nit = L >> 5, nks = L >> 4;
    f32x16 acc[4];
#pragma unroll
    for (int i = 0; i < 4; ++i)
#pragma unroll
        for (int r = 0; r < 16; ++r) acc[i][r] = 0.f;
    const LAS unsigned char* ap = lds + (hh * 128 + dq * 32 + l31) * VROW + lh * 16;
    const bf16_t* bp = wsm + (size_t)head * 16384 + (size_t)l31 * 128 + lh * 8;
    bf16x8 bq[4], bn[4];
#pragma unroll
    for (int i = 0; i < 4; ++i) { bq[i] = (bf16x8){0, 0, 0, 0, 0, 0, 0, 0}; if (i < nit) bq[i] = *(const bf16x8*)(bp + (size_t)i * 32 * 128); }
#pragma unroll
    for (int ks = 0; ks < nks; ++ks) {
        const bf16x8 a = *(const LAS bf16x8*)(ap + ks * 32);
#pragma unroll
        for (int i = 0; i < 4; ++i) { bn[i] = bq[i]; if (i < nit && ks + 1 < nks) bn[i] = *(const bf16x8*)(bp + (size_t)i * 32 * 128 + (ks + 1) * 16); }
#pragma unroll
        for (int i = 0; i < 4; ++i) if (i < nit) acc[i] = __builtin_amdgcn_mfma_f32_32x32x16_bf16(a, bq[i], acc[i], 0, 0, 0);
#pragma unroll
        for (int i = 0; i < 4; ++i) bq[i] = bn[i];
    }
    const float* bs = p.in[13] + head * 128;
#pragma unroll
    for (int i = 0; i < 4; ++i) if (i < nit) { const int ii = i * 32 + l31, row = row0 + ii; const float bias = bs[ii];
#pragma unroll
        for (int rg = 0; rg < 4; ++rg) { const int d = dq * 32 + rg * 8 + lh * 4, c = head * 128 + d; const u32x2 uu = *(const u32x2*)(proj + (size_t)row * NE + c);
            u32x2 w; w.x = cvt_pk_bf16(bf_lo(uu.x) * (acc[i][rg * 4] + bias), bf_hi(uu.x) * (acc[i][rg * 4 + 1] + bias)); w.y = cvt_pk_bf16(bf_lo(uu.y) * (acc[i][rg * 4 + 2] + bias), bf_hi(uu.y) * (acc[i][rg * 4 + 3] + bias));
            *(u32x2*)(mix + (size_t)row * HLD + c) = w; } }
    __syncthreads();
}

__device__ __forceinline__ void gla_item_decode(int it, int& s, int& h, int& row0, int& L) {
    if (it < 512) { s = it >> 8; h = (it >> 6) & 3; row0 = s * 4096 + (it & 63) * 64; L = 64; } else { const int q = it - 512; s = q >> 2; h = q & 3; row0 = TP + s * 32; L = 32; }
}
template <int L>
__device__ __forceinline__ void glau_item(const Params& p, LAS unsigned char* lds, int it) {
    const int tid = threadIdx.x, wid = tid >> 6, lane = tid & 63;
    const bf16_t* proj = (const bf16_t*)(p.ws + OFF_PROJ); const float* glr = (const float*)(p.ws + OFF_GLR);
    int s, h, row0, Lrt; gla_item_decode(it, s, h, row0, Lrt); constexpr bool smp = (L == 32);
    constexpr int KROW = 144;
    LAS unsigned char* kdT = lds;
    LAS unsigned char* vT = lds + 128 * KROW;
    LAS float* glt = (LAS float*)(lds + 384 * KROW);
    LAS float* part = glt + 64 * 16;
    LAS float* totl = part + 4 * 128;
    if (tid < L * 4) *(LAS f32x4*)(glt + tid * 4) = *(const f32x4*)(glr + (size_t)row0 * 16 + tid * 4);
    __syncthreads();
    const int d = tid & 127, lq = tid >> 7; constexpr int Lq = L >> 2;
    float wg[16];
#pragma unroll
    for (int r = 0; r < 16; ++r) wg[r] = p.in[15][r * 512 + h * 128 + d];
    const float gb = p.in[16][h * 128 + d];
    float cum[16]; float run = 0.f;
#pragma unroll
    for (int i = 0; i < 16; ++i) { cum[i] = 0.f; if (i < Lq) { const int l = lq * Lq + i; float x = gb;
#pragma unroll
            for (int r4 = 0; r4 < 4; ++r4) { const f32x4 gg = *(const LAS f32x4*)(glt + l * 16 + r4 * 4); x += gg[0] * wg[r4 * 4] + gg[1] * wg[r4 * 4 + 1] + gg[2] * wg[r4 * 4 + 2] + gg[3] * wg[r4 * 4 + 3]; }
            const float ls = fminf(x, 0.f) - __logf(1.0f + __expf(-fabsf(x)));
            run += ls * (1.0f / 16.0f); cum[i] = run; } }
    part[lq * 128 + d] = run;
    __syncthreads();
    float offs = 0.f, tot = 0.f;
#pragma unroll
    for (int q = 0; q < 4; ++q) { const float pv = part[q * 128 + d]; tot += pv; if (q < lq) offs += pv; }
    if (lq == 0) { totl[d] = tot; ((float*)(p.ws + OFF_DECAY))[(size_t)it * 128 + d] = __expf(tot); }
    { unsigned pk[8];
#pragma unroll
      for (int i = 0; i < 16; i += 2) { float v0 = 0.f, v1 = 0.f;
          if (i < Lq) { const int l = lq * Lq + i; v0 = bf1(proj[(size_t)(row0 + l) * NE + 2560 + h * 128 + d]) * __expf(tot - offs - cum[i]); v1 = bf1(proj[(size_t)(row0 + l + 1) * NE + 2560 + h * 128 + d]) * __expf(tot - offs - cum[i + 1]); }
          pk[i >> 1] = cvt_pk_bf16(v0, v1); }
      LAS unsigned char* dstp = kdT + d * KROW + lq * Lq * 2;
      *(LAS u32x4*)dstp = (u32x4){pk[0], pk[1], pk[2], pk[3]};
      if (Lq == 16) *(LAS u32x4*)(dstp + 16) = (u32x4){pk[4], pk[5], pk[6], pk[7]}; }
    { const int v = tid & 255, hf = tid >> 8; constexpr int Lh = L >> 1; unsigned pk[16];
#pragma unroll
      for (int i = 0; i < 32; i += 2) { unsigned a = 0, b = 0; if (i < Lh) { const int l = hf * Lh + i; a = proj[(size_t)(row0 + l) * NE + 3072 + h * 256 + v]; b = proj[(size_t)(row0 + l + 1) * NE + 3072 + h * 256 + v]; } pk[i >> 1] = a | (b << 16); }
      LAS unsigned char* dstp = vT + v * KROW + hf * Lh * 2;
      *(LAS u32x4*)dstp = (u32x4){pk[0], pk[1], pk[2], pk[3]}; *(LAS u32x4*)(dstp + 16) = (u32x4){pk[4], pk[5], pk[6], pk[7]};
      if (Lh == 32) { *(LAS u32x4*)(dstp + 32) = (u32x4){pk[8], pk[9], pk[10], pk[11]}; *(LAS u32x4*)(dstp + 48) = (u32x4){pk[12], pk[13], pk[14], pk[15]}; } }
    __syncthreads();
    const int l31 = lane & 31, lh = lane >> 5, vs = wid * 32; constexpr int nks = L >> 4;
    f32x16 acc[4];
#pragma unroll
    for (int i = 0; i < 4; ++i)
#pragma unroll
        for (int r = 0; r < 16; ++r) acc[i][r] = 0.f;
#pragma unroll
    for (int ks = 0; ks < nks; ++ks) { const bf16x8 b = *(const LAS bf16x8*)(vT + (vs + l31) * KROW + ks * 32 + lh * 16);
#pragma unroll
        for (int dt = 0; dt < 4; ++dt) { const bf16x8 a = *(const LAS bf16x8*)(kdT + (dt * 32 + l31) * KROW + ks * 32 + lh * 16); acc[dt] = __builtin_amdgcn_mfma_f32_32x32x16_bf16(a, b, acc[dt], 0, 0, 0); } }
    const int v = vs + l31;
    if (!smp) { bf16_t* ut = (bf16_t*)(p.ws + OFF_UT) + ((size_t)it * 256 + v) * 128;
#pragma unroll
        for (int dt = 0; dt < 4; ++dt)
#pragma unroll
            for (int rg = 0; rg < 4; ++rg) { u32x2 w; w.x = cvt_pk_bf16(acc[dt][rg * 4], acc[dt][rg * 4 + 1]); w.y = cvt_pk_bf16(acc[dt][rg * 4 + 2], acc[dt][rg * 4 + 3]); *(u32x2*)(ut + dt * 32 + rg * 8 + lh * 4) = w; }
    } else { const float* s0 = p.in[2] + ((size_t)s * 4 + h) * 128 * 256; float* so = p.out + O_GLA_S + ((size_t)s * 4 + h) * 128 * 256; bf16_t* st = (bf16_t*)(p.ws + OFF_ST) + ((size_t)it * 256 + v) * 128;
#pragma unroll
        for (int dt = 0; dt < 4; ++dt)
#pragma unroll
            for (int rg = 0; rg < 4; ++rg) { const int dd = dt * 32 + rg * 8 + lh * 4; float sv[4];
#pragma unroll
                for (int e = 0; e < 4; ++e) { sv[e] = __expf(totl[dd + e]) * s0[(size_t)(dd + e) * 256 + v] + acc[dt][rg * 4 + e]; so[(size_t)(dd + e) * 256 + v] = sv[e]; }
                u32x2 w; w.x = cvt_pk_bf16(sv[0], sv[1]); w.y = cvt_pk_bf16(sv[2], sv[3]); *(u32x2*)(st + dd) = w; } }
    __syncthreads();
}

__device__ __forceinline__ void phase_gla_scan(const Params& p) {
    for (int gtid = blockIdx.x * 512 + threadIdx.x; gtid < 2 * 4 * 256 * 64; gtid += gridDim.x * 512) {
    const int dq = gtid & 63, v = (gtid >> 6) & 255, sh = gtid >> 14;
    const bf16_t* ut = (const bf16_t*)(p.ws + OFF_UT); const float* dec = (const float*)(p.ws + OFF_DECAY); bf16_t* st = (bf16_t*)(p.ws + OFF_ST);
    f32x2 S = (f32x2){0.f, 0.f};
#pragma unroll 16
    for (int c = 0; c < 64; ++c) { const int it = sh * 64 + c; const unsigned uw = *(const unsigned*)(ut + ((size_t)it * 256 + v) * 128 + dq * 2); const f32x2 u = (f32x2){bf_lo(uw), bf_hi(uw)}, dc = *(const f32x2*)(dec + (size_t)it * 128 + dq * 2);
        S = S * dc + u; *(unsigned*)(st + ((size_t)it * 256 + v) * 128 + dq * 2) = cvt_pk_bf16(S[0], S[1]); }
    float* o = p.out + O_GLA_P + (size_t)sh * 128 * 256;
    o[(size_t)(dq * 2) * 256 + v] = S[0]; o[(size_t)(dq * 2 + 1) * 256 + v] = S[1];
    }
}

template <int L>
__device__ __forceinline__ void glao_item(const Params& p, LAS unsigned char* lds, int it) {
    const int tid = threadIdx.x, wid = tid >> 6, lane = tid & 63, l31 = lane & 31, lh = lane >> 5;
    const bf16_t* proj = (const bf16_t*)(p.ws + OFF_PROJ); bf16_t* mix = (bf16_t*)(p.ws + OFF_MIX);
    int s, h, row0, Lrt; gla_item_decode(it, s, h, row0, Lrt);
    constexpr int nlt = L >> 5; const int vs = wid * 32;
    LAS float* red = (LAS float*)lds;
    const bf16_t* ap = (const bf16_t*)(p.ws + OFF_ST) + ((size_t)it * 256 + vs + l31) * 128 + lh * 8;
    const bf16_t* bp = proj + (size_t)(row0 + l31) * NE + 2048 + h * 128 + lh * 8;
    f32x16 acc[2];
#pragma unroll
    for (int i = 0; i < 2; ++i)
#pragma unroll
        for (int r = 0; r < 16; ++r) acc[i][r] = 0.f;
#pragma unroll
    for (int ks = 0; ks < 8; ++ks) { const bf16x8 a = *(const bf16x8*)(ap + ks * 16);
#pragma unroll
        for (int lt = 0; lt < 2; ++lt) if (lt < nlt) { const bf16x8 b = *(const bf16x8*)(bp + (size_t)lt * 32 * NE + ks * 16); acc[lt] = __builtin_amdgcn_mfma_f32_32x32x16_bf16(a, b, acc[lt], 0, 0, 0); } }
    const float qs = 0.08838834764831845f;
#pragma unroll
    for (int lt = 0; lt < 2; ++lt) { float ss = 0.f;
#pragma unroll
        for (int r = 0; r < 16; ++r) { acc[lt][r] *= qs; ss += acc[lt][r] * acc[lt][r]; }
        ss += __shfl_xor(ss, 32);
        if (lh == 0) red[wid * 64 + lt * 32 + l31] = ss; }
    __syncthreads();
    const float* og = p.in[17] + h * 256;
#pragma unroll
    for (int lt = 0; lt < 2; ++lt) if (lt < nlt) { float tot = 0.f;
#pragma unroll
        for (int w = 0; w < 8; ++w) tot += red[w * 64 + lt * 32 + l31];
        const float rstd = rsqrtf(tot * (1.0f / 256.f) + EPS); const int row = row0 + lt * 32 + l31;
#pragma unroll
        for (int rg = 0; rg < 4; ++rg) { const int vv = vs + rg * 8 + lh * 4; const u32x2 rr = *(const u32x2*)(proj + (size_t)row * NE + 4096 + h * 256 + vv); const f32x4 gg = *(const f32x4*)(og + vv);
            const float r0 = bf_lo(rr.x), r1 = bf_hi(rr.x), r2 = bf_lo(rr.y), r3 = bf_hi(rr.y);
            u32x2 w; w.x = cvt_pk_bf16(acc[lt][rg * 4] * rstd * gg[0] * r0 * sigmoidf(r0), acc[lt][rg * 4 + 1] * rstd * gg[1] * r1 * sigmoidf(r1));
            w.y = cvt_pk_bf16(acc[lt][rg * 4 + 2] * rstd * gg[2] * r2 * sigmoidf(r2), acc[lt][rg * 4 + 3] * rstd * gg[3] * r3 * sigmoidf(r3));
            *(u32x2*)(mix + (size_t)row * HLD + 1024 + h * 256 + vv) = w; } }
    __syncthreads();
}

__device__ __forceinline__ void phase_convfix(const Params& p, int layer) {
    bf16_t* ACT = (bf16_t*)(p.ws + OFF_VAL); const bf16_t* GF = (const bf16_t*)(p.ws + OFF_GF); const bf16_t* VF = (const bf16_t*)(p.ws + OFF_VF); const bf16_t* GL = (const bf16_t*)(p.ws + OFF_GL);
    const float* cw = p.in[33] + (size_t)layer * 3 * DFF; const float* cb = p.in[34] + (size_t)layer * DFF; const float* st = p.in[6] + (size_t)layer * 32 * 2 * DFF;
    for (int idx = blockIdx.x * 512 + threadIdx.x; idx < 160 * 704; idx += gridDim.x * 512) {
        const int pr = idx / 704, c = (idx - pr * 704) * 8;
        const int ra = pr < 128 ? pr * 64 : TP + (pr - 128) * 32, hb = ra >> 5;
        float w0[8], w1[8], w2[8], bb[8], h0[8], h1[8], ga[8], gb[8], va[8], vb[8];
#pragma unroll
        for (int e = 0; e < 8; e += 4) { const f32x4 a = *(const f32x4*)(cw + c + e), b = *(const f32x4*)(cw + DFF + c + e), d = *(const f32x4*)(cw + 2 * DFF + c + e), f = *(const f32x4*)(cb + c + e);
#pragma unroll
            for (int j = 0; j < 4; ++j) { w0[e + j] = a[j]; w1[e + j] = b[j]; w2[e + j] = d[j]; bb[e + j] = f[j]; } }
        if (ra >= TP) { const float* sp = st + (size_t)(pr - 128) * 2 * DFF + c;
#pragma unroll
            for (int e = 0; e < 8; e += 4) { const f32x4 a = *(const f32x4*)(sp + e), b = *(const f32x4*)(sp + DFF + e);
#pragma unroll
                for (int j = 0; j < 4; ++j) { h0[e + j] = a[j]; h1[e + j] = b[j]; } } }
        else if ((ra & 4095) == 0) {
#pragma unroll
            for (int e = 0; e < 8; ++e) { h0[e] = 0.f; h1[e] = 0.f; } }
        else { const u32x4 a = *(const u32x4*)(GL + ((size_t)((ra >> 6) - 1) * 2) * DFF + c), b = *(const u32x4*)(GL + ((size_t)((ra >> 6) - 1) * 2 + 1) * DFF + c);
#pragma unroll
            for (int e = 0; e < 4; ++e) { h0[2 * e] = bf_lo(a[e]); h0[2 * e + 1] = bf_hi(a[e]); h1[2 * e] = bf_lo(b[e]); h1[2 * e + 1] = bf_hi(b[e]); } }
        { const u32x4 a = *(const u32x4*)(GF + ((size_t)hb * 2) * DFF + c), b = *(const u32x4*)(GF + ((size_t)hb * 2 + 1) * DFF + c), d = *(const u32x4*)(VF + ((size_t)hb * 2) * DFF + c), f = *(const u32x4*)(VF + ((size_t)hb * 2 + 1) * DFF + c);
#pragma unroll
          for (int e = 0; e < 4; ++e) { ga[2 * e] = bf_lo(a[e]); ga[2 * e + 1] = bf_hi(a[e]); gb[2 * e] = bf_lo(b[e]); gb[2 * e + 1] = bf_hi(b[e]); va[2 * e] = bf_lo(d[e]); va[2 * e + 1] = bf_hi(d[e]); vb[2 * e] = bf_lo(f[e]); vb[2 * e + 1] = bf_hi(f[e]); } }
        float oa[8], ob[8];
#pragma unroll
        for (int e = 0; e < 8; ++e) { oa[e] = gelu_t(bb[e] + w0[e] * h0[e] + w1[e] * h1[e] + w2[e] * ga[e]) * va[e]; ob[e] = gelu_t(bb[e] + w0[e] * h1[e] + w1[e] * ga[e] + w2[e] * gb[e]) * vb[e]; }
        *(u32x4*)(ACT + (size_t)ra * ALD + c) = (u32x4){cvt_pk_bf16(oa[0], oa[1]), cvt_pk_bf16(oa[2], oa[3]), cvt_pk_bf16(oa[4], oa[5]), cvt_pk_bf16(oa[6], oa[7])};
        *(u32x4*)(ACT + (size_t)(ra + 1) * ALD + c) = (u32x4){cvt_pk_bf16(ob[0], ob[1]), cvt_pk_bf16(ob[2], ob[3]), cvt_pk_bf16(ob[4], ob[5]), cvt_pk_bf16(ob[6], ob[7])};
    }
}

template <int W>
__device__ __forceinline__ void pool_item(const Params& p, const float* proj2, bf16_t* delta, int r8, int c) {
    const int row0 = r8 * 8; const bool smp = row0 >= TP;
    const int seq = smp ? (row0 - TP) >> 5 : row0 >> 12, t0 = smp ? (row0 - TP) & 31 : row0 & 4095, rowbase = row0 - t0;
    const float* spool = p.in[3] + (size_t)seq * 15 * 1024 + c;
    f32x4 xs[W + 7];
#pragma unroll
    for (int j = 0; j < W + 7; ++j) { const int t = t0 - (W - 1) + j; const bool hist = smp && t < 0; const bool ok = t >= 0 || hist;
        const float* ptr = hist ? spool + (size_t)(15 + t) * 1024 : proj2 + (size_t)(rowbase + (t >= 0 ? t : 0)) * DM + c;
        const f32x4 v = *(const f32x4*)ptr; xs[j] = ok ? v : (f32x4){0.f, 0.f, 0.f, 0.f}; }
    f32x4 Wd = xs[0];
#pragma unroll
    for (int j = 1; j < W; ++j) Wd = Wd + xs[j];
#pragma unroll
    for (int u = 0; u < 8; ++u) { const int t = t0 + u; const f32x4 x = xs[u + W - 1];
        const float cnt = smp ? (float)W : (float)((t + 1) < W ? (t + 1) : W); const f32x4 dl = Wd * (1.0f / cnt) - x;
        u32x2 o; o.x = cvt_pk_bf16(dl[0], dl[1]); o.y = cvt_pk_bf16(dl[2], dl[3]); *(u32x2*)(delta + (size_t)(row0 + u) * YLD + c) = o;
        if (!smp && t >= 4081) *(f32x4*)(p.out + O_POOL_P + ((size_t)seq * 15 + (t - 4081)) * 1024 + c) = x;
        if (smp && t >= 17) *(f32x4*)(p.out + O_POOL_S + ((size_t)seq * 15 + (t - 17)) * 1024 + c) = x;
        if (u < 7) Wd = Wd + xs[u + W] - xs[u]; }
}
__device__ __forceinline__ void phase_pool(const Params& p) {
    const float* proj2 = (const float*)(p.ws + OFF_PROJ2); bf16_t* delta = (bf16_t*)(p.ws + OFF_DELTA);
    for (int idx = blockIdx.x * 512 + threadIdx.x; idx < (T / 8) * 256; idx += gridDim.x * 512) {
        const int r8 = idx >> 8, c = (idx & 255) * 4, g = c >> 8;
        if (g == 0) pool_item<2>(p, proj2, delta, r8, c); else if (g == 1) pool_item<4>(p, proj2, delta, r8, c);
        else if (g == 2) pool_item<8>(p, proj2, delta, r8, c); else pool_item<16>(p, proj2, delta, r8, c);
    }
}

template <int PASS>
__device__ __forceinline__ void phase_s5(const Params& p, LAS unsigned char* lds, int nitems) {
    const int tid = threadIdx.x, wid = tid >> 6, lane = tid & 63, hcol = lane & 15, q4 = lane >> 4;
    const float* proj2 = (const float*)(p.ws + OFF_PROJ2); float* Eb = (float*)(p.ws + OFF_E); bf16_t* yb = (bf16_t*)(p.ws + OFF_YB);
    LAS float* ut = (LAS float*)lds;
    constexpr int SROW = 272;
    LAS unsigned char* sb = lds + 32768 + wid * 32 * SROW;
    int oct_cur = -1;
    float lbr = 0.f, lbi = 0.f, p64r = 0.f, p64i = 0.f, dsk = 0.f; f32x2 bb[16]; bf16x8 Bc[4];
#pragma unroll
    for (int i = 0; i < 16; ++i) bb[i] = (f32x2){0.f, 0.f};
#pragma unroll
    for (int i = 0; i < 4; ++i) Bc[i] = (bf16x8){0, 0, 0, 0, 0, 0, 0, 0};
    f32x4 un[4];
    auto issue_u = [&](int item) {
        const int cs = item >> 3, oct = item & 7; const bool smp = cs >= 128;
        const int b = smp ? cs - 128 : cs >> 6, ch = smp ? 0 : cs & 63, L = smp ? 32 : 64, row0 = smp ? TP + b * 32 : b * 4096 + ch * 64;
#pragma unroll
        for (int k = 0; k < 4; ++k) { const int i = tid + k * 512; un[k] = (f32x4){0.f, 0.f, 0.f, 0.f}; if (i < L * 32) un[k] = *(const f32x4*)(proj2 + (size_t)(row0 + (i >> 5)) * DM + 1024 + oct * 128 + (i & 31) * 4); }
    };
    if ((int)blockIdx.x < nitems) issue_u((int)blockIdx.x);
    for (int item = blockIdx.x; item < nitems; item += gridDim.x) {
        const int cs = item >> 3, oct = item & 7, g = oct * 8 + wid; const bool smp = cs >= 128;
        const int b = smp ? cs - 128 : cs >> 6, ch = smp ? 0 : cs & 63, L = smp ? 32 : 64, row0 = smp ? TP + b * 32 : b * 4096 + ch * 64;
#pragma unroll
        for (int k = 0; k < 4; ++k) { const int i = tid + k * 512; if (i < L * 32) *(LAS f32x4*)(ut + (i >> 5) * 128 + (i & 31) * 4) = un[k]; }
        if (item + (int)gridDim.x < nitems) issue_u(item + (int)gridDim.x);
        if (oct != oct_cur) {
            oct_cur = oct;
            const float are = p.in[22][g * 64 + lane], aim = p.in[23][g * 64 + lane], dt = __expf(p.in[24][g]);
            const float er = __expf(are * dt); float rev = aim * dt * 0.15915494309189535f; rev -= floorf(rev);
            lbr = er * __builtin_amdgcn_cosf(rev); lbi = er * __builtin_amdgcn_sinf(rev);
            const float den = 1.0f / (are * are + aim * aim); const float nr = lbr - 1.0f, ni = lbi;
            const float cr = (nr * are + ni * aim) * den, ci = (ni * are - nr * aim) * den;
            const float* br = p.in[25] + ((size_t)g * 64 + lane) * 16; const float* bi = p.in[26] + ((size_t)g * 64 + lane) * 16;
#pragma unroll
            for (int q = 0; q < 4; ++q) { const f32x4 x = *(const f32x4*)(br + q * 4), y = *(const f32x4*)(bi + q * 4);
#pragma unroll
                for (int e = 0; e < 4; ++e) bb[q * 4 + e] = (f32x2){cr * x[e] - ci * y[e], cr * y[e] + ci * x[e]}; }
            if (PASS == 2) {
                p64r = lbr; p64i = lbi;
#pragma unroll
                for (int q = 0; q < 6; ++q) { const float t = p64r * p64r - p64i * p64i; p64i = 2.f * p64r * p64i; p64r = t; }
#pragma unroll
                for (int ks = 0; ks < 4; ++ks) { const float* src = (ks < 2 ? p.in[27] : p.in[28]) + ((size_t)g * 16 + hcol) * 64 + (ks & 1) * 32 + q4 * 8; const float sg = ks < 2 ? 1.f : -1.f;
                    const f32x4 x = *(const f32x4*)src, y = *(const f32x4*)(src + 4); u32x4 w; w.x = cvt_pk_bf16(sg * x[0], sg * x[1]); w.y = cvt_pk_bf16(sg * x[2], sg * x[3]); w.z = cvt_pk_bf16(sg * y[0], sg * y[1]); w.w = cvt_pk_bf16(sg * y[2], sg * y[3]);
                    Bc[ks] = __builtin_bit_cast(bf16x8, w); }
                dsk = p.in[29][g * 16 + hcol]; }
        }
        float sr = 0.f, si = 0.f;
        if (PASS == 2) {
            if (smp) { sr = p.in[4][((size_t)b * 64 + g) * 64 + lane]; si = p.in[5][((size_t)b * 64 + g) * 64 + lane]; }
            else { const float* e0 = Eb + (((size_t)b * 64) * 64 + g) * 128 + lane * 2;
                for (int j0 = 0; j0 < ch; j0 += 16) { f32x2 ev[16];
#pragma unroll
                    for (int jj = 0; jj < 16; ++jj) { const int j = (j0 + jj) < ch ? (j0 + jj) : (ch - 1); ev[jj] = *(const f32x2*)(e0 + (size_t)j * 64 * 128); }
#pragma unroll
                    for (int jj = 0; jj < 16; ++jj) { const bool on = (j0 + jj) < ch; const float t = p64r * sr - p64i * si + ev[jj].x, u2 = p64r * si + p64i * sr + ev[jj].y; sr = on ? t : sr; si = on ? u2 : si; } } }
        }
        __syncthreads();
        for (int sub = 0; sub < L; sub += 32) {
#pragma unroll 2
            for (int tt = 0; tt < 32; ++tt) { const int t = sub + tt; f32x2 bu0 = (f32x2){0.f, 0.f}, bu1 = (f32x2){0.f, 0.f};
#pragma unroll
                for (int q = 0; q < 4; ++q) { const f32x4 u = *(const LAS f32x4*)(ut + t * 128 + wid * 16 + q * 4);
                    bu0 = bu0 + bb[q * 4] * u[0]; bu1 = bu1 + bb[q * 4 + 1] * u[1]; bu0 = bu0 + bb[q * 4 + 2] * u[2]; bu1 = bu1 + bb[q * 4 + 3] * u[3]; }
                const float bur = bu0[0] + bu1[0], bui = bu0[1] + bu1[1];
                const float nr2 = lbr * sr - lbi * si + bur; si = lbr * si + lbi * sr + bui; sr = nr2;
                if (PASS == 2) { *(LAS bf16_t*)(sb + tt * SROW + lane * 2) = (bf16_t)(cvt_pk_bf16(sr, 0.f) & 0xffffu); *(LAS bf16_t*)(sb + tt * SROW + 128 + lane * 2) = (bf16_t)(cvt_pk_bf16(si, 0.f) & 0xffffu); } }
            if (PASS == 2) {
                __syncthreads();
#pragma unroll
                for (int mt = 0; mt < 2; ++mt) { f32x4 acc = (f32x4){0.f, 0.f, 0.f, 0.f};
#pragma unroll
                    for (int ks = 0; ks < 4; ++ks) { const bf16x8 a = *(const LAS bf16x8*)(sb + (mt * 16 + hcol) * SROW + ks * 64 + q4 * 16); acc = __builtin_amdgcn_mfma_f32_16x16x32_bf16(a, Bc[ks], acc, 0, 0, 0); }
#pragma unroll
                    for (int j = 0; j < 4; ++j) { const int t = sub + mt * 16 + q4 * 4 + j; const float y = acc[j] + dsk * ut[t * 128 + wid * 16 + hcol];
                        yb[(size_t)(row0 + t) * YLD + g * 16 + hcol] = (bf16_t)(cvt_pk_bf16(gelu_t(y), 0.f) & 0xffffu); } }
                __syncthreads();
            }
        }
        if (PASS == 1) { *(f32x2*)(Eb + ((((size_t)b * 64 + ch) * 64) + g) * 128 + lane * 2) = (f32x2){sr, si}; }
        else { if (smp) { p.out[O_S5RE_S + ((size_t)b * 64 + g) * 64 + lane] = sr; p.out[O_S5IM_S + ((size_t)b * 64 + g) * 64 + lane] = si; }
               else if (ch == 63) { p.out[O_S5RE_P + ((size_t)b * 64 + g) * 64 + lane] = sr; p.out[O_S5IM_P + ((size_t)b * 64 + g) * 64 + lane] = si; } }
        __syncthreads();
    }
}


__device__ __forceinline__ void phase_s5_ends(const Params& p, LAS unsigned char* lds, int nitems) {
    const int tid = threadIdx.x, wid = tid >> 6, lane = tid & 63, l31 = lane & 31, hh = lane >> 5;
    const float* proj2 = (const float*)(p.ws + OFF_PROJ2); float* Eb = (float*)(p.ws + OFF_E);
    constexpr int UROW = 272;
    int oct_cur = -1;
    float lr[2] = {0.f, 0.f}, li[2] = {0.f, 0.f}, l4r[2] = {0.f, 0.f}, l4i[2] = {0.f, 0.f}; bf16x8 Bre[2], Bim[2];
#pragma unroll
    for (int i = 0; i < 2; ++i) { Bre[i] = (bf16x8){0, 0, 0, 0, 0, 0, 0, 0}; Bim[i] = Bre[i]; }
    for (int item = blockIdx.x; item < nitems; item += gridDim.x) {
        const int cs = item >> 3, oct = item & 7, g = oct * 8 + wid, b = cs >> 6, ch = cs & 63, row0 = b * 4096 + ch * 64;
#pragma unroll
        for (int k = 0; k < 4; ++k) { const int i = tid + k * 512, t = i >> 5, q = i & 31; const f32x4 v = *(const f32x4*)(proj2 + (size_t)(row0 + t) * DM + 1024 + oct * 128 + q * 4);
            u32x2 w; w.x = cvt_pk_bf16(v[0], v[1]); w.y = cvt_pk_bf16(v[2], v[3]); *(LAS u32x2*)(lds + t * UROW + q * 8) = w; }
        if (oct != oct_cur) { oct_cur = oct;
            const float dt = __expf(p.in[24][g]);
#pragma unroll
            for (int sx = 0; sx < 2; ++sx) { const int st = l31 + 32 * sx;
                const float are = p.in[22][g * 64 + st], aim = p.in[23][g * 64 + st];
                const float er = __expf(are * dt); float rev = aim * dt * 0.15915494309189535f; rev -= floorf(rev);
                lr[sx] = er * __builtin_amdgcn_cosf(rev); li[sx] = er * __builtin_amdgcn_sinf(rev);
                const float den = 1.0f / (are * are + aim * aim); const float nr = lr[sx] - 1.0f, ni = li[sx];
                const float cr = (nr * are + ni * aim) * den, ci = (ni * are - nr * aim) * den;
                const float* br = p.in[25] + ((size_t)g * 64 + st) * 16 + hh * 8; const float* bi = p.in[26] + ((size_t)g * 64 + st) * 16 + hh * 8;
                const f32x4 x0 = *(const f32x4*)br, x1 = *(const f32x4*)(br + 4), y0 = *(const f32x4*)bi, y1 = *(const f32x4*)(bi + 4);
                u32x4 wr, wi;
                wr.x = cvt_pk_bf16(cr * x0[0] - ci * y0[0], cr * x0[1] - ci * y0[1]); wr.y = cvt_pk_bf16(cr * x0[2] - ci * y0[2], cr * x0[3] - ci * y0[3]);
                wr.z = cvt_pk_bf16(cr * x1[0] - ci * y1[0], cr * x1[1] - ci * y1[1]); wr.w = cvt_pk_bf16(cr * x1[2] - ci * y1[2], cr * x1[3] - ci * y1[3]);
                wi.x = cvt_pk_bf16(cr * y0[0] + ci * x0[0], cr * y0[1] + ci * x0[1]); wi.y = cvt_pk_bf16(cr * y0[2] + ci * x0[2], cr * y0[3] + ci * x0[3]);
                wi.z = cvt_pk_bf16(cr * y1[0] + ci * x1[0], cr * y1[1] + ci * x1[1]); wi.w = cvt_pk_bf16(cr * y1[2] + ci * x1[2], cr * y1[3] + ci * x1[3]);
                Bre[sx] = __builtin_bit_cast(bf16x8, wr); Bim[sx] = __builtin_bit_cast(bf16x8, wi);
                const float t2r = lr[sx] * lr[sx] - li[sx] * li[sx], t2i = 2.f * lr[sx] * li[sx]; l4r[sx] = t2r * t2r - t2i * t2i; l4i[sx] = 2.f * t2r * t2i; } }
        __syncthreads();
        float sr[2] = {0.f, 0.f}, si[2] = {0.f, 0.f};
#pragma unroll
        for (int sub = 0; sub < 2; ++sub) {
            const bf16x8 a = *(const LAS bf16x8*)(lds + (sub * 32 + l31) * UROW + (wid * 16 + hh * 8) * 2);
            f32x16 z;
#pragma unroll
            for (int r = 0; r < 16; ++r) z[r] = 0.f;
#pragma unroll
            for (int sx = 0; sx < 2; ++sx) { const f32x16 ar = __builtin_amdgcn_mfma_f32_32x32x16_bf16(a, Bre[sx], z, 0, 0, 0), ai = __builtin_amdgcn_mfma_f32_32x32x16_bf16(a, Bim[sx], z, 0, 0, 0);
#pragma unroll
                for (int ag = 0; ag < 4; ++ag) {
#pragma unroll
                    for (int bq = 0; bq < 4; ++bq) { const float t = lr[sx] * sr[sx] - li[sx] * si[sx] + ar[ag * 4 + bq]; si[sx] = lr[sx] * si[sx] + li[sx] * sr[sx] + ai[ag * 4 + bq]; sr[sx] = t; }
                    if (!(sub == 1 && ag == 3)) { const float t = l4r[sx] * sr[sx] - l4i[sx] * si[sx]; si[sx] = l4r[sx] * si[sx] + l4i[sx] * sr[sx]; sr[sx] = t; } } }
        }
#pragma unroll
        for (int sx = 0; sx < 2; ++sx) { if (hh == 0) { const float t = l4r[sx] * sr[sx] - l4i[sx] * si[sx]; si[sx] = l4r[sx] * si[sx] + l4i[sx] * sr[sx]; sr[sx] = t; }
            const float tr = sr[sx] + __shfl_xor(sr[sx], 32), ti = si[sx] + __shfl_xor(si[sx], 32);
            if (hh == 0) *(f32x2*)(Eb + ((((size_t)b * 64 + ch) * 64) + g) * 128 + (l31 + 32 * sx) * 2) = (f32x2){tr, ti}; }
        __syncthreads();
    }
}

__device__ __forceinline__ void phase_s5_out(const Params& p, LAS unsigned char* lds, int nitems) {
    const int tid = threadIdx.x, wid = tid >> 6, lane = tid & 63, l31 = lane & 31, hh = lane >> 5, hcol = lane & 15, q4 = lane >> 4;
    const float* proj2 = (const float*)(p.ws + OFF_PROJ2); const float* Eb = (const float*)(p.ws + OFF_E); bf16_t* yb = (bf16_t*)(p.ws + OFF_YB);
    constexpr int UROW = 272, SROW = 272;
    LAS unsigned char* sb = lds + 64 * UROW + wid * 32 * SROW;
    int oct_cur = -1;
    float lr[2] = {0.f, 0.f}, li[2] = {0.f, 0.f}, p64r[2] = {0.f, 0.f}, p64i[2] = {0.f, 0.f}; f32x4 dsk4 = (f32x4){0.f, 0.f, 0.f, 0.f}; bf16x8 Bre[2], Bim[2], Bc[4];
#pragma unroll
    for (int i = 0; i < 2; ++i) { Bre[i] = (bf16x8){0, 0, 0, 0, 0, 0, 0, 0}; Bim[i] = Bre[i]; }
#pragma unroll
    for (int i = 0; i < 4; ++i) Bc[i] = (bf16x8){0, 0, 0, 0, 0, 0, 0, 0};
    for (int item = blockIdx.x; item < nitems; item += gridDim.x) {
        const int cs = item >> 3, oct = item & 7, g = oct * 8 + wid; const bool smp = cs >= 128;
        const int b = smp ? cs - 128 : cs >> 6, ch = smp ? 0 : cs & 63, L = smp ? 32 : 64, row0 = smp ? TP + b * 32 : b * 4096 + ch * 64;
#pragma unroll
        for (int k = 0; k < 4; ++k) { const int i = tid + k * 512, t = i >> 5, q = i & 31; if (i < L * 32) { const f32x4 v = *(const f32x4*)(proj2 + (size_t)(row0 + t) * DM + 1024 + oct * 128 + q * 4);
            u32x2 w; w.x = cvt_pk_bf16(v[0], v[1]); w.y = cvt_pk_bf16(v[2], v[3]); *(LAS u32x2*)(lds + t * UROW + q * 8) = w; } }
        if (oct != oct_cur) { oct_cur = oct;
            const float dt = __expf(p.in[24][g]);
#pragma unroll
            for (int sx = 0; sx < 2; ++sx) { const int st = l31 + 32 * sx;
                const float are = p.in[22][g * 64 + st], aim = p.in[23][g * 64 + st];
                const float er = __expf(are * dt); float rev = aim * dt * 0.15915494309189535f; rev -= floorf(rev);
                lr[sx] = er * __builtin_amdgcn_cosf(rev); li[sx] = er * __builtin_amdgcn_sinf(rev);
                const float den = 1.0f / (are * are + aim * aim); const float nr = lr[sx] - 1.0f, ni = li[sx];
                const float cr = (nr * are + ni * aim) * den, ci = (ni * are - nr * aim) * den;
                const float* br = p.in[25] + ((size_t)g * 64 + st) * 16 + hh * 8; const float* bi = p.in[26] + ((size_t)g * 64 + st) * 16 + hh * 8;
                const f32x4 x0 = *(const f32x4*)br, x1 = *(const f32x4*)(br + 4), y0 = *(const f32x4*)bi, y1 = *(const f32x4*)(bi + 4);
                u32x4 wr, wi;
                wr.x = cvt_pk_bf16(cr * x0[0] - ci * y0[0], cr * x0[1] - ci * y0[1]); wr.y = cvt_pk_bf16(cr * x0[2] - ci * y0[2], cr * x0[3] - ci * y0[3]);
                wr.z = cvt_pk_bf16(cr * x1[0] - ci * y1[0], cr * x1[1] - ci * y1[1]); wr.w = cvt_pk_bf16(cr * x1[2] - ci * y1[2], cr * x1[3] - ci * y1[3]);
                wi.x = cvt_pk_bf16(cr * y0[0] + ci * x0[0], cr * y0[1] + ci * x0[1]); wi.y = cvt_pk_bf16(cr * y0[2] + ci * x0[2], cr * y0[3] + ci * x0[3]);
                wi.z = cvt_pk_bf16(cr * y1[0] + ci * x1[0], cr * y1[1] + ci * x1[1]); wi.w = cvt_pk_bf16(cr * y1[2] + ci * x1[2], cr * y1[3] + ci * x1[3]);
                Bre[sx] = __builtin_bit_cast(bf16x8, wr); Bim[sx] = __builtin_bit_cast(bf16x8, wi);
                float pr = lr[sx], pi = li[sx];
#pragma unroll
                for (int q = 0; q < 6; ++q) { const float t = pr * pr - pi * pi; pi = 2.f * pr * pi; pr = t; }
                p64r[sx] = pr; p64i[sx] = pi; }
#pragma unroll
            for (int ks = 0; ks < 4; ++ks) { const float* src = (ks < 2 ? p.in[27] : p.in[28]) + ((size_t)g * 16 + hcol) * 64 + (ks & 1) * 32 + q4 * 8; const float sg = ks < 2 ? 1.f : -1.f;
                const f32x4 x = *(const f32x4*)src, y = *(const f32x4*)(src + 4); u32x4 w; w.x = cvt_pk_bf16(sg * x[0], sg * x[1]); w.y = cvt_pk_bf16(sg * x[2], sg * x[3]); w.z = cvt_pk_bf16(sg * y[0], sg * y[1]); w.w = cvt_pk_bf16(sg * y[2], sg * y[3]);
                Bc[ks] = __builtin_bit_cast(bf16x8, w); }
            dsk4 = *(const f32x4*)(p.in[29] + g * 16 + q4 * 4); }
        float sr[2] = {0.f, 0.f}, si[2] = {0.f, 0.f};
        if (smp) {
#pragma unroll
            for (int sx = 0; sx < 2; ++sx) { const int st = l31 + 32 * sx; sr[sx] = p.in[4][((size_t)b * 64 + g) * 64 + st]; si[sx] = p.in[5][((size_t)b * 64 + g) * 64 + st]; }
        } else { const float* e0 = Eb + (((size_t)b * 64) * 64 + g) * 128 + l31 * 2;
            for (int j0 = 0; j0 < ch; j0 += 16) { f32x2 ev[2][16];
#pragma unroll
                for (int jj = 0; jj < 16; ++jj) { const int j = (j0 + jj) < ch ? (j0 + jj) : (ch - 1); ev[0][jj] = *(const f32x2*)(e0 + (size_t)j * 64 * 128); ev[1][jj] = *(const f32x2*)(e0 + (size_t)j * 64 * 128 + 64); }
#pragma unroll
                for (int jj = 0; jj < 16; ++jj) { const bool on = (j0 + jj) < ch;
#pragma unroll
                    for (int sx = 0; sx < 2; ++sx) { const float t = p64r[sx] * sr[sx] - p64i[sx] * si[sx] + ev[sx][jj].x, u2 = p64r[sx] * si[sx] + p64i[sx] * sr[sx] + ev[sx][jj].y; sr[sx] = on ? t : sr[sx]; si[sx] = on ? u2 : si[sx]; } } } }
        __syncthreads();
        for (int sub = 0; sub < L; sub += 32) {
            const bf16x8 a = *(const LAS bf16x8*)(lds + (sub + l31) * UROW + (wid * 16 + hh * 8) * 2);
            f32x16 z;
#pragma unroll
            for (int r = 0; r < 16; ++r) z[r] = 0.f;
#pragma unroll
            for (int sx = 0; sx < 2; ++sx) {
                const f32x16 ar = __builtin_amdgcn_mfma_f32_32x32x16_bf16(a, Bre[sx], z, 0, 0, 0), ai = __builtin_amdgcn_mfma_f32_32x32x16_bf16(a, Bim[sx], z, 0, 0, 0);
                const float lrs = lr[sx], lis = li[sx]; float s_r = sr[sx], s_i = si[sx];
#pragma unroll
                for (int ag = 0; ag < 4; ++ag) {
                    float c1r[4], c1i[4], c2r[4], c2i[4]; float tr = s_r, ti = s_i;
#pragma unroll
                    for (int bq = 0; bq < 4; ++bq) { const float t = lrs * tr - lis * ti + ar[ag * 4 + bq]; ti = lrs * ti + lis * tr + ai[ag * 4 + bq]; tr = t; c1r[bq] = tr; c1i[bq] = ti; }
                    float xr = __shfl_xor(tr, 32), xi = __shfl_xor(ti, 32);
#pragma unroll
                    for (int bq = 0; bq < 4; ++bq) { const float t = lrs * xr - lis * xi + ar[ag * 4 + bq]; xi = lrs * xi + lis * xr + ai[ag * 4 + bq]; xr = t; c2r[bq] = xr; c2i[bq] = xi; }
                    s_r = __shfl_xor(xr, 32); s_i = __shfl_xor(xi, 32);
#pragma unroll
                    for (int bq = 0; bq < 4; ++bq) { const int tt = ag * 8 + hh * 4 + bq; const float vr = hh ? c2r[bq] : c1r[bq], vi = hh ? c2i[bq] : c1i[bq];
                        *(LAS bf16_t*)(sb + tt * SROW + (l31 + 32 * sx) * 2) = (bf16_t)(cvt_pk_bf16(vr, 0.f) & 0xffffu); *(LAS bf16_t*)(sb + tt * SROW + 128 + (l31 + 32 * sx) * 2) = (bf16_t)(cvt_pk_bf16(vi, 0.f) & 0xffffu); }
                }
                sr[sx] = s_r; si[sx] = s_i; __builtin_amdgcn_sched_barrier(0); }
            __syncthreads();
#pragma unroll
            for (int mt = 0; mt < 2; ++mt) { f32x4 acc = (f32x4){0.f, 0.f, 0.f, 0.f};
#pragma unroll
                for (int ks = 0; ks < 4; ++ks) { const bf16x8 af = *(const LAS bf16x8*)(sb + (mt * 16 + hcol) * SROW + ks * 64 + q4 * 16); acc = __builtin_amdgcn_mfma_f32_16x16x32_bf16(Bc[ks], af, acc, 0, 0, 0); }
                const int t = sub + mt * 16 + hcol; const u32x2 uw = *(const LAS u32x2*)(lds + t * UROW + (wid * 16 + q4 * 4) * 2);
                const float y0 = acc[0] + dsk4[0] * bf_lo(uw.x), y1 = acc[1] + dsk4[1] * bf_hi(uw.x), y2 = acc[2] + dsk4[2] * bf_lo(uw.y), y3 = acc[3] + dsk4[3] * bf_hi(uw.y);
                u32x2 w; w.x = cvt_pk_bf16(gelu_t(y0), gelu_t(y1)); w.y = cvt_pk_bf16(gelu_t(y2), gelu_t(y3));
                *(u32x2*)(yb + (size_t)(row0 + t) * YLD + g * 16 + q4 * 4) = w; }
            __syncthreads();
        }
        if (hh == 0 && (smp || ch == 63)) { float* ore = p.out + (smp ? O_S5RE_S : O_S5RE_P) + ((size_t)b * 64 + g) * 64; float* oim = p.out + (smp ? O_S5IM_S : O_S5IM_P) + ((size_t)b * 64 + g) * 64;
#pragma unroll
            for (int sx = 0; sx < 2; ++sx) { ore[l31 + 32 * sx] = sr[sx]; oim[l31 + 32 * sx] = si[sx]; } }
        __syncthreads();
    }
}

#define XB_TMO      128
#define XB_XCNT(j)  (256  + 64 * (j))
#define XB_XSUB(j)  (1280 + 64 * (j))
#define XB_XGEN(j)  (2304 + 64 * (j))
#define XB_TOP      3328
#define XB_TOPGEN   3392
#define XCD_BAR_WORDS 3456
#define XB_SPIN_CAP (1u << 20)
__device__ __forceinline__ unsigned xb_ld(unsigned* p)              { return __hip_atomic_load(p, __ATOMIC_RELAXED, __HIP_MEMORY_SCOPE_AGENT); }
__device__ __forceinline__ unsigned xb_add(unsigned* p, unsigned v) { return __hip_atomic_fetch_add(p, v, __ATOMIC_RELAXED, __HIP_MEMORY_SCOPE_AGENT); }
__device__ __forceinline__ unsigned xb_xcc_id() { return (unsigned)__builtin_amdgcn_s_getreg((3 << 11) | 20) & 0xFu; }
#define XB_SPIN(cond, bar) do { unsigned _sp = 0; while (cond) { __builtin_amdgcn_s_sleep(1); \
    if ((++_sp & 255u) == 0u) { if (xb_ld(&(bar)[XB_TMO])) break; if (_sp > XB_SPIN_CAP) { atomicAdd(&(bar)[XB_TMO], 1u); break; } } } } while (0)
struct XcdBarrier { unsigned* bar; unsigned x; volatile LAS unsigned* st; };
__device__ __forceinline__ XcdBarrier xcd_barrier_post(unsigned* bar, volatile LAS unsigned* st) {
    XcdBarrier b; b.bar = bar; b.x = xb_xcc_id(); b.st = st;
    if (threadIdx.x == 0) (void)xb_add(&bar[XB_XCNT(b.x)], 1u);
    return b;
}
__device__ __forceinline__ void xcd_barrier_complete(unsigned* bar, unsigned x, unsigned& nloc, unsigned& nx) {
    const unsigned G = gridDim.x * gridDim.y * gridDim.z;
    unsigned sum, cnt, mine, sp = 0u;
    for (;;) {
        sum = 0u; cnt = 0u; mine = 0u;
#pragma unroll
        for (unsigned j = 0; j < 16; ++j) { const unsigned c = xb_ld(&bar[XB_XCNT(j)]); sum += c; cnt += (c > 0u) ? 1u : 0u; mine = (j == x) ? c : mine; }
        if (sum == G) break;
        __builtin_amdgcn_s_sleep(1);
        if ((++sp & 255u) == 0u) { if (xb_ld(&bar[XB_TMO])) break; if (sp > XB_SPIN_CAP) { atomicAdd(&bar[XB_TMO], 1u); break; } }
    }
    nloc = mine > 0u ? mine : 1u; nx = cnt > 0u ? cnt : 1u;
}
__device__ __forceinline__ void xcd_barrier(const XcdBarrier& b) {
    asm volatile("s_waitcnt vmcnt(0)" ::: "memory");
    __syncthreads();
    if (threadIdx.x == 0) {
        unsigned* bar = b.bar;
        __builtin_amdgcn_s_waitcnt(0);
        unsigned nloc = b.st[0], nx = b.st[1];
        if (nloc == 0u) { xcd_barrier_complete(bar, b.x, nloc, nx); b.st[0] = nloc; b.st[1] = nx; }
        const unsigned old = xb_add(&bar[XB_XSUB(b.x)], 1u);
        const unsigned gen = old / nloc;
        if (old + 1u == (gen + 1u) * nloc) {
            __builtin_amdgcn_fence(__ATOMIC_RELEASE, "agent");
            asm volatile("s_waitcnt vmcnt(0)" ::: "memory");
            const unsigned og = xb_add(&bar[XB_TOP], 1u);
            const unsigned tg = og / nx;
            if (og + 1u == (tg + 1u) * nx) xb_add(&bar[XB_TOPGEN], 1u);
            else XB_SPIN(xb_ld(&bar[XB_TOPGEN]) == tg, bar);
            __builtin_amdgcn_fence(__ATOMIC_ACQUIRE, "agent");
            xb_add(&bar[XB_XGEN(b.x)], 1u);
            asm volatile("s_waitcnt vmcnt(0)" ::: "memory");
        } else {
            XB_SPIN(xb_ld(&bar[XB_XGEN(b.x)]) == gen, bar);
            __builtin_amdgcn_fence(__ATOMIC_ACQUIRE, "agent");
            asm volatile("s_waitcnt vmcnt(0)" ::: "memory");
        }
    }
    __syncthreads();
}

__device__ __forceinline__ void run_phase(const Params& p, LAS unsigned char* lds, const int ph, const int vb) {
#ifdef ONLY_PH
    if (ph != ONLY_PH) return;
#endif
    unsigned char* ws = p.ws; const int nb = gridDim.x;
    switch (ph) {
    case 0: phase_prep(p, lds); break;
    case 1: { pg8::EpiBf16<1> E; E.O = (bf16_t*)(ws + OFF_PROJ); E.ldc = NE; E.gelu_tiles = 8; E.scale = nullptr; E.slab = 0;
              run_gemm(lds, (const bf16_t*)(ws + OFF_H), (const bf16_t*)(ws + OFF_WIN_E), NE, DM, HLD, HLD, 0, E, vb);
              phase_glr(p, vb);
              if (nb == 256 && vb >= 208) prep_run<1>(p, lds, vb - 208, 48, NL1); } break;
    case 2: { for (int it = blockIdx.x; it < 640; it += nb) { if (it < 512) glau_item<64>(p, lds, it); else glau_item<32>(p, lds, it); }
              for (int it = nb - 1 - (int)blockIdx.x; it < 384; it += nb) { if (it < 256) amix_item<128>(p, lds, it); else amix_item<32>(p, lds, it); } } break;
    case 3: phase_gla_scan(p); break;
    case 4: for (int it = blockIdx.x; it < 640; it += nb) { if (it < 512) glao_item<64>(p, lds, it); else glao_item<32>(p, lds, it); } break;
    case 5: case 15: { pg8::EpiBf16<1> E; E.O = (bf16_t*)(ws + OFF_M); E.ldc = DM; E.gelu_tiles = 0; E.scale = nullptr; E.slab = 0;
              const bf16_t* W = (const bf16_t*)(ws + (ph == 5 ? OFF_WOUT_E : OFF_WOUT_O));
              run_gemm(lds, (const bf16_t*)(ws + OFF_MIX), W, DM, DM, HLD, HLD, 0, E, vb, TP);
              run_gemm_split(lds, (const bf16_t*)(ws + OFF_MIX), W, DM, HLD, 8, (bf16_t*)(ws + OFF_SLAB_A), vb); } break;
    case 6: phase_norm(p, true, nullptr, p.in[8], p.in[9], (const bf16_t*)(ws + OFF_SLAB_A), 8); break;
    case 7: case 17: { const int layer = ph == 7 ? 0 : 1; pg8::EpiGateVal E; E.ACT = (bf16_t*)(ws + OFF_VAL); E.GF = (bf16_t*)(ws + OFF_GF); E.VF = (bf16_t*)(ws + OFF_VF); E.GL = (bf16_t*)(ws + OFF_GL);
              E.ffn_p = p.out + O_FFN_P + (size_t)layer * 2 * 2 * DFF; E.ffn_s = p.out + O_FFN_S + (size_t)layer * 32 * 2 * DFF;
              E.cw = p.in[33] + (size_t)layer * 3 * DFF; E.cb = p.in[34] + (size_t)layer * DFF;
              run_gemm(lds, (const bf16_t*)(ws + OFF_H), (const bf16_t*)(ws + (layer ? OFF_WUP1 : OFF_WUP0)), 2 * DFF, DM, HLD, HLD, 0, E, vb);
              if (nb == 256 && vb >= 48) { if (layer == 0) prep_run<2>(p, lds, vb - 48, 208, NL2); else prep_run<5>(p, lds, vb - 48, 208, NL5); } } break;
    case 8: phase_convfix(p, 0); break;
    case 18: phase_convfix(p, 1); break;
    case 9: case 19: { pg8::EpiBf16<1> E; E.O = (bf16_t*)(ws + OFF_M); E.ldc = DM; E.gelu_tiles = 0; E.scale = nullptr; E.slab = 0;
              const bf16_t* W = (const bf16_t*)(ws + (ph == 9 ? OFF_WDN0 : OFF_WDN1));
              run_gemm(lds, (const bf16_t*)(ws + OFF_VAL), W, DM, DFF, ALD, ALD, 0, E, vb, TP);
              run_gemm_split(lds, (const bf16_t*)(ws + OFF_VAL), W, DFF, ALD, 4, (bf16_t*)(ws + OFF_SLAB_B), vb);
              if (ph == 9 && nb == 256 && vb >= 128) prep_run<3>(p, lds, vb - 128, 128, NL3); } break;
    case 10: phase_norm(p, false, nullptr, p.in[10], p.in[7] + DM, (const bf16_t*)(ws + OFF_SLAB_B), 4); break;
    case 11: { pg8::EpiF32 E; E.C = (float*)(ws + OFF_PROJ2); E.ldc = DM; E.slab = 0;
              run_gemm(lds, (const bf16_t*)(ws + OFF_H), (const bf16_t*)(ws + OFF_WIN_O), DM, DM, HLD, HLD, 0, E, vb);
              if (nb == 256 && vb >= 32) prep_run<4>(p, lds, vb - 32, 224, NL4); } break;
    case 12: { phase_pool(p); phase_s5_ends(p, lds, 1024); } break;
    case 13: phase_s5_out(p, lds, 1280); break;
    case 14: { pg8::EpiGlu E; E.O = (bf16_t*)(ws + OFF_MIX) + 1024; E.ldc = HLD;
              run_gemm(lds, (const bf16_t*)(ws + OFF_YB), (const bf16_t*)(ws + OFF_WGLU), 2048, 1024, YLD, YLD, 0, E, vb); }
             { pg8::EpiBf16<1> E2; E2.O = (bf16_t*)(ws + OFF_MIX); E2.ldc = HLD; E2.gelu_tiles = 0; E2.scale = nullptr; E2.slab = 0;
              run_gemm(lds, (const bf16_t*)(ws + OFF_DELTA), (const bf16_t*)(ws + OFF_CMAP), 1024, 256, YLD, CLD, 256, E2, vb, T, nb >= 64 ? 32 : 0); } break;
    case 16: phase_norm(p, false, nullptr, p.in[8] + DM, p.in[9] + DM, (const bf16_t*)(ws + OFF_SLAB_A), 8); break;
    case 20: phase_norm(p, false, p.out + O_Y, p.in[10] + DM, nullptr, (const bf16_t*)(ws + OFF_SLAB_B), 4); break;
    default: break;
    }
}

__global__ void __launch_bounds__(512, 2) fwd_megakernel(Params p) {
    extern __shared__ __attribute__((aligned(16))) unsigned char shm[];
    LAS unsigned char* lds = (LAS unsigned char*)shm;
    cg::grid_group grid = cg::this_grid();
    volatile LAS unsigned* xst = (volatile LAS unsigned*)(lds + 131072);
    if (threadIdx.x == 0) { xst[0] = 0u; xst[1] = 0u; }
    __syncthreads();
    const XcdBarrier xb = xcd_barrier_post((unsigned*)(p.ws + OFF_BAR), xst);
    const int vb = (int)blockIdx.x;
    if (p.ph_hi > NPHASE) grid.sync();
#define GSYNC() xcd_barrier(xb)
#ifndef DUP_MASK
#define DUP_MASK 0u
#endif
#ifndef EXTRA_SYNC
#define EXTRA_SYNC 0
#endif
#define PH(n) if (p.ph_lo <= (n) && (n) < p.ph_hi) { run_phase(p, lds, SEQ[n], vb); if ((DUP_MASK >> (n)) & 1u) { GSYNC(); run_phase(p, lds, SEQ[n], vb); } \
        if ((n) + 1 < p.ph_hi) { GSYNC(); for (int _e = 0; _e < EXTRA_SYNC; ++_e) GSYNC(); } }
    PH(0) PH(1) PH(2) PH(3) PH(4) PH(5) PH(6) PH(7) PH(8) PH(9) PH(10) PH(11) PH(12) PH(13) PH(14) PH(15) PH(16) PH(17) PH(18) PH(19) PH(20)
#undef PH
}

extern "C" void kernel_launch(void* const* d_in, const int* in_sizes, int n_in, void* d_out, int out_size, void* d_ws, size_t ws_size, hipStream_t stream) {
    static int grid_blocks = 0;
    if (grid_blocks == 0) {
        if (n_in != 36 || (size_t)out_size != O_END || ws_size < WS_END) { fprintf(stderr, "kernel_launch: unexpected sizes n_in %d out %d ws %zu (need %zu)\n", n_in, out_size, ws_size, (size_t)WS_END); grid_blocks = -1; return; }
        int dev = 0, cus = 0, per_cu = 0;
        hipGetDevice(&dev); hipDeviceGetAttribute(&cus, hipDeviceAttributeMultiprocessorCount, dev);
        if (hipFuncSetAttribute((const void*)fwd_megakernel, hipFuncAttributeMaxDynamicSharedMemorySize, LDS_BYTES) != hipSuccess) { fprintf(stderr, "kernel_launch: hipFuncSetAttribute failed\n"); grid_blocks = -1; return; }
        hipOccupancyMaxActiveBlocksPerMultiprocessor(&per_cu, (const void*)fwd_megakernel, 512, LDS_BYTES);
        if (per_cu < 1) { fprintf(stderr, "kernel_launch: occupancy query says %d blocks per CU\n", per_cu); per_cu = 1; }
        (void)hipGetLastError();
        grid_blocks = cus;
    }
    if (grid_blocks < 0) return;
    Params p{};
    for (int i = 0; i < 36; ++i) p.in[i] = (const float*)d_in[i];
    p.out = (float*)d_out; p.ws = (unsigned char*)d_ws;
#if MULTI_LAUNCH
    for (int ph = 0; ph < NPHASE; ++ph) { p.ph_lo = ph; p.ph_hi = ph + 1; hipLaunchKernelGGL(fwd_megakernel, dim3(grid_blocks), dim3(512), LDS_BYTES, stream, p); }
#else
    p.ph_lo = 0; p.ph_hi = NPHASE;
    if (hipMemsetAsync((unsigned char*)d_ws + OFF_BAR, 0, 16384, stream) != hipSuccess) { fprintf(stderr, "kernel_launch: barrier memset failed\n"); return; }
    void* args[] = {&p};
    hipError_t e = hipLaunchCooperativeKernel((const void*)fwd_megakernel, dim3(grid_blocks), dim3(512), args, LDS_BYTES, stream);
    if (e != hipSuccess) fprintf(stderr, "cooperative launch failed: %s (grid %d)\n", hipGetErrorString(e), grid_blocks);
#endif
}
```

```cpp
#include <hip/hip_runtime.h>
#include <hip/hip_cooperative_groups.h>
#include <cstdio>
namespace cg = cooperative_groups;

#define LAS __attribute__((address_space(3)))
typedef unsigned short bf16_t;
typedef short bf16x8 __attribute__((ext_vector_type(8)));
typedef float f32x4 __attribute__((ext_vector_type(4)));
typedef float f32x2 __attribute__((ext_vector_type(2)));
typedef float f32x16 __attribute__((ext_vector_type(16)));
typedef unsigned u32x4 __attribute__((ext_vector_type(4)));
typedef unsigned u32x2 __attribute__((ext_vector_type(2)));

#ifndef MULTI_LAUNCH
#define MULTI_LAUNCH 0
#endif

constexpr int T = 9216, TP = 8192, DM = 2048, DFF = 5632, NE = 5120, NE_SRC = 5136;
constexpr float EPS = 1e-6f;
constexpr int PADK = 64, HLD = DM + PADK, ALD = DFF + PADK, YLD = 1024 + PADK, CLD = 256 + PADK;
constexpr int NPHASE = 21;
__device__ constexpr int SEQ[NPHASE] = {0, 1, 2, 3, 4, 5, 6, 7, 8, 9, 10, 11, 12, 13, 14, 15, 16, 17, 18, 19, 20};
constexpr int LDS_BYTES = 131072 + 16;

constexpr size_t al256(size_t x) { return (x + 255) & ~(size_t)255; }
constexpr size_t SZ_WIN_E = (size_t)NE * HLD * 2, SZ_WG = 16 * DM * 2, SZ_W22 = (size_t)DM * HLD * 2, SZ_WUP = (size_t)2 * DFF * HLD * 2,
                 SZ_WDN = (size_t)DM * ALD * 2, SZ_CMAP = 1024 * CLD * 2, SZ_WGLU = (size_t)2048 * YLD * 2, SZ_WSM = 8 * 128 * 128 * 2;
constexpr size_t OFF_WIN_E = 0;
constexpr size_t OFF_WG = OFF_WIN_E + SZ_WIN_E;
constexpr size_t OFF_WOUT_E = OFF_WG + SZ_WG;
constexpr size_t OFF_WUP0 = OFF_WOUT_E + SZ_W22;
constexpr size_t OFF_WUP1 = OFF_WUP0 + SZ_WUP;
constexpr size_t OFF_WDN0 = OFF_WUP1 + SZ_WUP;
constexpr size_t OFF_WDN1 = OFF_WDN0 + SZ_WDN;
constexpr size_t OFF_WIN_O = OFF_WDN1 + SZ_WDN;
constexpr size_t OFF_CMAP = OFF_WIN_O + SZ_W22;
constexpr size_t OFF_WGLU = OFF_CMAP + SZ_CMAP;
constexpr size_t OFF_WOUT_O = OFF_WGLU + SZ_WGLU;
constexpr size_t OFF_WSM = OFF_WOUT_O + SZ_W22;
constexpr size_t OFF_H = OFF_WSM + SZ_WSM;
constexpr size_t OFF_MIX = OFF_H + (size_t)T * HLD * 2;
constexpr size_t OFF_M = OFF_MIX + (size_t)T * HLD * 2;
constexpr size_t OFF_XA = OFF_M + (size_t)T * DM * 4;
constexpr size_t OFF_R1 = OFF_XA + (size_t)T * DM * 4;
constexpr size_t SZ_R1 = (size_t)T * DFF * 2 + (size_t)T * ALD * 2;
constexpr size_t OFF_PROJ = OFF_R1;
constexpr size_t OFF_UT = OFF_PROJ + (size_t)T * NE * 2;
constexpr size_t OFF_ST = OFF_UT + (size_t)512 * 256 * 128 * 4;
constexpr size_t OFF_DECAY = OFF_ST + (size_t)640 * 256 * 128 * 2;
constexpr size_t OFF_GLR = OFF_DECAY + (size_t)640 * 128 * 4;
static_assert(OFF_GLR + (size_t)T * 16 * 4 <= OFF_R1 + SZ_R1, "arena");
constexpr size_t OFF_GATE = OFF_R1;
constexpr size_t OFF_VAL = OFF_R1 + (size_t)T * DFF * 2;
constexpr size_t OFF_GF = OFF_R1;
constexpr size_t OFF_VF = OFF_GF + (size_t)576 * DFF * 2;
constexpr size_t OFF_GL = OFF_VF + (size_t)576 * DFF * 2;
constexpr size_t OFF_PROJ2 = OFF_R1;
constexpr size_t OFF_DELTA = OFF_PROJ2 + (size_t)T * DM * 4;
constexpr size_t OFF_YB = OFF_DELTA + (size_t)T * YLD * 2;
constexpr size_t OFF_E = OFF_YB + (size_t)T * YLD * 2;
constexpr size_t OFF_SLAB_A = OFF_R1;
constexpr size_t OFF_SLAB_B = OFF_MIX;
constexpr size_t OFF_BAR = OFF_R1 + SZ_R1;
constexpr size_t WS_END = OFF_BAR + 16384;

constexpr size_t O_Y = 0;
constexpr size_t O_GLA_P = O_Y + (size_t)T * DM;
constexpr size_t O_GLA_S = O_GLA_P + 2 * 4 * 128 * 256;
constexpr size_t O_AV = O_GLA_S + (size_t)32 * 4 * 128 * 256;
constexpr size_t O_POOL_P = O_AV + (size_t)32 * 32 * 1024;
constexpr size_t O_POOL_S = O_POOL_P + 2 * 15 * 1024;
constexpr size_t O_S5RE_P = O_POOL_S + 32 * 15 * 1024;
constexpr size_t O_S5IM_P = O_S5RE_P + 2 * 64 * 64;
constexpr size_t O_S5RE_S = O_S5IM_P + 2 * 64 * 64;
constexpr size_t O_S5IM_S = O_S5RE_S + 32 * 64 * 64;
constexpr size_t O_FFN_P = O_S5IM_S + 32 * 64 * 64;
constexpr size_t O_FFN_S = O_FFN_P + 2 * 2 * 2 * DFF;
constexpr size_t O_END = O_FFN_S + (size_t)2 * 32 * 2 * DFF;

struct Params {
    const float* in[36];
    float* out;
    unsigned char* ws;
    int ph_lo, ph_hi;
};

__device__ __forceinline__ unsigned cvt_pk_bf16(float lo, float hi) { unsigned r; asm volatile("v_cvt_pk_bf16_f32 %0, %1, %2" : "=v"(r) : "v"(lo), "v"(hi)); return r; }
__device__ __forceinline__ float bf_lo(unsigned w) { return __uint_as_float(w << 16); }
__device__ __forceinline__ float bf_hi(unsigned w) { return __uint_as_float(w & 0xffff0000u); }
__device__ __forceinline__ float bf1(bf16_t b) { return __uint_as_float(((unsigned)b) << 16); }
__device__ __forceinline__ float fast_rcp(float x) { return __builtin_amdgcn_rcpf(x); }
__device__ __forceinline__ float sigmoidf(float x) { return fast_rcp(1.0f + __builtin_amdgcn_exp2f(-1.4426950409f * x)); }
__device__ __forceinline__ float gelu_t(float x) { const float u = x * (1.5957691216f + 0.0713548163f * x * x); return x * fast_rcp(1.0f + __builtin_amdgcn_exp2f(-1.4426950409f * u)); }
__device__ __forceinline__ float wave_sum(float v) {
#pragma unroll
    for (int o = 32; o >= 1; o >>= 1) v += __shfl_xor(v, o);
    return v;
}
__device__ __forceinline__ const float* xrow_in(const Params& p, int row) { return row < TP ? p.in[0] + (size_t)row * DM : p.in[1] + (size_t)(row - TP) * DM; }

namespace pg8 {
constexpr int BM = 256, BK = 64, HALF = 128, HTB = HALF * BK * 2, STAGE_BYTES = 8 * HTB, NXCD = 8, WGM = 8;
__device__ __forceinline__ int lds_byte(int r, int c) { const int st = (r >> 4) * 2 + (c >> 5), rr = r & 15, cc = c & 31, ob = rr * 64 + cc * 2; return st * 1024 + (ob ^ (((ob >> 9) & 1) << 5)); }
__device__ __forceinline__ void stage_rc(int b, int& R, int& C) { const int st = b / 1024, sb = b % 1024, swz = sb ^ (((sb >> 9) & 1) << 5); R = (st >> 1) * 16 + swz / 64; C = (st & 1) * 32 + (swz % 64) / 2; }
__device__ __forceinline__ int perm32(int rho) { const int n = rho >> 4, i = rho & 15; return 8 * (i >> 2) + 4 * n + (i & 3); }
struct Unit { int pm, pn, ks; };
struct Gemm { const bf16_t* A; const bf16_t* Bt; int M, N, K, lda, ldb, a_pn_off; };
struct StaticOrder {
    int nM, nN, nwg, G, c;
    __device__ void init(int M, int N, int G_, int c_) { nM = M / BM; nN = N / BM; nwg = nM * nN; G = G_; c = c_; }
    __device__ bool next(int i, Unit& u) const {
        const long L = (long)i * G + c; if (L >= nwg) return false;
        int wgid = (int)L; { const int q = nwg / NXCD, r = nwg % NXCD, xcd = wgid % NXCD, off = wgid / NXCD; wgid = (xcd < r ? xcd * (q + 1) : r * (q + 1) + (xcd - r) * q) + off; }
        const int nig = WGM * nN, gid = wgid / nig, fm = gid * WGM, gsz = (nM - fm) < WGM ? (nM - fm) : WGM;
        u.pm = fm + ((wgid % nig) % gsz); u.pn = (wgid % nig) / gsz; u.ks = 0; return true;
    }
};
struct SplitOrder {
    int S, nsub, G, c;
    __device__ void init(int nN, int S_, int G_, int c_) { S = S_; nsub = 4 * nN * S_; G = G_; c = c_; }
    __device__ bool next(int i, Unit& u) const {
        const long L = (long)i * G + c; if (L >= nsub) return false;
        const int l = (int)L, tile = l / S; u.ks = l - tile * S; u.pm = tile & 3; u.pn = tile >> 2; return true;
    }
};

struct EpiF32 {
    static constexpr bool PERM = false;
    float* C; int ldc; size_t slab;
    __device__ __forceinline__ void operator()(const f32x4 (&acc)[2][2][4][2], const Unit& u, int wr, int wc, int fr, int fq) const {
        const int row0 = u.pm * BM + wr * 64 + fr, col0 = u.pn * BM + wc * 32 + 4 * fq;
#pragma unroll
        for (int ai = 0; ai < 2; ++ai)
#pragma unroll
            for (int m = 0; m < 4; ++m) { float* rowp = C + (size_t)u.ks * slab + (size_t)(row0 + ai * HALF + m * 16) * ldc + col0;
#pragma unroll
                for (int bj = 0; bj < 2; ++bj)
#pragma unroll
                    for (int n = 0; n < 2; ++n) *(f32x4*)(rowp + bj * HALF + n * 16) = acc[ai][bj][m][n]; }
    }
};
template <int MODE> struct EpiBf16 {
    static constexpr bool PERM = true;
    bf16_t* O; int ldc; int gelu_tiles; const float* scale; size_t slab;
    __device__ __forceinline__ void operator()(const f32x4 (&acc)[2][2][4][2], const Unit& u, int wr, int wc, int fr, int fq) const {
        const int row0 = u.pm * BM + wr * 64 + fr, col0 = u.pn * BM + wc * 32 + 8 * fq;
        bf16_t* Ob = O + (size_t)u.ks * slab;
        const bool dog = (MODE == 1) && (u.pn < gelu_tiles);
#pragma unroll
        for (int ai = 0; ai < 2; ++ai)
#pragma unroll
            for (int m = 0; m < 4; ++m) { bf16_t* rowp = Ob + (size_t)(row0 + ai * HALF + m * 16) * ldc + col0;
#pragma unroll
                for (int bj = 0; bj < 2; ++bj) { f32x4 v0 = acc[ai][bj][m][0], v1 = acc[ai][bj][m][1];
                    if (MODE == 2) { v0 = v0 * *(const f32x4*)(scale + col0 + bj * HALF); v1 = v1 * *(const f32x4*)(scale + col0 + bj * HALF + 4); }
                    if (dog) {
#pragma unroll
                        for (int j = 0; j < 4; ++j) { v0[j] = gelu_t(v0[j]); v1[j] = gelu_t(v1[j]); } }
                    u32x4 w; w.x = cvt_pk_bf16(v0[0], v0[1]); w.y = cvt_pk_bf16(v0[2], v0[3]); w.z = cvt_pk_bf16(v1[0], v1[1]); w.w = cvt_pk_bf16(v1[2], v1[3]);
                    *(u32x4*)(rowp + bj * HALF) = w; } }
    }
};
struct EpiGateVal {
    static constexpr bool PERM = true;
    bf16_t* ACT; bf16_t* GF; bf16_t* VF; bf16_t* GL; float* ffn_p; float* ffn_s; const float* cw; const float* cb;
    __device__ __forceinline__ void operator()(const f32x4 (&acc)[2][2][4][2], const Unit& u, int wr, int wc, int fr, int fq) const {
        const int lane = threadIdx.x & 63, row0 = u.pm * BM + wr * 64 + fr, col0 = u.pn * HALF + wc * 32 + 8 * fq;
        const int src1 = (lane & 48) | ((fr - 1) & 15), src2 = (lane & 48) | ((fr - 2) & 15);
        f32x4 w0[2], w1[2], w2[2], bb[2];
#pragma unroll
        for (int n = 0; n < 2; ++n) { w0[n] = *(const f32x4*)(cw + col0 + 4 * n); w1[n] = *(const f32x4*)(cw + DFF + col0 + 4 * n); w2[n] = *(const f32x4*)(cw + 2 * DFF + col0 + 4 * n); bb[n] = *(const f32x4*)(cb + col0 + 4 * n); }
#pragma unroll
        for (int ai = 0; ai < 2; ++ai) {
            f32x4 pP1[2], pP2[2];
#pragma unroll
            for (int n = 0; n < 2; ++n) { pP1[n] = (f32x4){0.f, 0.f, 0.f, 0.f}; pP2[n] = (f32x4){0.f, 0.f, 0.f, 0.f}; }
#pragma unroll
            for (int m = 0; m < 4; ++m) { const int row = row0 + ai * HALF + m * 16; const size_t off = (size_t)row * ALD + col0;
                const f32x4 g0 = acc[ai][0][m][0], g1v = acc[ai][0][m][1], v0 = acc[ai][1][m][0], v1 = acc[ai][1][m][1];
                u32x2 a2[2];
#pragma unroll
                for (int n = 0; n < 2; ++n) { const f32x4 g = n ? g1v : g0, v = n ? v1 : v0; f32x4 P1, P2;
#pragma unroll
                    for (int j = 0; j < 4; ++j) { P1[j] = __shfl(g[j], src1); P2[j] = __shfl(g[j], src2); }
                    const f32x4 h1 = fr >= 1 ? P1 : pP1[n], h2 = fr >= 2 ? P2 : pP2[n]; pP1[n] = P1; pP2[n] = P2;
                    const f32x4 cv = bb[n] + w0[n] * h2 + w1[n] * h1 + w2[n] * g; f32x4 o;
#pragma unroll
                    for (int j = 0; j < 4; ++j) o[j] = gelu_t(cv[j]) * v[j];
                    a2[n].x = cvt_pk_bf16(o[0], o[1]); a2[n].y = cvt_pk_bf16(o[2], o[3]); }
                const bool deferred = (fr < 2) && (m == 0 || (m == 2 && row >= TP));
                if (!deferred) { *(u32x4*)(ACT + off) = (u32x4){a2[0].x, a2[0].y, a2[1].x, a2[1].y}; }
                else { const size_t so = ((size_t)(row >> 5) * 2 + (row & 1)) * DFF + col0;
                    *(u32x4*)(GF + so) = (u32x4){cvt_pk_bf16(g0[0], g0[1]), cvt_pk_bf16(g0[2], g0[3]), cvt_pk_bf16(g1v[0], g1v[1]), cvt_pk_bf16(g1v[2], g1v[3])};
                    *(u32x4*)(VF + so) = (u32x4){cvt_pk_bf16(v0[0], v0[1]), cvt_pk_bf16(v0[2], v0[3]), cvt_pk_bf16(v1[0], v1[1]), cvt_pk_bf16(v1[2], v1[3])}; }
                if (m == 3 && fr >= 14 && row < TP) { const size_t so = ((size_t)(row >> 6) * 2 + (fr - 14)) * DFF + col0;
                    *(u32x4*)(GL + so) = (u32x4){cvt_pk_bf16(g0[0], g0[1]), cvt_pk_bf16(g0[2], g0[3]), cvt_pk_bf16(g1v[0], g1v[1]), cvt_pk_bf16(g1v[2], g1v[3])}; }
                float* sp = nullptr;
                if (row < TP) { const int t = row & 4095; if (t >= 4094) sp = ffn_p + ((size_t)(row >> 12) * 2 + (t - 4094)) * DFF + col0; }
                else { const int rr = row - TP, t = rr & 31; if (t >= 30) sp = ffn_s + ((size_t)(rr >> 5) * 2 + (t - 30)) * DFF + col0; }
                if (sp) { *(f32x4*)sp = g0; *(f32x4*)(sp + 4) = g1v; } }
        }
    }
};
struct EpiGlu {
    static constexpr bool PERM = true;
    bf16_t* O; int ldc;
    __device__ __forceinline__ void operator()(const f32x4 (&acc)[2][2][4][2], const Unit& u, int wr, int wc, int fr, int fq) const {
        const int row0 = u.pm * BM + wr * 64 + fr, col0 = u.pn * HALF + wc * 32 + 8 * fq;
#pragma unroll
        for (int ai = 0; ai < 2; ++ai)
#pragma unroll
            for (int m = 0; m < 4; ++m) { const int row = row0 + ai * HALF + m * 16;
                f32x4 a0 = acc[ai][0][m][0], a1 = acc[ai][0][m][1]; const f32x4 b0 = acc[ai][1][m][0], b1 = acc[ai][1][m][1];
#pragma unroll
                for (int j = 0; j < 4; ++j) { a0[j] *= sigmoidf(b0[j]); a1[j] *= sigmoidf(b1[j]); }
                u32x4 w; w.x = cvt_pk_bf16(a0[0], a0[1]); w.y = cvt_pk_bf16(a0[2], a0[3]); w.z = cvt_pk_bf16(a1[0], a1[1]); w.w = cvt_pk_bf16(a1[2], a1[3]);
                *(u32x4*)(O + (size_t)row * ldc + col0) = w; }
    }
};

template <class Epi, class Sched>
__device__ __forceinline__ void gemm_phase(LAS unsigned char* lds, const Gemm g, const Sched& S, const Epi& E) {
    const int tid = threadIdx.x, wid = __builtin_amdgcn_readfirstlane(tid >> 6), lane = tid & 63, wr = wid >> 2, wc = wid & 3, fr = lane & 15, fq = lane >> 4;
    const int K = g.K, nt = K / BK;
    unsigned voffA[2], voffB[2];
#pragma unroll
    for (int i = 0; i < 2; ++i) { int R, C; stage_rc(tid * 16 + i * 8192, R, C); const int Rb = Epi::PERM ? ((R & ~31) + perm32(R & 31)) : R;
        voffA[i] = (unsigned)(R * g.lda + C) * 2u; voffB[i] = (unsigned)(Rb * g.ldb + C) * 2u; }
    const size_t kstep = (size_t)(BK * 2);
    const size_t hstepA = (size_t)HALF * g.lda * 2, hstepB = (size_t)HALF * g.ldb * 2;
    const size_t tstepA = 2 * hstepA, tstepB = 2 * hstepB;
    const size_t pnoff = (size_t)g.a_pn_off * 2, ksb = (size_t)g.K * 2;
    const unsigned ldsw = (unsigned)wid * 1024u;
    const int aoff = lds_byte(wr * 64 + fr, fq * 8), boff = lds_byte(wc * 32 + fr, fq * 8);
#define PG8_SA(b, h) (((b) * 2 + (h)) * HTB)
#define PG8_SB(b, h) ((4 + (b) * 2 + (h)) * HTB)
#define PG8_STAGE(bufoff, gbase, voff) do { _Pragma("unroll") for (int _i = 0; _i < 2; ++_i) \
        __builtin_amdgcn_global_load_lds((const unsigned*)((const char*)(gbase) + (voff)[_i]), (LAS unsigned*)(lds + (bufoff) + ldsw + _i * 8192), 16, 0, 0); } while (0)
#define PG8_LDA(dst, b, h) do { _Pragma("unroll") for (int m = 0; m < 4; ++m) _Pragma("unroll") for (int k = 0; k < 2; ++k) dst[m][k] = *(const LAS bf16x8*)(lds + PG8_SA(b, h) + aoff + m * 2048 + k * 1024); } while (0)
#define PG8_LDB(dst, b, h) do { _Pragma("unroll") for (int n = 0; n < 2; ++n) _Pragma("unroll") for (int k = 0; k < 2; ++k) dst[n][k] = *(const LAS bf16x8*)(lds + PG8_SB(b, h) + boff + n * 2048 + k * 1024); } while (0)
#define PG8_MMA(ai, bj, At, Bt) do { __builtin_amdgcn_s_setprio(1); _Pragma("unroll") for (int m = 0; m < 4; ++m) _Pragma("unroll") for (int n = 0; n < 2; ++n) _Pragma("unroll") for (int k = 0; k < 2; ++k) \
        acc[ai][bj][m][n] = __builtin_amdgcn_mfma_f32_16x16x32_bf16(Bt[n][k], At[m][k], acc[ai][bj][m][n], 0, 0, 0); __builtin_amdgcn_s_setprio(0); } while (0)
#define PG8_WAIT_V(n) asm volatile("s_waitcnt vmcnt(" #n ")" ::: "memory")
#define PG8_WAIT_L(n) asm volatile("s_waitcnt lgkmcnt(" #n ")" ::: "memory")
#define PG8_BAR __builtin_amdgcn_s_barrier()
#define PG8_SCHED __builtin_amdgcn_sched_barrier(0)
    Unit cur, nxt; int ui = 0;
    if (!S.next(0, cur)) return;
    f32x4 acc[2][2][4][2];
#pragma unroll
    for (int a = 0; a < 2; ++a)
#pragma unroll
        for (int b = 0; b < 2; ++b)
#pragma unroll
            for (int m = 0; m < 4; ++m)
#pragma unroll
                for (int n = 0; n < 2; ++n) acc[a][b][m][n] = (f32x4){0.f, 0.f, 0.f, 0.f};
    bf16x8 At[4][2], B0[2][2], B1[2][2];
    const char* cA = (const char*)g.A + (size_t)cur.pm * tstepA + (size_t)cur.pn * pnoff + (size_t)cur.ks * ksb; const char* cB = (const char*)g.Bt + (size_t)cur.pn * tstepB + (size_t)cur.ks * ksb;
    PG8_STAGE(PG8_SB(0, 0), cB, voffB); PG8_STAGE(PG8_SA(0, 0), cA, voffA); PG8_STAGE(PG8_SB(0, 1), cB + hstepB, voffB); PG8_STAGE(PG8_SA(0, 1), cA + hstepA, voffA);
    if (wr == 1) PG8_BAR;
    PG8_WAIT_V(4); PG8_BAR;
    PG8_STAGE(PG8_SB(1, 0), cB + kstep, voffB); PG8_STAGE(PG8_SA(1, 0), cA + kstep, voffA); PG8_STAGE(PG8_SB(1, 1), cB + hstepB + kstep, voffB);
    PG8_WAIT_V(6); PG8_BAR;
    for (;;) {
        const bool has_next = S.next(ui + 1, nxt);
        const char* nA = has_next ? (const char*)g.A + (size_t)nxt.pm * tstepA + (size_t)nxt.pn * pnoff + (size_t)nxt.ks * ksb : cA; const char* nB = has_next ? (const char*)g.Bt + (size_t)nxt.pn * tstepB + (size_t)nxt.ks * ksb : cB;
        for (int t = 0; t < nt; t += 2) {
            const bool last = (t == nt - 2);
            const char* a1 = cA + (size_t)(t + 1) * kstep;
            const char* a2 = last ? nA : cA + (size_t)(t + 2) * kstep; const char* b2 = last ? nB : cB + (size_t)(t + 2) * kstep;
            const char* a3 = a2 + kstep; const char* b3 = b2 + kstep;
            PG8_LDB(B0, 0, 0); PG8_SCHED; PG8_LDA(At, 0, 0); PG8_STAGE(PG8_SA(1, 1), a1 + hstepA, voffA);
            PG8_WAIT_L(8); PG8_BAR; PG8_WAIT_L(0); PG8_MMA(0, 0, At, B0); PG8_BAR; PG8_SCHED;
            PG8_LDB(B1, 0, 1); PG8_STAGE(PG8_SB(0, 0), b2, voffB);
            PG8_BAR; PG8_WAIT_L(0); PG8_MMA(0, 1, At, B1); PG8_BAR;
            PG8_LDA(At, 0, 1); PG8_STAGE(PG8_SA(0, 0), a2, voffA);
            PG8_BAR; PG8_WAIT_L(0); PG8_MMA(1, 0, At, B0); PG8_BAR; PG8_SCHED;
            PG8_STAGE(PG8_SB(0, 1), b2 + hstepB, voffB);
            PG8_WAIT_V(6); PG8_BAR; PG8_MMA(1, 1, At, B1); PG8_BAR;
            PG8_LDB(B0, 1, 0); PG8_SCHED; PG8_LDA(At, 1, 0); PG8_STAGE(PG8_SA(0, 1), a2 + hstepA, voffA);
            PG8_WAIT_L(8); PG8_BAR; PG8_WAIT_L(0); PG8_MMA(0, 0, At, B0); PG8_BAR; PG8_SCHED;
            PG8_LDB(B1, 1, 1); PG8_STAGE(PG8_SB(1, 0), b3, voffB);
            PG8_BAR; PG8_WAIT_L(0); PG8_MMA(0, 1, At, B1); PG8_BAR;
            PG8_LDA(At, 1, 1); PG8_STAGE(PG8_SA(1, 0), a3, voffA);
            PG8_BAR; PG8_WAIT_L(0); PG8_MMA(1, 0, At, B0); PG8_BAR; PG8_SCHED;
            PG8_STAGE(PG8_SB(1, 1), b3 + hstepB, voffB);
            PG8_WAIT_V(6); PG8_BAR; PG8_MMA(1, 1, At, B1); PG8_BAR;
        }
        E(acc, cur, wr, wc, fr, fq);
        if (!has_next) break;
#pragma unroll
        for (int a = 0; a < 2; ++a)
#pragma unroll
            for (int b = 0; b < 2; ++b)
#pragma unroll
                for (int m = 0; m < 4; ++m)
#pragma unroll
                    for (int n = 0; n < 2; ++n) acc[a][b][m][n] = (f32x4){0.f, 0.f, 0.f, 0.f};
        cur = nxt; cA = nA; cB = nB; ++ui;
    }
    PG8_WAIT_V(0);
    if (wr == 0) PG8_BAR;
    PG8_BAR;
#undef PG8_SA
#undef PG8_SB
#undef PG8_STAGE
#undef PG8_LDA
#undef PG8_LDB
#undef PG8_MMA
#undef PG8_WAIT_V
#undef PG8_WAIT_L
#undef PG8_BAR
#undef PG8_SCHED
}
}

template <class Epi>
__device__ __forceinline__ void run_gemm(LAS unsigned char* lds, const bf16_t* A, const bf16_t* Bt, int N, int K, int lda, int ldb, int a_pn_off, const Epi& E, int vb, int M = T, int cshift = 0) {
    pg8::Gemm g; g.A = A; g.Bt = Bt; g.M = M; g.N = N; g.K = K; g.lda = lda; g.ldb = ldb; g.a_pn_off = a_pn_off;
    int c = vb - cshift; if (c < 0) c += (int)gridDim.x;
    pg8::StaticOrder S; S.init(M, N, (int)gridDim.x, c);
    pg8::gemm_phase<Epi, pg8::StaticOrder>(lds, g, S, E);
}
__device__ __forceinline__ void run_gemm_split(LAS unsigned char* lds, const bf16_t* A, const bf16_t* Bt, int K, int ld, int S, bf16_t* slabs, int vb) {
    pg8::Gemm g; g.A = A + (size_t)TP * ld; g.Bt = Bt; g.M = 1024; g.N = DM; g.K = K / S; g.lda = ld; g.ldb = ld; g.a_pn_off = 0;
    pg8::SplitOrder O; O.init(8, S, (int)gridDim.x, vb);
    pg8::EpiBf16<1> E; E.O = slabs; E.ldc = DM; E.gelu_tiles = 0; E.scale = nullptr; E.slab = (size_t)1024 * DM;
    pg8::gemm_phase<pg8::EpiBf16<1>, pg8::SplitOrder>(lds, g, O, E);
}

__device__ __forceinline__ void get_job(const Params& p, int j, const float*& src, bf16_t*& dst, int& K, int& N, int& ld, int& half, const float*& nscale) {
    unsigned char* ws = p.ws; half = 0; nscale = nullptr;
    switch (j) {
        case 0: src = p.in[11]; dst = (bf16_t*)(ws + OFF_WIN_E); K = DM; N = NE; ld = NE_SRC; break;
        case 1: src = p.in[18]; dst = (bf16_t*)(ws + OFF_WOUT_E); K = DM; N = DM; ld = DM; break;
        case 2: src = p.in[32]; dst = (bf16_t*)(ws + OFF_WUP0); K = DM; N = 2 * DFF; ld = 2 * DFF; half = DFF; break;
        case 3: src = p.in[32] + (size_t)DM * 2 * DFF; dst = (bf16_t*)(ws + OFF_WUP1); K = DM; N = 2 * DFF; ld = 2 * DFF; half = DFF; break;
        case 4: src = p.in[35]; dst = (bf16_t*)(ws + OFF_WDN0); K = DFF; N = DM; ld = DM; break;
        case 5: src = p.in[35] + (size_t)DFF * DM; dst = (bf16_t*)(ws + OFF_WDN1); K = DFF; N = DM; ld = DM; break;
        case 6: src = p.in[19]; dst = (bf16_t*)(ws + OFF_WIN_O); K = DM; N = DM; ld = DM; break;
        case 7: case 8: case 9: case 10: src = p.in[20] + (size_t)(j - 7) * 65536; dst = (bf16_t*)(ws + OFF_CMAP) + (size_t)(j - 7) * 256 * CLD; K = 256; N = 256; ld = 256; nscale = p.in[21] + (j - 7) * 256; break;
        case 11: src = p.in[30]; dst = (bf16_t*)(ws + OFF_WGLU); K = 1024; N = 2048; ld = 2048; half = 1024; break;
        default: src = p.in[31]; dst = (bf16_t*)(ws + OFF_WOUT_O); K = DM; N = DM; ld = DM; break;
    }
}
struct TileInfo { const float* src; bf16_t* dst; const float* nscale; int K, ld, half, k0, n0; };
__device__ __forceinline__ void prep_decode(const Params& p, int tile, TileInfo& ti) {
    int j, t0;
    if (tile < 640) { j = 0; t0 = 0; } else if (tile < 896) { j = 1; t0 = 640; } else if (tile < 2304) { j = 2; t0 = 896; } else if (tile < 3712) { j = 3; t0 = 2304; }
    else if (tile < 4416) { j = 4; t0 = 3712; } else if (tile < 5120) { j = 5; t0 = 4416; } else if (tile < 5376) { j = 6; t0 = 5120; }
    else if (tile < 5392) { j = 7 + ((tile - 5376) >> 2); t0 = 5376 + ((tile - 5376) & ~3); } else if (tile < 5520) { j = 11; t0 = 5392; } else { j = 12; t0 = 5520; }
    int N; get_job(p, j, ti.src, ti.dst, ti.K, N, ti.ld, ti.half, ti.nscale);
    const int local = tile - t0, ntn = N >> 8, tk = local / ntn, tn = local - tk * ntn; ti.k0 = tk * 64; ti.n0 = tn * 256;
}
constexpr int NL0 = 2048, NL1 = 336, NL2 = 1456, NL3 = 640, NL4 = 592, NL5 = 704;
__device__ __forceinline__ int list_tile(int list, int q) {
    switch (list) {
        case 0: return q < 640 ? q : 896 + (q - 640);
        case 1: return q < 256 ? 640 + q : 3712 + (q - 256);
        case 2: return q < 624 ? 3792 + q : (q < 1280 ? 5120 + (q - 624) : 2304 + (q - 1280));
        case 3: return 2480 + q;
        case 4: return 3120 + q;
        default: return 4416 + q;
    }
}
template <int LIST>
__device__ __forceinline__ void prep_run(const Params& p, LAS unsigned char* lds, int q0, int qs, int qend) {
    const int tid = threadIdx.x, wid = tid >> 6, lane = tid & 63;
    constexpr int TROW = 144;
    int it = 0, q = q0;
    TileInfo cur; f32x4 v[8];
    if (q < qend) { prep_decode(p, list_tile(LIST, q), cur);
#pragma unroll
        for (int i = 0; i < 8; ++i) v[i] = *(const f32x4*)(cur.src + (size_t)(cur.k0 + wid * 8 + i) * cur.ld + cur.n0 + lane * 4); }
    while (q < qend) {
        LAS unsigned char* buf = lds + (it & 1) * (256 * TROW);
        if (cur.nscale) { const f32x4 sc = *(const f32x4*)(cur.nscale + cur.n0 + lane * 4);
#pragma unroll
            for (int i = 0; i < 8; ++i) v[i] = v[i] * sc; }
#pragma unroll
        for (int e = 0; e < 4; ++e) { u32x4 w; w.x = cvt_pk_bf16(v[0][e], v[1][e]); w.y = cvt_pk_bf16(v[2][e], v[3][e]); w.z = cvt_pk_bf16(v[4][e], v[5][e]); w.w = cvt_pk_bf16(v[6][e], v[7][e]);
            *(LAS u32x4*)(buf + (lane * 4 + e) * TROW + wid * 16) = w; }
        const int nq = q + qs; TileInfo nxt = cur;
        if (nq < qend) { prep_decode(p, list_tile(LIST, nq), nxt);
#pragma unroll
            for (int i = 0; i < 8; ++i) v[i] = *(const f32x4*)(nxt.src + (size_t)(nxt.k0 + wid * 8 + i) * nxt.ld + nxt.n0 + lane * 4); }
        __syncthreads();
#pragma unroll
        for (int i = 0; i < 4; ++i) { const int n = i * 64 + (tid >> 3), kq = (tid & 7) * 8; const int ns = cur.n0 + n;
            int drow = ns; if (cur.half) { const int which = ns >= cur.half ? 1 : 0, nn = ns - which * cur.half; drow = (nn >> 7) * 256 + which * 128 + (nn & 127); }
            *(u32x4*)(cur.dst + (size_t)drow * (cur.K + PADK) + cur.k0 + kq) = *(const LAS u32x4*)(buf + n * TROW + kq * 2); }
        cur = nxt; q = nq; ++it;
    }
    __syncthreads();
}
__device__ __forceinline__ void phase_prep(const Params& p, LAS unsigned char* lds) {
    const int tid = threadIdx.x, wid = tid >> 6, lane = tid & 63;
    prep_run<0>(p, lds, (int)blockIdx.x, (int)gridDim.x, NL0);
    if (gridDim.x != 256) {
        prep_run<1>(p, lds, (int)blockIdx.x, (int)gridDim.x, NL1); prep_run<2>(p, lds, (int)blockIdx.x, (int)gridDim.x, NL2); prep_run<3>(p, lds, (int)blockIdx.x, (int)gridDim.x, NL3);
        prep_run<4>(p, lds, (int)blockIdx.x, (int)gridDim.x, NL4); prep_run<5>(p, lds, (int)blockIdx.x, (int)gridDim.x, NL5); }
    const int gtid = blockIdx.x * 512 + tid, gstride = gridDim.x * 512;
    { bf16_t* wg = (bf16_t*)(p.ws + OFF_WG);
      for (int i = gtid; i < DM * 16; i += gstride) { const int k = i >> 4, r = i & 15; wg[r * DM + k] = (bf16_t)(cvt_pk_bf16(p.in[11][(size_t)k * NE_SRC + NE + r], 0.f) & 0xffffu); } }
    { bf16_t* wsm = (bf16_t*)(p.ws + OFF_WSM);
      for (int i = gtid; i < 8 * 128 * 128; i += gstride) { const int jj = i & 127, ii = (i >> 7) & 127; const float w = ((jj >> 6) <= (ii >> 6)) ? p.in[12][i] : 0.f; wsm[i] = (bf16_t)(cvt_pk_bf16(w, 0.f) & 0xffffu); } }
    { bf16_t* h = (bf16_t*)(p.ws + OFF_H); const float* g = p.in[7];
      for (int row = blockIdx.x * 8 + wid; row < T; row += gridDim.x * 8) {
          const float* x = xrow_in(p, row); f32x4 v[8]; float ss = 0.f;
#pragma unroll
          for (int q = 0; q < 4; ++q) { v[2 * q] = *(const f32x4*)(x + q * 512 + lane * 8); v[2 * q + 1] = *(const f32x4*)(x + q * 512 + lane * 8 + 4); }
#pragma unroll
          for (int q = 0; q < 8; ++q) ss += v[q][0] * v[q][0] + v[q][1] * v[q][1] + v[q][2] * v[q][2] + v[q][3] * v[q][3];
          ss = wave_sum(ss); const float rstd = rsqrtf(ss * (1.0f / DM) + EPS);
#pragma unroll
          for (int q = 0; q < 4; ++q) { const f32x4 ga = *(const f32x4*)(g + q * 512 + lane * 8), gb = *(const f32x4*)(g + q * 512 + lane * 8 + 4); const f32x4 a = v[2 * q] * rstd * ga, c = v[2 * q + 1] * rstd * gb;
              *(u32x4*)(h + (size_t)row * HLD + q * 512 + lane * 8) = (u32x4){cvt_pk_bf16(a[0], a[1]), cvt_pk_bf16(a[2], a[3]), cvt_pk_bf16(c[0], c[1]), cvt_pk_bf16(c[2], c[3])}; }
      } }
}

__device__ __forceinline__ void phase_norm(const Params& p, bool x_from_input, float* xout_f32, const float* g_post, const float* g_pre, const bf16_t* slabs, int nslab) {
    const int tid = threadIdx.x, wid = tid >> 6, lane = tid & 63;
    const bf16_t* m = (const bf16_t*)(p.ws + OFF_M); bf16_t* xa = (bf16_t*)(p.ws + OFF_XA); bf16_t* h = (bf16_t*)(p.ws + OFF_H);
    for (int row = blockIdx.x * 8 + wid; row < T; row += gridDim.x * 8) {
        float mv[4][8], xv[4][8]; float ss = 0.f;
        if (x_from_input) { const float* x = xrow_in(p, row);
#pragma unroll
            for (int q = 0; q < 4; ++q) { const f32x4 a = *(const f32x4*)(x + q * 512 + lane * 8), c = *(const f32x4*)(x + q * 512 + lane * 8 + 4);
#pragma unroll
                for (int e = 0; e < 4; ++e) { xv[q][e] = a[e]; xv[q][4 + e] = c[e]; } }
        } else { const bf16_t* x = xa + (size_t)row * DM;
#pragma unroll
            for (int q = 0; q < 4; ++q) { const u32x4 w = *(const u32x4*)(x + q * 512 + lane * 8);
#pragma unroll
                for (int e = 0; e < 4; ++e) { xv[q][2 * e] = bf_lo(w[e]); xv[q][2 * e + 1] = bf_hi(w[e]); } } }
        if (row < TP) { const bf16_t* mr = m + (size_t)row * DM;
#pragma unroll
            for (int q = 0; q < 4; ++q) { const u32x4 w = *(const u32x4*)(mr + q * 512 + lane * 8);
#pragma unroll
                for (int e = 0; e < 4; ++e) { mv[q][2 * e] = bf_lo(w[e]); mv[q][2 * e + 1] = bf_hi(w[e]); } }
        } else { const bf16_t* sr = slabs + (size_t)(row - TP) * DM;
#pragma unroll
            for (int q = 0; q < 4; ++q)
#pragma unroll
                for (int e = 0; e < 8; ++e) mv[q][e] = 0.f;
#pragma unroll 4
            for (int k = 0; k < nslab; ++k) {
#pragma unroll
                for (int q = 0; q < 4; ++q) { const u32x4 w = *(const u32x4*)(sr + (size_t)k * 1024 * DM + q * 512 + lane * 8);
#pragma unroll
                    for (int e = 0; e < 4; ++e) { mv[q][2 * e] += bf_lo(w[e]); mv[q][2 * e + 1] += bf_hi(w[e]); } } } }
#pragma unroll
        for (int q = 0; q < 4; ++q)
#pragma unroll
            for (int e = 0; e < 8; ++e) ss += mv[q][e] * mv[q][e];
        ss = wave_sum(ss); const float rstd = rsqrtf(ss * (1.0f / DM) + EPS); float s2 = 0.f;
#pragma unroll
        for (int q = 0; q < 4; ++q) { const f32x4 ga = *(const f32x4*)(g_post + q * 512 + lane * 8), gb = *(const f32x4*)(g_post + q * 512 + lane * 8 + 4);
#pragma unroll
            for (int e = 0; e < 8; ++e) { xv[q][e] += mv[q][e] * rstd * (e < 4 ? ga[e & 3] : gb[e & 3]); s2 += xv[q][e] * xv[q][e]; }
            if (xout_f32) { float* o = xout_f32 + (size_t)row * DM + q * 512 + lane * 8; *(f32x4*)o = (f32x4){xv[q][0], xv[q][1], xv[q][2], xv[q][3]}; *(f32x4*)(o + 4) = (f32x4){xv[q][4], xv[q][5], xv[q][6], xv[q][7]}; }
            else *(u32x4*)(xa + (size_t)row * DM + q * 512 + lane * 8) = (u32x4){cvt_pk_bf16(xv[q][0], xv[q][1]), cvt_pk_bf16(xv[q][2], xv[q][3]), cvt_pk_bf16(xv[q][4], xv[q][5]), cvt_pk_bf16(xv[q][6], xv[q][7])}; }
        if (g_pre) { s2 = wave_sum(s2); const float r2 = rsqrtf(s2 * (1.0f / DM) + EPS);
#pragma unroll
            for (int q = 0; q < 4; ++q) { const f32x4 ga = *(const f32x4*)(g_pre + q * 512 + lane * 8), gb = *(const f32x4*)(g_pre + q * 512 + lane * 8 + 4); float o[8];
#pragma unroll
                for (int e = 0; e < 8; ++e) o[e] = xv[q][e] * r2 * (e < 4 ? ga[e & 3] : gb[e & 3]);
                *(u32x4*)(h + (size_t)row * HLD + q * 512 + lane * 8) = (u32x4){cvt_pk_bf16(o[0], o[1]), cvt_pk_bf16(o[2], o[3]), cvt_pk_bf16(o[4], o[5]), cvt_pk_bf16(o[6], o[7])}; } }
    }
}

__device__ __forceinline__ void phase_glr(const Params& p, int vb) {
    const int tid = threadIdx.x, wid = tid >> 6, lane = tid & 63, fr = lane & 15, fq = lane >> 4;
    const bf16_t* h = (const bf16_t*)(p.ws + OFF_H); const bf16_t* wg = (const bf16_t*)(p.ws + OFF_WG); float* glr = (float*)(p.ws + OFF_GLR);
    for (int grp = ((int)gridDim.x - 1 - vb) * 8 + wid; grp < T / 16; grp += (int)gridDim.x * 8) {
        f32x4 acc = (f32x4){0.f, 0.f, 0.f, 0.f};
        const bf16_t* ap = h + (size_t)(grp * 16 + fr) * HLD + fq * 8; const bf16_t* bp = wg + (size_t)fr * DM + fq * 8;
#pragma unroll 8
        for (int ks = 0; ks < DM / 32; ++ks) { const bf16x8 a = *(const bf16x8*)(ap + ks * 32), b = *(const bf16x8*)(bp + ks * 32); acc = __builtin_amdgcn_mfma_f32_16x16x32_bf16(a, b, acc, 0, 0, 0); }
#pragma unroll
        for (int j = 0; j < 4; ++j) glr[(size_t)(grp * 16 + fq * 4 + j) * 16 + fr] = acc[j];
    }
}

template <int L>
__device__ __forceinline__ void amix_item(const Params& p, LAS unsigned char* lds, int item) {
    const int tid = threadIdx.x, wid = tid >> 6, lane = tid & 63;
    const bf16_t* proj = (const bf16_t*)(p.ws + OFF_PROJ); bf16_t* mix = (bf16_t*)(p.ws + OFF_MIX); const bf16_t* wsm = (const bf16_t*)(p.ws + OFF_WSM);
    const int tb = item >> 2, hp = item & 3; constexpr bool smp = (L == 32); const int row0 = smp ? TP + (tb - 64) * 32 : tb * 128;
    constexpr int VROW = 272;
    LAS float* stats = (LAS float*)(lds + 256 * VROW);
    for (int l0 = wid * 4; l0 < L; l0 += 32) {
        u32x4 a[4], b[4];
#pragma unroll
        for (int r4 = 0; r4 < 4; ++r4) { const bf16_t* r = proj + (size_t)(row0 + l0 + r4) * NE + 1024; a[r4] = *(const u32x4*)(r + lane * 8); b[r4] = *(const u32x4*)(r + 512 + lane * 8); }
#pragma unroll
        for (int r4 = 0; r4 < 4; ++r4) { float s = 0.f, q = 0.f;
#pragma unroll
            for (int e = 0; e < 4; ++e) { const float a0 = bf_lo(a[r4][e]), a1 = bf_hi(a[r4][e]), b0 = bf_lo(b[r4][e]), b1 = bf_hi(b[r4][e]); s += (a0 + a1) + (b0 + b1); q += (a0 * a0 + a1 * a1) + (b0 * b0 + b1 * b1); }
            s = wave_sum(s); q = wave_sum(q); const float mean = s * (1.0f / 1024.f), var = fmaxf(q * (1.0f / 1024.f) - mean * mean, 0.f);
            if (lane == 0) { stats[(l0 + r4) * 2] = mean; stats[(l0 + r4) * 2 + 1] = rsqrtf(var + EPS); } }
    }
    __syncthreads();
    const int c0 = hp * 256; const float* gain = p.in[14];
    for (int wi0 = tid; wi0 < L * 32; wi0 += 2048) {
        u32x4 av4[4];
#pragma unroll
        for (int u4 = 0; u4 < 4; ++u4) { const int wi = wi0 + u4 * 512; if (wi < L * 32) { const int j = wi % L, cg8 = wi / L; av4[u4] = *(const u32x4*)(proj + (size_t)(row0 + j) * NE + 1024 + c0 + cg8 * 8); } }
#pragma unroll
        for (int u4 = 0; u4 < 4; ++u4) { const int wi = wi0 + u4 * 512; if (wi < L * 32) { const int j = wi % L, cg8 = wi / L;
            const u32x4 a = av4[u4]; const float mean = stats[j * 2], rstd = stats[j * 2 + 1];
            const f32x4 g0 = *(const f32x4*)(gain + c0 + cg8 * 8), g1 = *(const f32x4*)(gain + c0 + cg8 * 8 + 4); float o[8];
#pragma unroll
            for (int e = 0; e < 4; ++e) { o[2 * e] = (bf_lo(a[e]) - mean) * rstd * (e < 2 ? g0[2 * e] : g1[2 * e - 4]); o[2 * e + 1] = (bf_hi(a[e]) - mean) * rstd * (e < 2 ? g0[2 * e + 1] : g1[2 * e - 3]); }
#pragma unroll
            for (int e = 0; e < 8; ++e) *(LAS bf16_t*)(lds + (cg8 * 8 + e) * VROW + j * 2) = (bf16_t)(cvt_pk_bf16(o[e], 0.f) & 0xffffu);
            if (smp) { float* av = p.out + O_AV + (size_t)(row0 - TP + j) * 1024 + c0 + cg8 * 8; *(f32x4*)av = (f32x4){o[0], o[1], o[2], o[3]}; *(f32x4*)(av + 4) = (f32x4){o[4], o[5], o[6], o[7]}; } } }
    }
    __syncthreads();
    const int hh = wid >> 2, dq = wid & 3, head = hp * 2 + hh, l31 = lane & 31, lh = lane >> 5;
    constexpr int nit = L >> 5, nks = L >> 4;
    f32x16 acc[4];
#pragma unroll
    for (int i = 0; i < 4; ++i)
#pragma unroll
        for (int r = 0; r < 16; ++r) acc[i][r] = 0.f;
    const LAS unsigned char* ap = lds + (hh * 128 + dq * 32 + l31) * VROW + lh * 16;
    const bf16_t* bp = wsm + (size_t)head * 16384 + (size_t)l31 * 128 + lh * 8;
    bf16x8 bq[4], bn[4];
#pragma unroll
    for (int i = 0; i < 4; ++i) { bq[i] = (bf16x8){0, 0, 0, 0, 0, 0, 0, 0}; if (i < nit) bq[i] = *(const bf16x8*)(bp + (size_t)i * 32 * 128); }
#pragma unroll
    for (int ks = 0; ks < nks; ++ks) {
        const bf16x8 a = *(const LAS bf16x8*)(ap + ks * 32);
#pragma unroll
        for (int i = 0; i < 4; ++i) { bn[i] = bq[i]; if (i < nit && ks + 1 < nks) bn[i] = *(const bf16x8*)(bp + (size_t)i * 32 * 128 + (ks + 1) * 16); }
#pragma unroll
        for (int i = 0; i < 4; ++i) if (i < nit) acc[i] = __builtin_amdgcn_mfma_f32_32x32x16_bf16(a, bq[i], acc[i], 0, 0, 0);
#pragma unroll
        for (int i = 0; i < 4; ++i) bq[i] = bn[i];
    }
    const float* bs = p.in[13] + head * 128;
#pragma unroll
    for (int i = 0; i < 4; ++i) if (i < nit) { const int ii = i * 32 + l31, row = row0 + ii; const float bias = bs[ii];
#pragma unroll
        for (int rg = 0; rg < 4; ++rg) { const int d = dq * 32 + rg * 8 + lh * 4, c = head * 128 + d; const u32x2 uu = *(const u32x2*)(proj + (size_t)row * NE + c);
            u32x2 w; w.x = cvt_pk_bf16(bf_lo(uu.x) * (acc[i][rg * 4] + bias), bf_hi(uu.x) * (acc[i][rg * 4 + 1] + bias)); w.y = cvt_pk_bf16(bf_lo(uu.y) * (acc[i][rg * 4 + 2] + bias), bf_hi(uu.y) * (acc[i][rg * 4 + 3] + bias));
            *(u32x2*)(mix + (size_t)row * HLD + c) = w; } }
    __syncthreads();
}

__device__ __forceinline__ void gla_item_decode(int it, int& s, int& h, int& row0, int& L) {
    if (it < 512) { s = it >> 8; h = (it >> 6) & 3; row0 = s * 4096 + (it & 63) * 64; L = 64; } else { const int q = it - 512; s = q >> 2; h = q & 3; row0 = TP + s * 32; L = 32; }
}
template <int L>
__device__ __forceinline__ void glau_item(const Params& p, LAS unsigned char* lds, int it) {
    const int tid = threadIdx.x, wid = tid >> 6, lane = tid & 63;
    const bf16_t* proj = (const bf16_t*)(p.ws + OFF_PROJ); const float* glr = (const float*)(p.ws + OFF_GLR);
    int s, h, row0, Lrt; gla_item_decode(it, s, h, row0, Lrt); constexpr bool smp = (L == 32);
    constexpr int KROW = 144;
    LAS unsigned char* kdT = lds;
    LAS unsigned char* vT = lds + 128 * KROW;
    LAS float* glt = (LAS float*)(lds + 384 * KROW);
    LAS float* part = glt + 64 * 16;
    LAS float* totl = part + 4 * 128;
    if (tid < L * 4) *(LAS f32x4*)(glt + tid * 4) = *(const f32x4*)(glr + (size_t)row0 * 16 + tid * 4);
    __syncthreads();
    const int d = tid & 127, lq = tid >> 7; constexpr int Lq = L >> 2;
    float wg[16];
#pragma unroll
    for (int r = 0; r < 16; ++r) wg[r] = p.in[15][r * 512 + h * 128 + d];
    const float gb = p.in[16][h * 128 + d];
    float cum[16]; float run = 0.f;
#pragma unroll
    for (int i = 0; i < 16; ++i) { cum[i] = 0.f; if (i < Lq) { const int l = lq * Lq + i; float x = gb;
#pragma unroll
            for (int r4 = 0; r4 < 4; ++r4) { const f32x4 gg = *(const LAS f32x4*)(glt + l * 16 + r4 * 4); x += gg[0] * wg[r4 * 4] + gg[1] * wg[r4 * 4 + 1] + gg[2] * wg[r4 * 4 + 2] + gg[3] * wg[r4 * 4 + 3]; }
            const float ls = fminf(x, 0.f) - __logf(1.0f + __expf(-fabsf(x)));
            run += ls * (1.0f / 16.0f); cum[i] = run; } }
    part[lq * 128 + d] = run;
    __syncthreads();
    float offs = 0.f, tot = 0.f;
#pragma unroll
    for (int q = 0; q < 4; ++q) { const float pv = part[q * 128 + d]; tot += pv; if (q < lq) offs += pv; }
    if (lq == 0) { totl[d] = tot; ((float*)(p.ws + OFF_DECAY))[(size_t)it * 128 + d] = __expf(tot); }
    { unsigned pk[8];
#pragma unroll
      for (int i = 0; i < 16; i += 2) { float v0 = 0.f, v1 = 0.f;
          if (i < Lq) { const int l = lq * Lq + i; v0 = bf1(proj[(size_t)(row0 + l) * NE + 2560 + h * 128 + d]) * __expf(tot - offs - cum[i]); v1 = bf1(proj[(size_t)(row0 + l + 1) * NE + 2560 + h * 128 + d]) * __expf(tot - offs - cum[i + 1]); }
          pk[i >> 1] = cvt_pk_bf16(v0, v1); }
      LAS unsigned char* dstp = kdT + d * KROW + lq * Lq * 2;
      *(LAS u32x4*)dstp = (u32x4){pk[0], pk[1], pk[2], pk[3]};
      if (Lq == 16) *(LAS u32x4*)(dstp + 16) = (u32x4){pk[4], pk[5], pk[6], pk[7]}; }
    { const int v = tid & 255, hf = tid >> 8; constexpr int Lh = L >> 1; unsigned pk[16];
#pragma unroll
      for (int i = 0; i < 32; i += 2) { unsigned a = 0, b = 0; if (i < Lh) { const int l = hf * Lh + i; a = proj[(size_t)(row0 + l) * NE + 3072 + h * 256 + v]; b = proj[(size_t)(row0 + l + 1) * NE + 3072 + h * 256 + v]; } pk[i >> 1] = a | (b << 16); }
      LAS unsigned char* dstp = vT + v * KROW + hf * Lh * 2;
      *(LAS u32x4*)dstp = (u32x4){pk[0], pk[1], pk[2], pk[3]}; *(LAS u32x4*)(dstp + 16) = (u32x4){pk[4], pk[5], pk[6], pk[7]};
      if (Lh == 32) { *(LAS u32x4*)(dstp + 32) = (u32x4){pk[8], pk[9], pk[10], pk[11]}; *(LAS u32x4*)(dstp + 48) = (u32x4){pk[12], pk[13], pk[14], pk[15]}; } }
    __syncthreads();
    const int l31 = lane & 31, lh = lane >> 5, vs = wid * 32; constexpr int nks = L >> 4;
    f32x16 acc[4];
#pragma unroll
    for (int i = 0; i < 4; ++i)
#pragma unroll
        for (int r = 0; r < 16; ++r) acc[i][r] = 0.f;
#pragma unroll
    for (int ks = 0; ks < nks; ++ks) { const bf16x8 b = *(const LAS bf16x8*)(vT + (vs + l31) * KROW + ks * 32 + lh * 16);
#pragma unroll
        for (int dt = 0; dt < 4; ++dt) { const bf16x8 a = *(const LAS bf16x8*)(kdT + (dt * 32 + l31) * KROW + ks * 32 + lh * 16); acc[dt] = __builtin_amdgcn_mfma_f32_32x32x16_bf16(a, b, acc[dt], 0, 0, 0); } }
    const int v = vs + l31;
    if (!smp) { bf16_t* ut = (bf16_t*)(p.ws + OFF_UT) + ((size_t)it * 256 + v) * 128;
#pragma unroll
        for (int dt = 0; dt < 4; ++dt)
#pragma unroll
            for (int rg = 0; rg < 4; ++rg) { u32x2 w; w.x = cvt_pk_bf16(acc[dt][rg * 4], acc[dt][rg * 4 + 1]); w.y = cvt_pk_bf16(acc[dt][rg * 4 + 2], acc[dt][rg * 4 + 3]); *(u32x2*)(ut + dt * 32 + rg * 8 + lh * 4) = w; }
    } else { const float* s0 = p.in[2] + ((size_t)s * 4 + h) * 128 * 256; float* so = p.out + O_GLA_S + ((size_t)s * 4 + h) * 128 * 256; bf16_t* st = (bf16_t*)(p.ws + OFF_ST) + ((size_t)it * 256 + v) * 128;
#pragma unroll
        for (int dt = 0; dt < 4; ++dt)
#pragma unroll
            for (int rg = 0; rg < 4; ++rg) { const int dd = dt * 32 + rg * 8 + lh * 4; float sv[4];
#pragma unroll
                for (int e = 0; e < 4; ++e) { sv[e] = __expf(totl[dd + e]) * s0[(size_t)(dd + e) * 256 + v] + acc[dt][rg * 4 + e]; so[(size_t)(dd + e) * 256 + v] = sv[e]; }
                u32x2 w; w.x = cvt_pk_bf16(sv[0], sv[1]); w.y = cvt_pk_bf16(sv[2], sv[3]); *(u32x2*)(st + dd) = w; } }
    __syncthreads();
}

__device__ __forceinline__ void phase_gla_scan(const Params& p) {
    for (int gtid = blockIdx.x * 512 + threadIdx.x; gtid < 2 * 4 * 256 * 64; gtid += gridDim.x * 512) {
    const int dq = gtid & 63, v = (gtid >> 6) & 255, sh = gtid >> 14;
    const bf16_t* ut = (const bf16_t*)(p.ws + OFF_UT); const float* dec = (const float*)(p.ws + OFF_DECAY); bf16_t* st = (bf16_t*)(p.ws + OFF_ST);
    f32x2 S = (f32x2){0.f, 0.f};
#pragma unroll 16
    for (int c = 0; c < 64; ++c) { const int it = sh * 64 + c; const unsigned uw = *(const unsigned*)(ut + ((size_t)it * 256 + v) * 128 + dq * 2); const f32x2 u = (f32x2){bf_lo(uw), bf_hi(uw)}, dc = *(const f32x2*)(dec + (size_t)it * 128 + dq * 2);
        S = S * dc + u; *(unsigned*)(st + ((size_t)it * 256 + v) * 128 + dq * 2) = cvt_pk_bf16(S[0], S[1]); }
    float* o = p.out + O_GLA_P + (size_t)sh * 128 * 256;
    o[(size_t)(dq * 2) * 256 + v] = S[0]; o[(size_t)(dq * 2 + 1) * 256 + v] = S[1];
    }
}

template <int L>
__device__ __forceinline__ void glao_item(const Params& p, LAS unsigned char* lds, int it) {
    const int tid = threadIdx.x, wid = tid >> 6, lane = tid & 63, l31 = lane & 31, lh = lane >> 5;
    const bf16_t* proj = (const bf16_t*)(p.ws + OFF_PROJ); bf16_t* mix = (bf16_t*)(p.ws + OFF_MIX);
    int s, h, row0, Lrt; gla_item_decode(it, s, h, row0, Lrt);
    constexpr int nlt = L >> 5; const int vs = wid * 32;
    LAS float* red = (LAS float*)lds;
    const bf16_t* ap = (const bf16_t*)(p.ws + OFF_ST) + ((size_t)it * 256 + vs + l31) * 128 + lh * 8;
    const bf16_t* bp = proj + (size_t)(row0 + l31) * NE + 2048 + h * 128 + lh * 8;
    f32x16 acc[2];
#pragma unroll
    for (int i = 0; i < 2; ++i)
#pragma unroll
        for (int r = 0; r < 16; ++r) acc[i][r] = 0.f;
#pragma unroll
    for (int ks = 0; ks < 8; ++ks) { const bf16x8 a = *(const bf16x8*)(ap + ks * 16);
#pragma unroll
        for (int lt = 0; lt < 2; ++lt) if (lt < nlt) { const bf16x8 b = *(const bf16x8*)(bp + (size_t)lt * 32 * NE + ks * 16); acc[lt] = __builtin_amdgcn_mfma_f32_32x32x16_bf16(a, b, acc[lt], 0, 0, 0); } }
    const float qs = 0.08838834764831845f;
#pragma unroll
    for (int lt = 0; lt < 2; ++lt) { float ss = 0.f;
#pragma unroll
        for (int r = 0; r < 16; ++r) { acc[lt][r] *= qs; ss += acc[lt][r] * acc[lt][r]; }
        ss += __shfl_xor(ss, 32);
        if (lh == 0) red[wid * 64 + lt * 32 + l31] = ss; }
    __syncthreads();
    const float* og = p.in[17] + h * 256;
#pragma unroll
    for (int lt = 0; lt < 2; ++lt) if (lt < nlt) { float tot = 0.f;
#pragma unroll
        for (int w = 0; w < 8; ++w) tot += red[w * 64 + lt * 32 + l31];
        const float rstd = rsqrtf(tot * (1.0f / 256.f) + EPS); const int row = row0 + lt * 32 + l31;
#pragma unroll
        for (int rg = 0; rg < 4; ++rg) { const int vv = vs + rg * 8 + lh * 4; const u32x2 rr = *(const u32x2*)(proj + (size_t)row * NE + 4096 + h * 256 + vv); const f32x4 gg = *(const f32x4*)(og + vv);
            const float r0 = bf_lo(rr.x), r1 = bf_hi(rr.x), r2 = bf_lo(rr.y), r3 = bf_hi(rr.y);
            u32x2 w; w.x = cvt_pk_bf16(acc[lt][rg * 4] * rstd * gg[0] * r0 * sigmoidf(r0), acc[lt][rg * 4 + 1] * rstd * gg[1] * r1 * sigmoidf(r1));
            w.y = cvt_pk_bf16(acc[lt][rg * 4 + 2] * rstd * gg[2] * r2 * sigmoidf(r2), acc[lt][rg * 4 + 3] * rstd * gg[3] * r3 * sigmoidf(r3));
            *(u32x2*)(mix + (size_t)row * HLD + 1024 + h * 256 + vv) = w; } }
    __syncthreads();
}

__device__ __forceinline__ void phase_convfix(const Params& p, int layer) {
    bf16_t* ACT = (bf16_t*)(p.ws + OFF_VAL); const bf16_t* GF = (const bf16_t*)(p.ws + OFF_GF); const bf16_t* VF = (const bf16_t*)(p.ws + OFF_VF); const bf16_t* GL = (const bf16_t*)(p.ws + OFF_GL);
    const float* cw = p.in[33] + (size_t)layer * 3 * DFF; const float* cb = p.in[34] + (size_t)layer * DFF; const float* st = p.in[6] + (size_t)layer * 32 * 2 * DFF;
    for (int idx = blockIdx.x * 512 + threadIdx.x; idx < 160 * 704; idx += gridDim.x * 512) {
        const int pr = idx / 704, c = (idx - pr * 704) * 8;
        const int ra = pr < 128 ? pr * 64 : TP + (pr - 128) * 32, hb = ra >> 5;
        float w0[8], w1[8], w2[8], bb[8], h0[8], h1[8], ga[8], gb[8], va[8], vb[8];
#pragma unroll
        for (int e = 0; e < 8; e += 4) { const f32x4 a = *(const f32x4*)(cw + c + e), b = *(const f32x4*)(cw + DFF + c + e), d = *(const f32x4*)(cw + 2 * DFF + c + e), f = *(const f32x4*)(cb + c + e);
#pragma unroll
            for (int j = 0; j < 4; ++j) { w0[e + j] = a[j]; w1[e + j] = b[j]; w2[e + j] = d[j]; bb[e + j] = f[j]; } }
        if (ra >= TP) { const float* sp = st + (size_t)(pr - 128) * 2 * DFF + c;
#pragma unroll
            for (int e = 0; e < 8; e += 4) { const f32x4 a = *(const f32x4*)(sp + e), b = *(const f32x4*)(sp + DFF + e);
#pragma unroll
                for (int j = 0; j < 4; ++j) { h0[e + j] = a[j]; h1[e + j] = b[j]; } } }
        else if ((ra & 4095) == 0) {
#pragma unroll
            for (int e = 0; e < 8; ++e) { h0[e] = 0.f; h1[e] = 0.f; } }
        else { const u32x4 a = *(const u32x4*)(GL + ((size_t)((ra >> 6) - 1) * 2) * DFF + c), b = *(const u32x4*)(GL + ((size_t)((ra >> 6) - 1) * 2 + 1) * DFF + c);
#pragma unroll
            for (int e = 0; e < 4; ++e) { h0[2 * e] = bf_lo(a[e]); h0[2 * e + 1] = bf_hi(a[e]); h1[2 * e] = bf_lo(b[e]); h1[2 * e + 1] = bf_hi(b[e]); } }
        { const u32x4 a = *(const u32x4*)(GF + ((size_t)hb * 2) * DFF + c), b = *(const u32x4*)(GF + ((size_t)hb * 2 + 1) * DFF + c), d = *(const u32x4*)(VF + ((size_t)hb * 2) * DFF + c), f = *(const u32x4*)(VF + ((size_t)hb * 2 + 1) * DFF + c);
#pragma unroll
          for (int e = 0; e < 4; ++e) { ga[2 * e] = bf_lo(a[e]); ga[2 * e + 1] = bf_hi(a[e]); gb[2 * e] = bf_lo(b[e]); gb[2 * e + 1] = bf_hi(b[e]); va[2 * e] = bf_lo(d[e]); va[2 * e + 1] = bf_hi(d[e]); vb[2 * e] = bf_lo(f[e]); vb[2 * e + 1] = bf_hi(f[e]); } }
        float oa[8], ob[8];
#pragma unroll
        for (int e = 0; e < 8; ++e) { oa[e] = gelu_t(bb[e] + w0[e] * h0[e] + w1[e] * h1[e] + w2[e] * ga[e]) * va[e]; ob[e] = gelu_t(bb[e] + w0[e] * h1[e] + w1[e] * ga[e] + w2[e] * gb[e]) * vb[e]; }
        *(u32x4*)(ACT + (size_t)ra * ALD + c) = (u32x4){cvt_pk_bf16(oa[0], oa[1]), cvt_pk_bf16(oa[2], oa[3]), cvt_pk_bf16(oa[4], oa[5]), cvt_pk_bf16(oa[6], oa[7])};
        *(u32x4*)(ACT + (size_t)(ra + 1) * ALD + c) = (u32x4){cvt_pk_bf16(ob[0], ob[1]), cvt_pk_bf16(ob[2], ob[3]), cvt_pk_bf16(ob[4], ob[5]), cvt_pk_bf16(ob[6], ob[7])};
    }
}

template <int W>
__device__ __forceinline__ void pool_item(const Params& p, const bf16_t* proj2, bf16_t* delta, int r8, int c) {
    const int row0 = r8 * 8; const bool smp = row0 >= TP;
    const int seq = smp ? (row0 - TP) >> 5 : row0 >> 12, t0 = smp ? (row0 - TP) & 31 : row0 & 4095, rowbase = row0 - t0;
    const float* spool = p.in[3] + (size_t)seq * 15 * 1024 + c;
    f32x4 xs[W + 7];
#pragma unroll
    for (int j = 0; j < W + 7; ++j) { const int t = t0 - (W - 1) + j; const bool hist = smp && t < 0; const bool ok = t >= 0 || hist;
        f32x4 v;
        if (hist) v = *(const f32x4*)(spool + (size_t)(15 + t) * 1024);
        else { const u32x2 w = *(const u32x2*)(proj2 + (size_t)(rowbase + (t >= 0 ? t : 0)) * DM + c); v = (f32x4){bf_lo(w.x), bf_hi(w.x), bf_lo(w.y), bf_hi(w.y)}; }
        xs[j] = ok ? v : (f32x4){0.f, 0.f, 0.f, 0.f}; }
    f32x4 Wd = xs[0];
#pragma unroll
    for (int j = 1; j < W; ++j) Wd = Wd + xs[j];
#pragma unroll
    for (int u = 0; u < 8; ++u) { const int t = t0 + u; const f32x4 x = xs[u + W - 1];
        const float cnt = smp ? (float)W : (float)((t + 1) < W ? (t + 1) : W); const f32x4 dl = Wd * (1.0f / cnt) - x;
        u32x2 o; o.x = cvt_pk_bf16(dl[0], dl[1]); o.y = cvt_pk_bf16(dl[2], dl[3]); *(u32x2*)(delta + (size_t)(row0 + u) * YLD + c) = o;
        if (!smp && t >= 4081) *(f32x4*)(p.out + O_POOL_P + ((size_t)seq * 15 + (t - 4081)) * 1024 + c) = x;
        if (smp && t >= 17) *(f32x4*)(p.out + O_POOL_S + ((size_t)seq * 15 + (t - 17)) * 1024 + c) = x;
        if (u < 7) Wd = Wd + xs[u + W] - xs[u]; }
}
__device__ __forceinline__ void phase_pool(const Params& p) {
    const bf16_t* proj2 = (const bf16_t*)(p.ws + OFF_PROJ2); bf16_t* delta = (bf16_t*)(p.ws + OFF_DELTA);
    for (int idx = blockIdx.x * 512 + threadIdx.x; idx < (T / 8) * 256; idx += gridDim.x * 512) {
        const int r8 = idx >> 8, c = (idx & 255) * 4, g = c >> 8;
        if (g == 0) pool_item<2>(p, proj2, delta, r8, c); else if (g == 1) pool_item<4>(p, proj2, delta, r8, c);
        else if (g == 2) pool_item<8>(p, proj2, delta, r8, c); else pool_item<16>(p, proj2, delta, r8, c);
    }
}

template <int PASS>
__device__ __forceinline__ void phase_s5(const Params& p, LAS unsigned char* lds, int nitems) {
    const int tid = threadIdx.x, wid = tid >> 6, lane = tid & 63, hcol = lane & 15, q4 = lane >> 4;
    const float* proj2 = (const float*)(p.ws + OFF_PROJ2); float* Eb = (float*)(p.ws + OFF_E); bf16_t* yb = (bf16_t*)(p.ws + OFF_YB);
    LAS float* ut = (LAS float*)lds;
    constexpr int SROW = 272;
    LAS unsigned char* sb = lds + 32768 + wid * 32 * SROW;
    int oct_cur = -1;
    float lbr = 0.f, lbi = 0.f, p64r = 0.f, p64i = 0.f, dsk = 0.f; f32x2 bb[16]; bf16x8 Bc[4];
#pragma unroll
    for (int i = 0; i < 16; ++i) bb[i] = (f32x2){0.f, 0.f};
#pragma unroll
    for (int i = 0; i < 4; ++i) Bc[i] = (bf16x8){0, 0, 0, 0, 0, 0, 0, 0};
    f32x4 un[4];
    auto issue_u = [&](int item) {
        const int cs = item >> 3, oct = item & 7; const bool smp = cs >= 128;
        const int b = smp ? cs - 128 : cs >> 6, ch = smp ? 0 : cs & 63, L = smp ? 32 : 64, row0 = smp ? TP + b * 32 : b * 4096 + ch * 64;
#pragma unroll
        for (int k = 0; k < 4; ++k) { const int i = tid + k * 512; un[k] = (f32x4){0.f, 0.f, 0.f, 0.f}; if (i < L * 32) un[k] = *(const f32x4*)(proj2 + (size_t)(row0 + (i >> 5)) * DM + 1024 + oct * 128 + (i & 31) * 4); }
    };
    if ((int)blockIdx.x < nitems) issue_u((int)blockIdx.x);
    for (int item = blockIdx.x; item < nitems; item += gridDim.x) {
        const int cs = item >> 3, oct = item & 7, g = oct * 8 + wid; const bool smp = cs >= 128;
        const int b = smp ? cs - 128 : cs >> 6, ch = smp ? 0 : cs & 63, L = smp ? 32 : 64, row0 = smp ? TP + b * 32 : b * 4096 + ch * 64;
#pragma unroll
        for (int k = 0; k < 4; ++k) { const int i = tid + k * 512; if (i < L * 32) *(LAS f32x4*)(ut + (i >> 5) * 128 + (i & 31) * 4) = un[k]; }
        if (item + (int)gridDim.x < nitems) issue_u(item + (int)gridDim.x);
        if (oct != oct_cur) {
            oct_cur = oct;
            const float are = p.in[22][g * 64 + lane], aim = p.in[23][g * 64 + lane], dt = __expf(p.in[24][g]);
            const float er = __expf(are * dt); float rev = aim * dt * 0.15915494309189535f; rev -= floorf(rev);
            lbr = er * __builtin_amdgcn_cosf(rev); lbi = er * __builtin_amdgcn_sinf(rev);
            const float den = 1.0f / (are * are + aim * aim); const float nr = lbr - 1.0f, ni = lbi;
            const float cr = (nr * are + ni * aim) * den, ci = (ni * are - nr * aim) * den;
            const float* br = p.in[25] + ((size_t)g * 64 + lane) * 16; const float* bi = p.in[26] + ((size_t)g * 64 + lane) * 16;
#pragma unroll
            for (int q = 0; q < 4; ++q) { const f32x4 x = *(const f32x4*)(br + q * 4), y = *(const f32x4*)(bi + q * 4);
#pragma unroll
                for (int e = 0; e < 4; ++e) bb[q * 4 + e] = (f32x2){cr * x[e] - ci * y[e], cr * y[e] + ci * x[e]}; }
            if (PASS == 2) {
                p64r = lbr; p64i = lbi;
#pragma unroll
                for (int q = 0; q < 6; ++q) { const float t = p64r * p64r - p64i * p64i; p64i = 2.f * p64r * p64i; p64r = t; }
#pragma unroll
                for (int ks = 0; ks < 4; ++ks) { const float* src = (ks < 2 ? p.in[27] : p.in[28]) + ((size_t)g * 16 + hcol) * 64 + (ks & 1) * 32 + q4 * 8; const float sg = ks < 2 ? 1.f : -1.f;
                    const f32x4 x = *(const f32x4*)src, y = *(const f32x4*)(src + 4); u32x4 w; w.x = cvt_pk_bf16(sg * x[0], sg * x[1]); w.y = cvt_pk_bf16(sg * x[2], sg * x[3]); w.z = cvt_pk_bf16(sg * y[0], sg * y[1]); w.w = cvt_pk_bf16(sg * y[2], sg * y[3]);
                    Bc[ks] = __builtin_bit_cast(bf16x8, w); }
                dsk = p.in[29][g * 16 + hcol]; }
        }
        float sr = 0.f, si = 0.f;
        if (PASS == 2) {
            if (smp) { sr = p.in[4][((size_t)b * 64 + g) * 64 + lane]; si = p.in[5][((size_t)b * 64 + g) * 64 + lane]; }
            else { const float* e0 = Eb + (((size_t)b * 64) * 64 + g) * 128 + lane * 2;
                for (int j0 = 0; j0 < ch; j0 += 16) { f32x2 ev[16];
#pragma unroll
                    for (int jj = 0; jj < 16; ++jj) { const int j = (j0 + jj) < ch ? (j0 + jj) : (ch - 1); ev[jj] = *(const f32x2*)(e0 + (size_t)j * 64 * 128); }
#pragma unroll
                    for (int jj = 0; jj < 16; ++jj) { const bool on = (j0 + jj) < ch; const float t = p64r * sr - p64i * si + ev[jj].x, u2 = p64r * si + p64i * sr + ev[jj].y; sr = on ? t : sr; si = on ? u2 : si; } } }
        }
        __syncthreads();
        for (int sub = 0; sub < L; sub += 32) {
#pragma unroll 2
            for (int tt = 0; tt < 32; ++tt) { const int t = sub + tt; f32x2 bu0 = (f32x2){0.f, 0.f}, bu1 = (f32x2){0.f, 0.f};
#pragma unroll
                for (int q = 0; q < 4; ++q) { const f32x4 u = *(const LAS f32x4*)(ut + t * 128 + wid * 16 + q * 4);
                    bu0 = bu0 + bb[q * 4] * u[0]; bu1 = bu1 + bb[q * 4 + 1] * u[1]; bu0 = bu0 + bb[q * 4 + 2] * u[2]; bu1 = bu1 + bb[q * 4 + 3] * u[3]; }
                const float bur = bu0[0] + bu1[0], bui = bu0[1] + bu1[1];
                const float nr2 = lbr * sr - lbi * si + bur; si = lbr * si + lbi * sr + bui; sr = nr2;
                if (PASS == 2) { *(LAS bf16_t*)(sb + tt * SROW + lane * 2) = (bf16_t)(cvt_pk_bf16(sr, 0.f) & 0xffffu); *(LAS bf16_t*)(sb + tt * SROW + 128 + lane * 2) = (bf16_t)(cvt_pk_bf16(si, 0.f) & 0xffffu); } }
            if (PASS == 2) {
                __syncthreads();
#pragma unroll
                for (int mt = 0; mt < 2; ++mt) { f32x4 acc = (f32x4){0.f, 0.f, 0.f, 0.f};
#pragma unroll
                    for (int ks = 0; ks < 4; ++ks) { const bf16x8 a = *(const LAS bf16x8*)(sb + (mt * 16 + hcol) * SROW + ks * 64 + q4 * 16); acc = __builtin_amdgcn_mfma_f32_16x16x32_bf16(a, Bc[ks], acc, 0, 0, 0); }
#pragma unroll
                    for (int j = 0; j < 4; ++j) { const int t = sub + mt * 16 + q4 * 4 + j; const float y = acc[j] + dsk * ut[t * 128 + wid * 16 + hcol];
                        yb[(size_t)(row0 + t) * YLD + g * 16 + hcol] = (bf16_t)(cvt_pk_bf16(gelu_t(y), 0.f) & 0xffffu); } }
                __syncthreads();
            }
        }
        if (PASS == 1) { *(f32x2*)(Eb + ((((size_t)b * 64 + ch) * 64) + g) * 128 + lane * 2) = (f32x2){sr, si}; }
        else { if (smp) { p.out[O_S5RE_S + ((size_t)b * 64 + g) * 64 + lane] = sr; p.out[O_S5IM_S + ((size_t)b * 64 + g) * 64 + lane] = si; }
               else if (ch == 63) { p.out[O_S5RE_P + ((size_t)b * 64 + g) * 64 + lane] = sr; p.out[O_S5IM_P + ((size_t)b * 64 + g) * 64 + lane] = si; } }
        __syncthreads();
    }
}


__device__ __forceinline__ void phase_s5_ends(const Params& p, LAS unsigned char* lds, int nitems) {
    const int tid = threadIdx.x, wid = tid >> 6, lane = tid & 63, l31 = lane & 31, hh = lane >> 5;
    const bf16_t* proj2 = (const bf16_t*)(p.ws + OFF_PROJ2); float* Eb = (float*)(p.ws + OFF_E);
    constexpr int UROW = 272;
    int oct_cur = -1;
    float lr[2] = {0.f, 0.f}, li[2] = {0.f, 0.f}, l4r[2] = {0.f, 0.f}, l4i[2] = {0.f, 0.f}; bf16x8 Bre[2], Bim[2];
#pragma unroll
    for (int i = 0; i < 2; ++i) { Bre[i] = (bf16x8){0, 0, 0, 0, 0, 0, 0, 0}; Bim[i] = Bre[i]; }
    for (int item = blockIdx.x; item < nitems; item += gridDim.x) {
        const int cs = item >> 3, oct = item & 7, g = oct * 8 + wid, b = cs >> 6, ch = cs & 63, row0 = b * 4096 + ch * 64;
#pragma unroll
        for (int k = 0; k < 4; ++k) { const int i = tid + k * 512, t = i >> 5, q = i & 31; const u32x2 w = *(const u32x2*)(proj2 + (size_t)(row0 + t) * DM + 1024 + oct * 128 + q * 4);
            *(LAS u32x2*)(lds + t * UROW + q * 8) = w; }
        if (oct != oct_cur) { oct_cur = oct;
            const float dt = __expf(p.in[24][g]);
#pragma unroll
            for (int sx = 0; sx < 2; ++sx) { const int st = l31 + 32 * sx;
                const float are = p.in[22][g * 64 + st], aim = p.in[23][g * 64 + st];
                const float er = __expf(are * dt); float rev = aim * dt * 0.15915494309189535f; rev -= floorf(rev);
                lr[sx] = er * __builtin_amdgcn_cosf(rev); li[sx] = er * __builtin_amdgcn_sinf(rev);
                const float den = 1.0f / (are * are + aim * aim); const float nr = lr[sx] - 1.0f, ni = li[sx];
                const float cr = (nr * are + ni * aim) * den, ci = (ni * are - nr * aim) * den;
                const float* br = p.in[25] + ((size_t)g * 64 + st) * 16 + hh * 8; const float* bi = p.in[26] + ((size_t)g * 64 + st) * 16 + hh * 8;
                const f32x4 x0 = *(const f32x4*)br, x1 = *(const f32x4*)(br + 4), y0 = *(const f32x4*)bi, y1 = *(const f32x4*)(bi + 4);
                u32x4 wr, wi;
                wr.x = cvt_pk_bf16(cr * x0[0] - ci * y0[0], cr * x0[1] - ci * y0[1]); wr.y = cvt_pk_bf16(cr * x0[2] - ci * y0[2], cr * x0[3] - ci * y0[3]);
                wr.z = cvt_pk_bf16(cr * x1[0] - ci * y1[0], cr * x1[1] - ci * y1[1]); wr.w = cvt_pk_bf16(cr * x1[2] - ci * y1[2], cr * x1[3] - ci * y1[3]);
                wi.x = cvt_pk_bf16(cr * y0[0] + ci * x0[0], cr * y0[1] + ci * x0[1]); wi.y = cvt_pk_bf16(cr * y0[2] + ci * x0[2], cr * y0[3] + ci * x0[3]);
                wi.z = cvt_pk_bf16(cr * y1[0] + ci * x1[0], cr * y1[1] + ci * x1[1]); wi.w = cvt_pk_bf16(cr * y1[2] + ci * x1[2], cr * y1[3] + ci * x1[3]);
                Bre[sx] = __builtin_bit_cast(bf16x8, wr); Bim[sx] = __builtin_bit_cast(bf16x8, wi);
                const float t2r = lr[sx] * lr[sx] - li[sx] * li[sx], t2i = 2.f * lr[sx] * li[sx]; l4r[sx] = t2r * t2r - t2i * t2i; l4i[sx] = 2.f * t2r * t2i; } }
        __syncthreads();
        float sr[2] = {0.f, 0.f}, si[2] = {0.f, 0.f};
#pragma unroll
        for (int sub = 0; sub < 2; ++sub) {
            const bf16x8 a = *(const LAS bf16x8*)(lds + (sub * 32 + l31) * UROW + (wid * 16 + hh * 8) * 2);
            f32x16 z;
#pragma unroll
            for (int r = 0; r < 16; ++r) z[r] = 0.f;
#pragma unroll
            for (int sx = 0; sx < 2; ++sx) { const f32x16 ar = __builtin_amdgcn_mfma_f32_32x32x16_bf16(a, Bre[sx], z, 0, 0, 0), ai = __builtin_amdgcn_mfma_f32_32x32x16_bf16(a, Bim[sx], z, 0, 0, 0);
#pragma unroll
                for (int ag = 0; ag < 4; ++ag) {
#pragma unroll
                    for (int bq = 0; bq < 4; ++bq) { const float t = lr[sx] * sr[sx] - li[sx] * si[sx] + ar[ag * 4 + bq]; si[sx] = lr[sx] * si[sx] + li[sx] * sr[sx] + ai[ag * 4 + bq]; sr[sx] = t; }
                    if (!(sub == 1 && ag == 3)) { const float t = l4r[sx] * sr[sx] - l4i[sx] * si[sx]; si[sx] = l4r[sx] * si[sx] + l4i[sx] * sr[sx]; sr[sx] = t; } } }
        }
#pragma unroll
        for (int sx = 0; sx < 2; ++sx) { if (hh == 0) { const float t = l4r[sx] * sr[sx] - l4i[sx] * si[sx]; si[sx] = l4r[sx] * si[sx] + l4i[sx] * sr[sx]; sr[sx] = t; }
            const float tr = sr[sx] + __shfl_xor(sr[sx], 32), ti = si[sx] + __shfl_xor(si[sx], 32);
            if (hh == 0) *(f32x2*)(Eb + ((((size_t)b * 64 + ch) * 64) + g) * 128 + (l31 + 32 * sx) * 2) = (f32x2){tr, ti}; }
        __syncthreads();
    }
}

__device__ __forceinline__ void phase_s5_out(const Params& p, LAS unsigned char* lds, int nitems) {
    const int tid = threadIdx.x, wid = tid >> 6, lane = tid & 63, l31 = lane & 31, hh = lane >> 5, hcol = lane & 15, q4 = lane >> 4;
    const bf16_t* proj2 = (const bf16_t*)(p.ws + OFF_PROJ2); const float* Eb = (const float*)(p.ws + OFF_E); bf16_t* yb = (bf16_t*)(p.ws + OFF_YB);
    constexpr int UROW = 272, SROW = 272;
    LAS unsigned char* sb = lds + 64 * UROW + wid * 32 * SROW;
    int oct_cur = -1;
    float lr[2] = {0.f, 0.f}, li[2] = {0.f, 0.f}, p64r[2] = {0.f, 0.f}, p64i[2] = {0.f, 0.f}; f32x4 dsk4 = (f32x4){0.f, 0.f, 0.f, 0.f}; bf16x8 Bre[2], Bim[2], Bc[4];
#pragma unroll
    for (int i = 0; i < 2; ++i) { Bre[i] = (bf16x8){0, 0, 0, 0, 0, 0, 0, 0}; Bim[i] = Bre[i]; }
#pragma unroll
    for (int i = 0; i < 4; ++i) Bc[i] = (bf16x8){0, 0, 0, 0, 0, 0, 0, 0};
    for (int item = blockIdx.x; item < nitems; item += gridDim.x) {
        const int cs = item >> 3, oct = item & 7, g = oct * 8 + wid; const bool smp = cs >= 128;
        const int b = smp ? cs - 128 : cs >> 6, ch = smp ? 0 : cs & 63, L = smp ? 32 : 64, row0 = smp ? TP + b * 32 : b * 4096 + ch * 64;
#pragma unroll
        for (int k = 0; k < 4; ++k) { const int i = tid + k * 512, t = i >> 5, q = i & 31; if (i < L * 32) { const u32x2 w = *(const u32x2*)(proj2 + (size_t)(row0 + t) * DM + 1024 + oct * 128 + q * 4);
            *(LAS u32x2*)(lds + t * UROW + q * 8) = w; } }
        if (oct != oct_cur) { oct_cur = oct;
            const float dt = __expf(p.in[24][g]);
#pragma unroll
            for (int sx = 0; sx < 2; ++sx) { const int st = l31 + 32 * sx;
                const float are = p.in[22][g * 64 + st], aim = p.in[23][g * 64 + st];
                const float er = __expf(are * dt); float rev = aim * dt * 0.15915494309189535f; rev -= floorf(rev);
                lr[sx] = er * __builtin_amdgcn_cosf(rev); li[sx] = er * __builtin_amdgcn_sinf(rev);
                const float den = 1.0f / (are * are + aim * aim); const float nr = lr[sx] - 1.0f, ni = li[sx];
                const float cr = (nr * are + ni * aim) * den, ci = (ni * are - nr * aim) * den;
                const float* br = p.in[25] + ((size_t)g * 64 + st) * 16 + hh * 8; const float* bi = p.in[26] + ((size_t)g * 64 + st) * 16 + hh * 8;
                const f32x4 x0 = *(const f32x4*)br, x1 = *(const f32x4*)(br + 4), y0 = *(const f32x4*)bi, y1 = *(const f32x4*)(bi + 4);
                u32x4 wr, wi;
                wr.x = cvt_pk_bf16(cr * x0[0] - ci * y0[0], cr * x0[1] - ci * y0[1]); wr.y = cvt_pk_bf16(cr * x0[2] - ci * y0[2], cr * x0[3] - ci * y0[3]);
                wr.z = cvt_pk_bf16(cr * x1[0] - ci * y1[0], cr * x1[1] - ci * y1[1]); wr.w = cvt_pk_bf16(cr * x1[2] - ci * y1[2], cr * x1[3] - ci * y1[3]);
                wi.x = cvt_pk_bf16(cr * y0[0] + ci * x0[0], cr * y0[1] + ci * x0[1]); wi.y = cvt_pk_bf16(cr * y0[2] + ci * x0[2], cr * y0[3] + ci * x0[3]);
                wi.z = cvt_pk_bf16(cr * y1[0] + ci * x1[0], cr * y1[1] + ci * x1[1]); wi.w = cvt_pk_bf16(cr * y1[2] + ci * x1[2], cr * y1[3] + ci * x1[3]);
                Bre[sx] = __builtin_bit_cast(bf16x8, wr); Bim[sx] = __builtin_bit_cast(bf16x8, wi);
                float pr = lr[sx], pi = li[sx];
#pragma unroll
                for (int q = 0; q < 6; ++q) { const float t = pr * pr - pi * pi; pi = 2.f * pr * pi; pr = t; }
                p64r[sx] = pr; p64i[sx] = pi; }
#pragma unroll
            for (int ks = 0; ks < 4; ++ks) { const float* src = (ks < 2 ? p.in[27] : p.in[28]) + ((size_t)g * 16 + hcol) * 64 + (ks & 1) * 32 + q4 * 8; const float sg = ks < 2 ? 1.f : -1.f;
                const f32x4 x = *(const f32x4*)src, y = *(const f32x4*)(src + 4); u32x4 w; w.x = cvt_pk_bf16(sg * x[0], sg * x[1]); w.y = cvt_pk_bf16(sg * x[2], sg * x[3]); w.z = cvt_pk_bf16(sg * y[0], sg * y[1]); w.w = cvt_pk_bf16(sg * y[2], sg * y[3]);
                Bc[ks] = __builtin_bit_cast(bf16x8, w); }
            dsk4 = *(const f32x4*)(p.in[29] + g * 16 + q4 * 4); }
        float sr[2] = {0.f, 0.f}, si[2] = {0.f, 0.f};
        if (smp) {
#pragma unroll
            for (int sx = 0; sx < 2; ++sx) { const int st = l31 + 32 * sx; sr[sx] = p.in[4][((size_t)b * 64 + g) * 64 + st]; si[sx] = p.in[5][((size_t)b * 64 + g) * 64 + st]; }
        } else { const float* e0 = Eb + (((size_t)b * 64) * 64 + g) * 128 + l31 * 2;
            for (int j0 = 0; j0 < ch; j0 += 16) { f32x2 ev[2][16];
#pragma unroll
                for (int jj = 0; jj < 16; ++jj) { const int j = (j0 + jj) < ch ? (j0 + jj) : (ch - 1); ev[0][jj] = *(const f32x2*)(e0 + (size_t)j * 64 * 128); ev[1][jj] = *(const f32x2*)(e0 + (size_t)j * 64 * 128 + 64); }
#pragma unroll
                for (int jj = 0; jj < 16; ++jj) { const bool on = (j0 + jj) < ch;
#pragma unroll
                    for (int sx = 0; sx < 2; ++sx) { const float t = p64r[sx] * sr[sx] - p64i[sx] * si[sx] + ev[sx][jj].x, u2 = p64r[sx] * si[sx] + p64i[sx] * sr[sx] + ev[sx][jj].y; sr[sx] = on ? t : sr[sx]; si[sx] = on ? u2 : si[sx]; } } } }
        __syncthreads();
        for (int sub = 0; sub < L; sub += 32) {
            const bf16x8 a = *(const LAS bf16x8*)(lds + (sub + l31) * UROW + (wid * 16 + hh * 8) * 2);
            f32x16 z;
#pragma unroll
            for (int r = 0; r < 16; ++r) z[r] = 0.f;
#pragma unroll
            for (int sx = 0; sx < 2; ++sx) {
                const f32x16 ar = __builtin_amdgcn_mfma_f32_32x32x16_bf16(a, Bre[sx], z, 0, 0, 0), ai = __builtin_amdgcn_mfma_f32_32x32x16_bf16(a, Bim[sx], z, 0, 0, 0);
                const float lrs = lr[sx], lis = li[sx]; float s_r = sr[sx], s_i = si[sx];
#pragma unroll
                for (int ag = 0; ag < 4; ++ag) {
                    float c1r[4], c1i[4], c2r[4], c2i[4]; float tr = s_r, ti = s_i;
#pragma unroll
                    for (int bq = 0; bq < 4; ++bq) { const float t = lrs * tr - lis * ti + ar[ag * 4 + bq]; ti = lrs * ti + lis * tr + ai[ag * 4 + bq]; tr = t; c1r[bq] = tr; c1i[bq] = ti; }
                    float xr = __shfl_xor(tr, 32), xi = __shfl_xor(ti, 32);
#pragma unroll
                    for (int bq = 0; bq < 4; ++bq) { const float t = lrs * xr - lis * xi + ar[ag * 4 + bq]; xi = lrs * xi + lis * xr + ai[ag * 4 + bq]; xr = t; c2r[bq] = xr; c2i[bq] = xi; }
                    s_r = __shfl_xor(xr, 32); s_i = __shfl_xor(xi, 32);
#pragma unroll
                    for (int bq = 0; bq < 4; ++bq) { const int tt = ag * 8 + hh * 4 + bq; const float vr = hh ? c2r[bq] : c1r[bq], vi = hh ? c2i[bq] : c1i[bq];
                        *(LAS bf16_t*)(sb + tt * SROW + (l31 + 32 * sx) * 2) = (bf16_t)(cvt_pk_bf16(vr, 0.f) & 0xffffu); *(LAS bf16_t*)(sb + tt * SROW + 128 + (l31 + 32 * sx) * 2) = (bf16_t)(cvt_pk_bf16(vi, 0.f) & 0xffffu); }
                }
                sr[sx] = s_r; si[sx] = s_i; __builtin_amdgcn_sched_barrier(0); }
            __syncthreads();
#pragma unroll
            for (int mt = 0; mt < 2; ++mt) { f32x4 acc = (f32x4){0.f, 0.f, 0.f, 0.f};
#pragma unroll
                for (int ks = 0; ks < 4; ++ks) { const bf16x8 af = *(const LAS bf16x8*)(sb + (mt * 16 + hcol) * SROW + ks * 64 + q4 * 16); acc = __builtin_amdgcn_mfma_f32_16x16x32_bf16(Bc[ks], af, acc, 0, 0, 0); }
                const int t = sub + mt * 16 + hcol; const u32x2 uw = *(const LAS u32x2*)(lds + t * UROW + (wid * 16 + q4 * 4) * 2);
                const float y0 = acc[0] + dsk4[0] * bf_lo(uw.x), y1 = acc[1] + dsk4[1] * bf_hi(uw.x), y2 = acc[2] + dsk4[2] * bf_lo(uw.y), y3 = acc[3] + dsk4[3] * bf_hi(uw.y);
                u32x2 w; w.x = cvt_pk_bf16(gelu_t(y0), gelu_t(y1)); w.y = cvt_pk_bf16(gelu_t(y2), gelu_t(y3));
                *(u32x2*)(yb + (size_t)(row0 + t) * YLD + g * 16 + q4 * 4) = w; }
            __syncthreads();
        }
        if (hh == 0 && (smp || ch == 63)) { float* ore = p.out + (smp ? O_S5RE_S : O_S5RE_P) + ((size_t)b * 64 + g) * 64; float* oim = p.out + (smp ? O_S5IM_S : O_S5IM_P) + ((size_t)b * 64 + g) * 64;
#pragma unroll
            for (int sx = 0; sx < 2; ++sx) { ore[l31 + 32 * sx] = sr[sx]; oim[l31 + 32 * sx] = si[sx]; } }
        __syncthreads();
    }
}

#define XB_TMO      128
#define XB_XCNT(j)  (256  + 64 * (j))
#define XB_XSUB(j)  (1280 + 64 * (j))
#define XB_XGEN(j)  (2304 + 64 * (j))
#define XB_TOP      3328
#define XB_TOPGEN   3392
#define XCD_BAR_WORDS 3456
#define XB_SPIN_CAP (1u << 20)
__device__ __forceinline__ unsigned xb_ld(unsigned* p)              { return __hip_atomic_load(p, __ATOMIC_RELAXED, __HIP_MEMORY_SCOPE_AGENT); }
__device__ __forceinline__ unsigned xb_add(unsigned* p, unsigned v) { return __hip_atomic_fetch_add(p, v, __ATOMIC_RELAXED, __HIP_MEMORY_SCOPE_AGENT); }
__device__ __forceinline__ unsigned xb_xcc_id() { return (unsigned)__builtin_amdgcn_s_getreg((3 << 11) | 20) & 0xFu; }
#define XB_SPIN(cond, bar) do { unsigned _sp = 0; while (cond) { __builtin_amdgcn_s_sleep(1); \
    if ((++_sp & 255u) == 0u) { if (xb_ld(&(bar)[XB_TMO])) break; if (_sp > XB_SPIN_CAP) { atomicAdd(&(bar)[XB_TMO], 1u); break; } } } } while (0)
struct XcdBarrier { unsigned* bar; unsigned x; volatile LAS unsigned* st; };
__device__ __forceinline__ XcdBarrier xcd_barrier_post(unsigned* bar, volatile LAS unsigned* st) {
    XcdBarrier b; b.bar = bar; b.x = xb_xcc_id(); b.st = st;
    if (threadIdx.x == 0) (void)xb_add(&bar[XB_XCNT(b.x)], 1u);
    return b;
}
__device__ __forceinline__ void xcd_barrier_complete(unsigned* bar, unsigned x, unsigned& nloc, unsigned& nx) {
    const unsigned G = gridDim.x * gridDim.y * gridDim.z;
    unsigned sum, cnt, mine, sp = 0u;
    for (;;) {
        sum = 0u; cnt = 0u; mine = 0u;
#pragma unroll
        for (unsigned j = 0; j < 16; ++j) { const unsigned c = xb_ld(&bar[XB_XCNT(j)]); sum += c; cnt += (c > 0u) ? 1u : 0u; mine = (j == x) ? c : mine; }
        if (sum == G) break;
        __builtin_amdgcn_s_sleep(1);
        if ((++sp & 255u) == 0u) { if (xb_ld(&bar[XB_TMO])) break; if (sp > XB_SPIN_CAP) { atomicAdd(&bar[XB_TMO], 1u); break; } }
    }
    nloc = mine > 0u ? mine : 1u; nx = cnt > 0u ? cnt : 1u;
}
__device__ __forceinline__ void xcd_barrier(const XcdBarrier& b) {
    asm volatile("s_waitcnt vmcnt(0)" ::: "memory");
    __syncthreads();
    if (threadIdx.x == 0) {
        unsigned* bar = b.bar;
        __builtin_amdgcn_s_waitcnt(0);
        unsigned nloc = b.st[0], nx = b.st[1];
        if (nloc == 0u) { xcd_barrier_complete(bar, b.x, nloc, nx); b.st[0] = nloc; b.st[1] = nx; }
        const unsigned old = xb_add(&bar[XB_XSUB(b.x)], 1u);
        const unsigned gen = old / nloc;
        if (old + 1u == (gen + 1u) * nloc) {
            __builtin_amdgcn_fence(__ATOMIC_RELEASE, "agent");
            asm volatile("s_waitcnt vmcnt(0)" ::: "memory");
            const unsigned og = xb_add(&bar[XB_TOP], 1u);
            const unsigned tg = og / nx;
            if (og + 1u == (tg + 1u) * nx) xb_add(&bar[XB_TOPGEN], 1u);
            else XB_SPIN(xb_ld(&bar[XB_TOPGEN]) == tg, bar);
            __builtin_amdgcn_fence(__ATOMIC_ACQUIRE, "agent");
            xb_add(&bar[XB_XGEN(b.x)], 1u);
            asm volatile("s_waitcnt vmcnt(0)" ::: "memory");
        } else {
            XB_SPIN(xb_ld(&bar[XB_XGEN(b.x)]) == gen, bar);
            __builtin_amdgcn_fence(__ATOMIC_ACQUIRE, "agent");
            asm volatile("s_waitcnt vmcnt(0)" ::: "memory");
        }
    }
    __syncthreads();
}

__device__ __forceinline__ void run_phase(const Params& p, LAS unsigned char* lds, const int ph, const int vb) {
#ifdef ONLY_PH
    if (ph != ONLY_PH) return;
#endif
    unsigned char* ws = p.ws; const int nb = gridDim.x;
    switch (ph) {
    case 0: phase_prep(p, lds); break;
    case 1: { pg8::EpiBf16<1> E; E.O = (bf16_t*)(ws + OFF_PROJ); E.ldc = NE; E.gelu_tiles = 8; E.scale = nullptr; E.slab = 0;
              run_gemm(lds, (const bf16_t*)(ws + OFF_H), (const bf16_t*)(ws + OFF_WIN_E), NE, DM, HLD, HLD, 0, E, vb);
              phase_glr(p, vb);
              if (nb == 256 && vb >= 208) prep_run<1>(p, lds, vb - 208, 48, NL1); } break;
    case 2: { for (int it = blockIdx.x; it < 640; it += nb) { if (it < 512) glau_item<64>(p, lds, it); else glau_item<32>(p, lds, it); }
              for (int it = nb - 1 - (int)blockIdx.x; it < 384; it += nb) { if (it < 256) amix_item<128>(p, lds, it); else amix_item<32>(p, lds, it); } } break;
    case 3: phase_gla_scan(p); break;
    case 4: for (int it = blockIdx.x; it < 640; it += nb) { if (it < 512) glao_item<64>(p, lds, it); else glao_item<32>(p, lds, it); } break;
    case 5: case 15: { pg8::EpiBf16<1> E; E.O = (bf16_t*)(ws + OFF_M); E.ldc = DM; E.gelu_tiles = 0; E.scale = nullptr; E.slab = 0;
              const bf16_t* W = (const bf16_t*)(ws + (ph == 5 ? OFF_WOUT_E : OFF_WOUT_O));
              run_gemm(lds, (const bf16_t*)(ws + OFF_MIX), W, DM, DM, HLD, HLD, 0, E, vb, TP);
              run_gemm_split(lds, (const bf16_t*)(ws + OFF_MIX), W, DM, HLD, 8, (bf16_t*)(ws + OFF_SLAB_A), vb); } break;
    case 6: phase_norm(p, true, nullptr, p.in[8], p.in[9], (const bf16_t*)(ws + OFF_SLAB_A), 8); break;
    case 7: case 17: { const int layer = ph == 7 ? 0 : 1; pg8::EpiGateVal E; E.ACT = (bf16_t*)(ws + OFF_VAL); E.GF = (bf16_t*)(ws + OFF_GF); E.VF = (bf16_t*)(ws + OFF_VF); E.GL = (bf16_t*)(ws + OFF_GL);
              E.ffn_p = p.out + O_FFN_P + (size_t)layer * 2 * 2 * DFF; E.ffn_s = p.out + O_FFN_S + (size_t)layer * 32 * 2 * DFF;
              E.cw = p.in[33] + (size_t)layer * 3 * DFF; E.cb = p.in[34] + (size_t)layer * DFF;
              run_gemm(lds, (const bf16_t*)(ws + OFF_H), (const bf16_t*)(ws + (layer ? OFF_WUP1 : OFF_WUP0)), 2 * DFF, DM, HLD, HLD, 0, E, vb);
              if (nb == 256 && vb >= 48) { if (layer == 0) prep_run<2>(p, lds, vb - 48, 208, NL2); else prep_run<5>(p, lds, vb - 48, 208, NL5); } } break;
    case 8: phase_convfix(p, 0); break;
    case 18: phase_convfix(p, 1); break;
    case 9: case 19: { pg8::EpiBf16<1> E; E.O = (bf16_t*)(ws + OFF_M); E.ldc = DM; E.gelu_tiles = 0; E.scale = nullptr; E.slab = 0;
              const bf16_t* W = (const bf16_t*)(ws + (ph == 9 ? OFF_WDN0 : OFF_WDN1));
              run_gemm(lds, (const bf16_t*)(ws + OFF_VAL), W, DM, DFF, ALD, ALD, 0, E, vb, TP);
              run_gemm_split(lds, (const bf16_t*)(ws + OFF_VAL), W, DFF, ALD, 4, (bf16_t*)(ws + OFF_SLAB_B), vb);
              if (ph == 9 && nb == 256 && vb >= 128) prep_run<3>(p, lds, vb - 128, 128, NL3); } break;
    case 10: phase_norm(p, false, nullptr, p.in[10], p.in[7] + DM, (const bf16_t*)(ws + OFF_SLAB_B), 4); break;
    case 11: { pg8::EpiBf16<1> E; E.O = (bf16_t*)(ws + OFF_PROJ2); E.ldc = DM; E.gelu_tiles = 0; E.scale = nullptr; E.slab = 0;
              run_gemm(lds, (const bf16_t*)(ws + OFF_H), (const bf16_t*)(ws + OFF_WIN_O), DM, DM, HLD, HLD, 0, E, vb);
              if (nb == 256 && vb >= 32) prep_run<4>(p, lds, vb - 32, 224, NL4); } break;
    case 12: { phase_pool(p); phase_s5_ends(p, lds, 1024); } break;
    case 13: phase_s5_out(p, lds, 1280); break;
    case 14: { pg8::EpiGlu E; E.O = (bf16_t*)(ws + OFF_MIX) + 1024; E.ldc = HLD;
              run_gemm(lds, (const bf16_t*)(ws + OFF_YB), (const bf16_t*)(ws + OFF_WGLU), 2048, 1024, YLD, YLD, 0, E, vb); }
             { pg8::EpiBf16<1> E2; E2.O = (bf16_t*)(ws + OFF_MIX); E2.ldc = HLD; E2.gelu_tiles = 0; E2.scale = nullptr; E2.slab = 0;
              run_gemm(lds, (const bf16_t*)(ws + OFF_DELTA), (const bf16_t*)(ws + OFF_CMAP), 1024, 256, YLD, CLD, 256, E2, vb, T, nb >= 64 ? 32 : 0); } break;
    case 16: phase_norm(p, false, nullptr, p.in[8] + DM, p.in[9] + DM, (const bf16_t*)(ws + OFF_SLAB_A), 8); break;
    case 20: phase_norm(p, false, p.out + O_Y, p.in[10] + DM, nullptr, (const bf16_t*)(ws + OFF_SLAB_B), 4); break;
    default: break;
    }
}

__global__ void __launch_bounds__(512, 2) fwd_megakernel(Params p) {
    extern __shared__ __attribute__((aligned(16))) unsigned char shm[];
    LAS unsigned char* lds = (LAS unsigned char*)shm;
    cg::grid_group grid = cg::this_grid();
    volatile LAS unsigned* xst = (volatile LAS unsigned*)(lds + 131072);
    if (threadIdx.x == 0) { xst[0] = 0u; xst[1] = 0u; }
    __syncthreads();
    const XcdBarrier xb = xcd_barrier_post((unsigned*)(p.ws + OFF_BAR), xst);
    const int vb = (int)blockIdx.x;
    if (p.ph_hi > NPHASE) grid.sync();
#define GSYNC() xcd_barrier(xb)
#ifndef DUP_MASK
#define DUP_MASK 0u
#endif
#ifndef EXTRA_SYNC
#define EXTRA_SYNC 0
#endif
#define PH(n) if (p.ph_lo <= (n) && (n) < p.ph_hi) { run_phase(p, lds, SEQ[n], vb); if ((DUP_MASK >> (n)) & 1u) { GSYNC(); run_phase(p, lds, SEQ[n], vb); } \
        if ((n) + 1 < p.ph_hi) { GSYNC(); for (int _e = 0; _e < EXTRA_SYNC; ++_e) GSYNC(); } }
    PH(0) PH(1) PH(2) PH(3) PH(4) PH(5) PH(6) PH(7) PH(8) PH(9) PH(10) PH(11) PH(12) PH(13) PH(14) PH(15) PH(16) PH(17) PH(18) PH(19) PH(20)
#undef PH
}

extern "C" void kernel_launch(void* const* d_in, const int* in_sizes, int n_in, void* d_out, int out_size, void* d_ws, size_t ws_size, hipStream_t stream) {
    static int grid_blocks = 0;
    if (grid_blocks == 0) {
        if (n_in != 36 || (size_t)out_size != O_END || ws_size < WS_END) { fprintf(stderr, "kernel_launch: unexpected sizes n_in %d out %d ws %zu (need %zu)\n", n_in, out_size, ws_size, (size_t)WS_END); grid_blocks = -1; return; }
        int dev = 0, cus = 0, per_cu = 0;
        hipGetDevice(&dev); hipDeviceGetAttribute(&cus, hipDeviceAttributeMultiprocessorCount, dev);
        if (hipFuncSetAttribute((const void*)fwd_megakernel, hipFuncAttributeMaxDynamicSharedMemorySize, LDS_BYTES) != hipSuccess) { fprintf(stderr, "kernel_launch: hipFuncSetAttribute failed\n"); grid_blocks = -1; return; }
        hipOccupancyMaxActiveBlocksPerMultiprocessor(&per_cu, (const void*)fwd_megakernel, 512, LDS_BYTES);
        if (per_cu < 1) { fprintf(stderr, "kernel_launch: occupancy query says %d blocks per CU\n", per_cu); per_cu = 1; }
        (void)hipGetLastError();
        grid_blocks = cus;
    }
    if (grid_blocks < 0) return;
    Params p{};
    for (int i = 0; i < 36; ++i) p.in[i] = (const float*)d_in[i];
    p.out = (float*)d_out; p.ws = (unsigned char*)d_ws;
#if MULTI_LAUNCH
    for (int ph = 0; ph < NPHASE; ++ph) { p.ph_lo = ph; p.ph_hi = ph + 1; hipLaunchKernelGGL(fwd_megakernel, dim3(grid_blocks), dim3(512), LDS_BYTES, stream, p); }
#else
    p.ph_lo = 0; p.ph_hi = NPHASE;
    if (hipMemsetAsync((unsigned char*)d_ws + OFF_BAR, 0, 16384, stream) != hipSuccess) { fprintf(stderr, "kernel_launch: barrier memset failed\n"); return; }
    void* args[] = {&p};
    hipError_t e = hipLaunchCooperativeKernel((const void*)fwd_megakernel, dim3(grid_blocks), dim3(512), args, LDS_BYTES, stream);
    if (e != hipSuccess) fprintf(stderr, "cooperative launch failed: %s (grid %d)\n", hipGetErrorString(e), grid_blocks);
#endif
}
```

```cpp
#include <hip/hip_runtime.h>
#include <hip/hip_cooperative_groups.h>
#include <cstdio>
namespace cg = cooperative_groups;

#define LAS __attribute__((address_space(3)))
typedef unsigned short bf16_t;
typedef short bf16x8 __attribute__((ext_vector_type(8)));
typedef float f32x4 __attribute__((ext_vector_type(4)));
typedef float f32x2 __attribute__((ext_vector_type(2)));
typedef float f32x16 __attribute__((ext_vector_type(16)));
typedef unsigned u32x4 __attribute__((ext_vector_type(4)));
typedef unsigned u32x2 __attribute__((ext_vector_type(2)));

#ifndef MULTI_LAUNCH
#define MULTI_LAUNCH 0
#endif

constexpr int T = 9216, TP = 8192, DM = 2048, DFF = 5632, NE = 5120, NE_SRC = 5136;
constexpr float EPS = 1e-6f;
constexpr int PADK = 64, HLD = DM + PADK, ALD = DFF + PADK, YLD = 1024 + PADK, CLD = 256 + PADK;
constexpr int NPHASE = 21;
__device__ constexpr int SEQ[NPHASE] = {0, 1, 2, 3, 4, 5, 6, 7, 8, 9, 10, 11, 12, 13, 14, 15, 16, 17, 18, 19, 20};
constexpr int LDS_BYTES = 131072 + 16;

constexpr size_t al256(size_t x) { return (x + 255) & ~(size_t)255; }
constexpr size_t SZ_WIN_E = (size_t)NE * HLD * 2, SZ_WG = 16 * DM * 2, SZ_W22 = (size_t)DM * HLD * 2, SZ_WUP = (size_t)2 * DFF * HLD * 2,
                 SZ_WDN = (size_t)DM * ALD * 2, SZ_CMAP = 1024 * CLD * 2, SZ_WGLU = (size_t)2048 * YLD * 2, SZ_WSM = 8 * 128 * 128 * 2;
constexpr size_t OFF_WIN_E = 0;
constexpr size_t OFF_WG = OFF_WIN_E + SZ_WIN_E;
constexpr size_t OFF_WOUT_E = OFF_WG + SZ_WG;
constexpr size_t OFF_WUP0 = OFF_WOUT_E + SZ_W22;
constexpr size_t OFF_WUP1 = OFF_WUP0 + SZ_WUP;
constexpr size_t OFF_WDN0 = OFF_WUP1 + SZ_WUP;
constexpr size_t OFF_WDN1 = OFF_WDN0 + SZ_WDN;
constexpr size_t OFF_WIN_O = OFF_WDN1 + SZ_WDN;
constexpr size_t OFF_CMAP = OFF_WIN_O + SZ_W22;
constexpr size_t OFF_WGLU = OFF_CMAP + SZ_CMAP;
constexpr size_t OFF_WOUT_O = OFF_WGLU + SZ_WGLU;
constexpr size_t OFF_WSM = OFF_WOUT_O + SZ_W22;
constexpr size_t OFF_H = OFF_WSM + SZ_WSM;
constexpr size_t OFF_MIX = OFF_H + (size_t)T * HLD * 2;
constexpr size_t OFF_M = OFF_MIX + (size_t)T * HLD * 2;
constexpr size_t OFF_XA = OFF_M + (size_t)T * DM * 4;
constexpr size_t OFF_R1 = OFF_XA + (size_t)T * DM * 4;
constexpr size_t SZ_R1 = (size_t)T * DFF * 2 + (size_t)T * ALD * 2;
constexpr size_t OFF_PROJ = OFF_R1;
constexpr size_t OFF_UT = OFF_PROJ + (size_t)T * NE * 2;
constexpr size_t OFF_ST = OFF_UT + (size_t)512 * 256 * 128 * 4;
constexpr size_t OFF_DECAY = OFF_ST + (size_t)640 * 256 * 128 * 2;
constexpr size_t OFF_GLR = OFF_DECAY + (size_t)640 * 128 * 4;
static_assert(OFF_GLR + (size_t)T * 16 * 4 <= OFF_R1 + SZ_R1, "arena");
constexpr size_t OFF_GATE = OFF_R1;
constexpr size_t OFF_VAL = OFF_R1 + (size_t)T * DFF * 2;
constexpr size_t OFF_GF = OFF_R1;
constexpr size_t OFF_VF = OFF_GF + (size_t)576 * DFF * 2;
constexpr size_t OFF_GL = OFF_VF + (size_t)576 * DFF * 2;
constexpr size_t OFF_PROJ2 = OFF_R1;
constexpr size_t OFF_DELTA = OFF_PROJ2 + (size_t)T * DM * 4;
constexpr size_t OFF_YB = OFF_DELTA + (size_t)T * YLD * 2;
constexpr size_t OFF_E = OFF_YB + (size_t)T * YLD * 2;
constexpr size_t OFF_SLAB_A = OFF_R1;
constexpr size_t OFF_SLAB_B = OFF_MIX;
constexpr size_t OFF_BAR = OFF_R1 + SZ_R1;
constexpr size_t WS_END = OFF_BAR + 16384;

constexpr size_t O_Y = 0;
constexpr size_t O_GLA_P = O_Y + (size_t)T * DM;
constexpr size_t O_GLA_S = O_GLA_P + 2 * 4 * 128 * 256;
constexpr size_t O_AV = O_GLA_S + (size_t)32 * 4 * 128 * 256;
constexpr size_t O_POOL_P = O_AV + (size_t)32 * 32 * 1024;
constexpr size_t O_POOL_S = O_POOL_P + 2 * 15 * 1024;
constexpr size_t O_S5RE_P = O_POOL_S + 32 * 15 * 1024;
constexpr size_t O_S5IM_P = O_S5RE_P + 2 * 64 * 64;
constexpr size_t O_S5RE_S = O_S5IM_P + 2 * 64 * 64;
constexpr size_t O_S5IM_S = O_S5RE_S + 32 * 64 * 64;
constexpr size_t O_FFN_P = O_S5IM_S + 32 * 64 * 64;
constexpr size_t O_FFN_S = O_FFN_P + 2 * 2 * 2 * DFF;
constexpr size_t O_END = O_FFN_S + (size_t)2 * 32 * 2 * DFF;

struct Params {
    const float* in[36];
    float* out;
    unsigned char* ws;
    int ph_lo, ph_hi;
};

__device__ __forceinline__ unsigned cvt_pk_bf16(float lo, float hi) { unsigned r; asm volatile("v_cvt_pk_bf16_f32 %0, %1, %2" : "=v"(r) : "v"(lo), "v"(hi)); return r; }
__device__ __forceinline__ float bf_lo(unsigned w) { return __uint_as_float(w << 16); }
__device__ __forceinline__ float bf_hi(unsigned w) { return __uint_as_float(w & 0xffff0000u); }
__device__ __forceinline__ float bf1(bf16_t b) { return __uint_as_float(((unsigned)b) << 16); }
__device__ __forceinline__ float fast_rcp(float x) { return __builtin_amdgcn_rcpf(x); }
__device__ __forceinline__ float sigmoidf(float x) { return fast_rcp(1.0f + __builtin_amdgcn_exp2f(-1.4426950409f * x)); }
__device__ __forceinline__ float gelu_t(float x) { const float u = x * (1.5957691216f + 0.0713548163f * x * x); return x * fast_rcp(1.0f + __builtin_amdgcn_exp2f(-1.4426950409f * u)); }
__device__ __forceinline__ float wave_sum(float v) {
#pragma unroll
    for (int o = 32; o >= 1; o >>= 1) v += __shfl_xor(v, o);
    return v;
}
__device__ __forceinline__ const float* xrow_in(const Params& p, int row) { return row < TP ? p.in[0] + (size_t)row * DM : p.in[1] + (size_t)(row - TP) * DM; }

namespace pg8 {
constexpr int BM = 256, BK = 64, HALF = 128, HTB = HALF * BK * 2, STAGE_BYTES = 8 * HTB, NXCD = 8, WGM = 8;
__device__ __forceinline__ int lds_byte(int r, int c) { const int st = (r >> 4) * 2 + (c >> 5), rr = r & 15, cc = c & 31, ob = rr * 64 + cc * 2; return st * 1024 + (ob ^ (((ob >> 9) & 1) << 5)); }
__device__ __forceinline__ void stage_rc(int b, int& R, int& C) { const int st = b / 1024, sb = b % 1024, swz = sb ^ (((sb >> 9) & 1) << 5); R = (st >> 1) * 16 + swz / 64; C = (st & 1) * 32 + (swz % 64) / 2; }
__device__ __forceinline__ int perm32(int rho) { const int n = rho >> 4, i = rho & 15; return 8 * (i >> 2) + 4 * n + (i & 3); }
struct Unit { int pm, pn, ks; };
struct Gemm { const bf16_t* A; const bf16_t* Bt; int M, N, K, lda, ldb, a_pn_off; };
struct StaticOrder {
    int nM, nN, nwg, G, c;
    __device__ void init(int M, int N, int G_, int c_) { nM = M / BM; nN = N / BM; nwg = nM * nN; G = G_; c = c_; }
    __device__ bool next(int i, Unit& u) const {
        const long L = (long)i * G + c; if (L >= nwg) return false;
        int wgid = (int)L; { const int q = nwg / NXCD, r = nwg % NXCD, xcd = wgid % NXCD, off = wgid / NXCD; wgid = (xcd < r ? xcd * (q + 1) : r * (q + 1) + (xcd - r) * q) + off; }
        const int nig = WGM * nN, gid = wgid / nig, fm = gid * WGM, gsz = (nM - fm) < WGM ? (nM - fm) : WGM;
        u.pm = fm + ((wgid % nig) % gsz); u.pn = (wgid % nig) / gsz; u.ks = 0; return true;
    }
};
struct SplitOrder {
    int S, nsub, G, c;
    __device__ void init(int nN, int S_, int G_, int c_) { S = S_; nsub = 4 * nN * S_; G = G_; c = c_; }
    __device__ bool next(int i, Unit& u) const {
        const long L = (long)i * G + c; if (L >= nsub) return false;
        const int l = (int)L, tile = l / S; u.ks = l - tile * S; u.pm = tile & 3; u.pn = tile >> 2; return true;
    }
};

struct EpiF32 {
    static constexpr bool PERM = false;
    float* C; int ldc; size_t slab;
    __device__ __forceinline__ void operator()(const f32x4 (&acc)[2][2][4][2], const Unit& u, int wr, int wc, int fr, int fq) const {
        const int row0 = u.pm * BM + wr * 64 + fr, col0 = u.pn * BM + wc * 32 + 4 * fq;
#pragma unroll
        for (int ai = 0; ai < 2; ++ai)
#pragma unroll
            for (int m = 0; m < 4; ++m) { float* rowp = C + (size_t)u.ks * slab + (size_t)(row0 + ai * HALF + m * 16) * ldc + col0;
#pragma unroll
                for (int bj = 0; bj < 2; ++bj)
#pragma unroll
                    for (int n = 0; n < 2; ++n) *(f32x4*)(rowp + bj * HALF + n * 16) = acc[ai][bj][m][n]; }
    }
};
template <int MODE> struct EpiBf16 {
    static constexpr bool PERM = true;
    bf16_t* O; int ldc; int gelu_tiles; const float* scale; size_t slab;
    __device__ __forceinline__ void operator()(const f32x4 (&acc)[2][2][4][2], const Unit& u, int wr, int wc, int fr, int fq) const {
        const int row0 = u.pm * BM + wr * 64 + fr, col0 = u.pn * BM + wc * 32 + 8 * fq;
        bf16_t* Ob = O + (size_t)u.ks * slab;
        const bool dog = (MODE == 1) && (u.pn < gelu_tiles);
#pragma unroll
        for (int ai = 0; ai < 2; ++ai)
#pragma unroll
            for (int m = 0; m < 4; ++m) { bf16_t* rowp = Ob + (size_t)(row0 + ai * HALF + m * 16) * ldc + col0;
#pragma unroll
                for (int bj = 0; bj < 2; ++bj) { f32x4 v0 = acc[ai][bj][m][0], v1 = acc[ai][bj][m][1];
                    if (MODE == 2) { v0 = v0 * *(const f32x4*)(scale + col0 + bj * HALF); v1 = v1 * *(const f32x4*)(scale + col0 + bj * HALF + 4); }
                    if (dog) {
#pragma unroll
                        for (int j = 0; j < 4; ++j) { v0[j] = gelu_t(v0[j]); v1[j] = gelu_t(v1[j]); } }
                    u32x4 w; w.x = cvt_pk_bf16(v0[0], v0[1]); w.y = cvt_pk_bf16(v0[2], v0[3]); w.z = cvt_pk_bf16(v1[0], v1[1]); w.w = cvt_pk_bf16(v1[2], v1[3]);
                    *(u32x4*)(rowp + bj * HALF) = w; } }
    }
};
struct EpiGateVal {
    static constexpr bool PERM = true;
    bf16_t* ACT; bf16_t* GF; bf16_t* VF; bf16_t* GL; float* ffn_p; float* ffn_s; const float* cw; const float* cb;
    __device__ __forceinline__ void operator()(const f32x4 (&acc)[2][2][4][2], const Unit& u, int wr, int wc, int fr, int fq) const {
        const int lane = threadIdx.x & 63, row0 = u.pm * BM + wr * 64 + fr, col0 = u.pn * HALF + wc * 32 + 8 * fq;
        const int src1 = (lane & 48) | ((fr - 1) & 15), src2 = (lane & 48) | ((fr - 2) & 15);
        f32x4 w0[2], w1[2], w2[2], bb[2];
#pragma unroll
        for (int n = 0; n < 2; ++n) { w0[n] = *(const f32x4*)(cw + col0 + 4 * n); w1[n] = *(const f32x4*)(cw + DFF + col0 + 4 * n); w2[n] = *(const f32x4*)(cw + 2 * DFF + col0 + 4 * n); bb[n] = *(const f32x4*)(cb + col0 + 4 * n); }
#pragma unroll
        for (int ai = 0; ai < 2; ++ai) {
            f32x4 pP1[2], pP2[2];
#pragma unroll
            for (int n = 0; n < 2; ++n) { pP1[n] = (f32x4){0.f, 0.f, 0.f, 0.f}; pP2[n] = (f32x4){0.f, 0.f, 0.f, 0.f}; }
#pragma unroll
            for (int m = 0; m < 4; ++m) { const int row = row0 + ai * HALF + m * 16; const size_t off = (size_t)row * ALD + col0;
                const f32x4 g0 = acc[ai][0][m][0], g1v = acc[ai][0][m][1], v0 = acc[ai][1][m][0], v1 = acc[ai][1][m][1];
                u32x2 a2[2];
#pragma unroll
                for (int n = 0; n < 2; ++n) { const f32x4 g = n ? g1v : g0, v = n ? v1 : v0; f32x4 P1, P2;
#pragma unroll
                    for (int j = 0; j < 4; ++j) { P1[j] = __shfl(g[j], src1); P2[j] = __shfl(g[j], src2); }
                    const f32x4 h1 = fr >= 1 ? P1 : pP1[n], h2 = fr >= 2 ? P2 : pP2[n]; pP1[n] = P1; pP2[n] = P2;
                    const f32x4 cv = bb[n] + w0[n] * h2 + w1[n] * h1 + w2[n] * g; f32x4 o;
#pragma unroll
                    for (int j = 0; j < 4; ++j) o[j] = gelu_t(cv[j]) * v[j];
                    a2[n].x = cvt_pk_bf16(o[0], o[1]); a2[n].y = cvt_pk_bf16(o[2], o[3]); }
                const bool deferred = (fr < 2) && (m == 0 || (m == 2 && row >= TP));
                if (!deferred) { *(u32x4*)(ACT + off) = (u32x4){a2[0].x, a2[0].y, a2[1].x, a2[1].y}; }
                else { const size_t so = ((size_t)(row >> 5) * 2 + (row & 1)) * DFF + col0;
                    *(u32x4*)(GF + so) = (u32x4){cvt_pk_bf16(g0[0], g0[1]), cvt_pk_bf16(g0[2], g0[3]), cvt_pk_bf16(g1v[0], g1v[1]), cvt_pk_bf16(g1v[2], g1v[3])};
                    *(u32x4*)(VF + so) = (u32x4){cvt_pk_bf16(v0[0], v0[1]), cvt_pk_bf16(v0[2], v0[3]), cvt_pk_bf16(v1[0], v1[1]), cvt_pk_bf16(v1[2], v1[3])}; }
                if (m == 3 && fr >= 14 && row < TP) { const size_t so = ((size_t)(row >> 6) * 2 + (fr - 14)) * DFF + col0;
                    *(u32x4*)(GL + so) = (u32x4){cvt_pk_bf16(g0[0], g0[1]), cvt_pk_bf16(g0[2], g0[3]), cvt_pk_bf16(g1v[0], g1v[1]), cvt_pk_bf16(g1v[2], g1v[3])}; }
                float* sp = nullptr;
                if (row < TP) { const int t = row & 4095; if (t >= 4094) sp = ffn_p + ((size_t)(row >> 12) * 2 + (t - 4094)) * DFF + col0; }
                else { const int rr = row - TP, t = rr & 31; if (t >= 30) sp = ffn_s + ((size_t)(rr >> 5) * 2 + (t - 30)) * DFF + col0; }
                if (sp) { *(f32x4*)sp = g0; *(f32x4*)(sp + 4) = g1v; } }
        }
    }
};
struct EpiGlu {
    static constexpr bool PERM = true;
    bf16_t* O; int ldc;
    __device__ __forceinline__ void operator()(const f32x4 (&acc)[2][2][4][2], const Unit& u, int wr, int wc, int fr, int fq) const {
        const int row0 = u.pm * BM + wr * 64 + fr, col0 = u.pn * HALF + wc * 32 + 8 * fq;
#pragma unroll
        for (int ai = 0; ai < 2; ++ai)
#pragma unroll
            for (int m = 0; m < 4; ++m) { const int row = row0 + ai * HALF + m * 16;
                f32x4 a0 = acc[ai][0][m][0], a1 = acc[ai][0][m][1]; const f32x4 b0 = acc[ai][1][m][0], b1 = acc[ai][1][m][1];
#pragma unroll
                for (int j = 0; j < 4; ++j) { a0[j] *= sigmoidf(b0[j]); a1[j] *= sigmoidf(b1[j]); }
                u32x4 w; w.x = cvt_pk_bf16(a0[0], a0[1]); w.y = cvt_pk_bf16(a0[2], a0[3]); w.z = cvt_pk_bf16(a1[0], a1[1]); w.w = cvt_pk_bf16(a1[2], a1[3]);
                *(u32x4*)(O + (size_t)row * ldc + col0) = w; }
    }
};

template <class Epi, class Sched>
__device__ __forceinline__ void gemm_phase(LAS unsigned char* lds, const Gemm g, const Sched& S, const Epi& E) {
    const int tid = threadIdx.x, wid = __builtin_amdgcn_readfirstlane(tid >> 6), lane = tid & 63, wr = wid >> 2, wc = wid & 3, fr = lane & 15, fq = lane >> 4;
    const int K = g.K, nt = K / BK;
    unsigned voffA[2], voffB[2];
#pragma unroll
    for (int i = 0; i < 2; ++i) { int R, C; stage_rc(tid * 16 + i * 8192, R, C); const int Rb = Epi::PERM ? ((R & ~31) + perm32(R & 31)) : R;
        voffA[i] = (unsigned)(R * g.lda + C) * 2u; voffB[i] = (unsigned)(Rb * g.ldb + C) * 2u; }
    const size_t kstep = (size_t)(BK * 2);
    const size_t hstepA = (size_t)HALF * g.lda * 2, hstepB = (size_t)HALF * g.ldb * 2;
    const size_t tstepA = 2 * hstepA, tstepB = 2 * hstepB;
    const size_t pnoff = (size_t)g.a_pn_off * 2, ksb = (size_t)g.K * 2;
    const unsigned ldsw = (unsigned)wid * 1024u;
    const int aoff = lds_byte(wr * 64 + fr, fq * 8), boff = lds_byte(wc * 32 + fr, fq * 8);
#define PG8_SA(b, h) (((b) * 2 + (h)) * HTB)
#define PG8_SB(b, h) ((4 + (b) * 2 + (h)) * HTB)
#define PG8_STAGE(bufoff, gbase, voff) do { _Pragma("unroll") for (int _i = 0; _i < 2; ++_i) \
        __builtin_amdgcn_global_load_lds((const unsigned*)((const char*)(gbase) + (voff)[_i]), (LAS unsigned*)(lds + (bufoff) + ldsw + _i * 8192), 16, 0, 0); } while (0)
#define PG8_LDA(dst, b, h) do { _Pragma("unroll") for (int m = 0; m < 4; ++m) _Pragma("unroll") for (int k = 0; k < 2; ++k) dst[m][k] = *(const LAS bf16x8*)(lds + PG8_SA(b, h) + aoff + m * 2048 + k * 1024); } while (0)
#define PG8_LDB(dst, b, h) do { _Pragma("unroll") for (int n = 0; n < 2; ++n) _Pragma("unroll") for (int k = 0; k < 2; ++k) dst[n][k] = *(const LAS bf16x8*)(lds + PG8_SB(b, h) + boff + n * 2048 + k * 1024); } while (0)
#define PG8_MMA(ai, bj, At, Bt) do { __builtin_amdgcn_s_setprio(1); _Pragma("unroll") for (int m = 0; m < 4; ++m) _Pragma("unroll") for (int n = 0; n < 2; ++n) _Pragma("unroll") for (int k = 0; k < 2; ++k) \
        acc[ai][bj][m][n] = __builtin_amdgcn_mfma_f32_16x16x32_bf16(Bt[n][k], At[m][k], acc[ai][bj][m][n], 0, 0, 0); __builtin_amdgcn_s_setprio(0); } while (0)
#define PG8_WAIT_V(n) asm volatile("s_waitcnt vmcnt(" #n ")" ::: "memory")
#define PG8_WAIT_L(n) asm volatile("s_waitcnt lgkmcnt(" #n ")" ::: "memory")
#define PG8_BAR __builtin_amdgcn_s_barrier()
#define PG8_SCHED __builtin_amdgcn_sched_barrier(0)
    Unit cur, nxt; int ui = 0;
    if (!S.next(0, cur)) return;
    f32x4 acc[2][2][4][2];
#pragma unroll
    for (int a = 0; a < 2; ++a)
#pragma unroll
        for (int b = 0; b < 2; ++b)
#pragma unroll
            for (int m = 0; m < 4; ++m)
#pragma unroll
                for (int n = 0; n < 2; ++n) acc[a][b][m][n] = (f32x4){0.f, 0.f, 0.f, 0.f};
    bf16x8 At[4][2], B0[2][2], B1[2][2];
    const char* cA = (const char*)g.A + (size_t)cur.pm * tstepA + (size_t)cur.pn * pnoff + (size_t)cur.ks * ksb; const char* cB = (const char*)g.Bt + (size_t)cur.pn * tstepB + (size_t)cur.ks * ksb;
    PG8_STAGE(PG8_SB(0, 0), cB, voffB); PG8_STAGE(PG8_SA(0, 0), cA, voffA); PG8_STAGE(PG8_SB(0, 1), cB + hstepB, voffB); PG8_STAGE(PG8_SA(0, 1), cA + hstepA, voffA);
    if (wr == 1) PG8_BAR;
    PG8_WAIT_V(4); PG8_BAR;
    PG8_STAGE(PG8_SB(1, 0), cB + kstep, voffB); PG8_STAGE(PG8_SA(1, 0), cA + kstep, voffA); PG8_STAGE(PG8_SB(1, 1), cB + hstepB + kstep, voffB);
    PG8_WAIT_V(6); PG8_BAR;
    for (;;) {
        const bool has_next = S.next(ui + 1, nxt);
        const char* nA = has_next ? (const char*)g.A + (size_t)nxt.pm * tstepA + (size_t)nxt.pn * pnoff + (size_t)nxt.ks * ksb : cA; const char* nB = has_next ? (const char*)g.Bt + (size_t)nxt.pn * tstepB + (size_t)nxt.ks * ksb : cB;
        for (int t = 0; t < nt; t += 2) {
            const bool last = (t == nt - 2);
            const char* a1 = cA + (size_t)(t + 1) * kstep;
            const char* a2 = last ? nA : cA + (size_t)(t + 2) * kstep; const char* b2 = last ? nB : cB + (size_t)(t + 2) * kstep;
            const char* a3 = a2 + kstep; const char* b3 = b2 + kstep;
            PG8_LDB(B0, 0, 0); PG8_SCHED; PG8_LDA(At, 0, 0); PG8_STAGE(PG8_SA(1, 1), a1 + hstepA, voffA);
            PG8_WAIT_L(8); PG8_BAR; PG8_WAIT_L(0); PG8_MMA(0, 0, At, B0); PG8_BAR; PG8_SCHED;
            PG8_LDB(B1, 0, 1); PG8_STAGE(PG8_SB(0, 0), b2, voffB);
            PG8_BAR; PG8_WAIT_L(0); PG8_MMA(0, 1, At, B1); PG8_BAR;
            PG8_LDA(At, 0, 1); PG8_STAGE(PG8_SA(0, 0), a2, voffA);
            PG8_BAR; PG8_WAIT_L(0); PG8_MMA(1, 0, At, B0); PG8_BAR; PG8_SCHED;
            PG8_STAGE(PG8_SB(0, 1), b2 + hstepB, voffB);
            PG8_WAIT_V(6); PG8_BAR; PG8_MMA(1, 1, At, B1); PG8_BAR;
            PG8_LDB(B0, 1, 0); PG8_SCHED; PG8_LDA(At, 1, 0); PG8_STAGE(PG8_SA(0, 1), a2 + hstepA, voffA);
            PG8_WAIT_L(8); PG8_BAR; PG8_WAIT_L(0); PG8_MMA(0, 0, At, B0); PG8_BAR; PG8_SCHED;
            PG8_LDB(B1, 1, 1); PG8_STAGE(PG8_SB(1, 0), b3, voffB);
            PG8_BAR; PG8_WAIT_L(0); PG8_MMA(0, 1, At, B1); PG8_BAR;
            PG8_LDA(At, 1, 1); PG8_STAGE(PG8_SA(1, 0), a3, voffA);
            PG8_BAR; PG8_WAIT_L(0); PG8_MMA(1, 0, At, B0); PG8_BAR; PG8_SCHED;
            PG8_STAGE(PG8_SB(1, 1), b3 + hstepB, voffB);
            PG8_WAIT_V(6); PG8_BAR; PG8_MMA(1, 1, At, B1); PG8_BAR;
        }
        E(acc, cur, wr, wc, fr, fq);
        if (!has_next) break;
#pragma unroll
        for (int a = 0; a < 2; ++a)
#pragma unroll
            for (int b = 0; b < 2; ++b)
#pragma unroll
                for (int m = 0; m < 4; ++m)
#pragma unroll
                    for (int n = 0; n < 2; ++n) acc[a][b][m][n] = (f32x4){0.f, 0.f, 0.f, 0.f};
        cur = nxt; cA = nA; cB = nB; ++ui;
    }
    PG8_WAIT_V(0);
    if (wr == 0) PG8_BAR;
    PG8_BAR;
#undef PG8_SA
#undef PG8_SB
#undef PG8_STAGE
#undef PG8_LDA
#undef PG8_LDB
#undef PG8_MMA
#undef PG8_WAIT_V
#undef PG8_WAIT_L
#undef PG8_BAR
#undef PG8_SCHED
}
}

template <class Epi>
__device__ __forceinline__ void run_gemm(LAS unsigned char* lds, const bf16_t* A, const bf16_t* Bt, int N, int K, int lda, int ldb, int a_pn_off, const Epi& E, int vb, int M = T, int cshift = 0) {
    pg8::Gemm g; g.A = A; g.Bt = Bt; g.M = M; g.N = N; g.K = K; g.lda = lda; g.ldb = ldb; g.a_pn_off = a_pn_off;
    int c = vb - cshift; if (c < 0) c += (int)gridDim.x;
    pg8::StaticOrder S; S.init(M, N, (int)gridDim.x, c);
    pg8::gemm_phase<Epi, pg8::StaticOrder>(lds, g, S, E);
}
__device__ __forceinline__ void run_gemm_split(LAS unsigned char* lds, const bf16_t* A, const bf16_t* Bt, int K, int ld, int S, bf16_t* slabs, int vb) {
    pg8::Gemm g; g.A = A + (size_t)TP * ld; g.Bt = Bt; g.M = 1024; g.N = DM; g.K = K / S; g.lda = ld; g.ldb = ld; g.a_pn_off = 0;
    pg8::SplitOrder O; O.init(8, S, (int)gridDim.x, vb);
    pg8::EpiBf16<1> E; E.O = slabs; E.ldc = DM; E.gelu_tiles = 0; E.scale = nullptr; E.slab = (size_t)1024 * DM;
    pg8::gemm_phase<pg8::EpiBf16<1>, pg8::SplitOrder>(lds, g, O, E);
}

__device__ __forceinline__ void get_job(const Params& p, int j, const float*& src, bf16_t*& dst, int& K, int& N, int& ld, int& half, const float*& nscale) {
    unsigned char* ws = p.ws; half = 0; nscale = nullptr;
    switch (j) {
        case 0: src = p.in[11]; dst = (bf16_t*)(ws + OFF_WIN_E); K = DM; N = NE; ld = NE_SRC; break;
        case 1: src = p.in[18]; dst = (bf16_t*)(ws + OFF_WOUT_E); K = DM; N = DM; ld = DM; break;
        case 2: src = p.in[32]; dst = (bf16_t*)(ws + OFF_WUP0); K = DM; N = 2 * DFF; ld = 2 * DFF; half = DFF; break;
        case 3: src = p.in[32] + (size_t)DM * 2 * DFF; dst = (bf16_t*)(ws + OFF_WUP1); K = DM; N = 2 * DFF; ld = 2 * DFF; half = DFF; break;
        case 4: src = p.in[35]; dst = (bf16_t*)(ws + OFF_WDN0); K = DFF; N = DM; ld = DM; break;
        case 5: src = p.in[35] + (size_t)DFF * DM; dst = (bf16_t*)(ws + OFF_WDN1); K = DFF; N = DM; ld = DM; break;
        case 6: src = p.in[19]; dst = (bf16_t*)(ws + OFF_WIN_O); K = DM; N = DM; ld = DM; break;
        case 7: case 8: case 9: case 10: src = p.in[20] + (size_t)(j - 7) * 65536; dst = (bf16_t*)(ws + OFF_CMAP) + (size_t)(j - 7) * 256 * CLD; K = 256; N = 256; ld = 256; nscale = p.in[21] + (j - 7) * 256; break;
        case 11: src = p.in[30]; dst = (bf16_t*)(ws + OFF_WGLU); K = 1024; N = 2048; ld = 2048; half = 1024; break;
        default: src = p.in[31]; dst = (bf16_t*)(ws + OFF_WOUT_O); K = DM; N = DM; ld = DM; break;
    }
}
struct TileInfo { const float* src; bf16_t* dst; const float* nscale; int K, ld, half, k0, n0; };
__device__ __forceinline__ void prep_decode(const Params& p, int tile, TileInfo& ti) {
    int j, t0;
    if (tile < 640) { j = 0; t0 = 0; } else if (tile < 896) { j = 1; t0 = 640; } else if (tile < 2304) { j = 2; t0 = 896; } else if (tile < 3712) { j = 3; t0 = 2304; }
    else if (tile < 4416) { j = 4; t0 = 3712; } else if (tile < 5120) { j = 5; t0 = 4416; } else if (tile < 5376) { j = 6; t0 = 5120; }
    else if (tile < 5392) { j = 7 + ((tile - 5376) >> 2); t0 = 5376 + ((tile - 5376) & ~3); } else if (tile < 5520) { j = 11; t0 = 5392; } else { j = 12; t0 = 5520; }
    int N; get_job(p, j, ti.src, ti.dst, ti.K, N, ti.ld, ti.half, ti.nscale);
    const int local = tile - t0, ntn = N >> 8, tk = local / ntn, tn = local - tk * ntn; ti.k0 = tk * 64; ti.n0 = tn * 256;
}
constexpr int NL0 = 2048, NL1 = 336, NL2 = 1456, NL3 = 640, NL4 = 592, NL5 = 704;
__device__ __forceinline__ int list_tile(int list, int q) {
    switch (list) {
        case 0: return q < 640 ? q : 896 + (q - 640);
        case 1: return q < 256 ? 640 + q : 3712 + (q - 256);
        case 2: return q < 624 ? 3792 + q : (q < 1280 ? 5120 + (q - 624) : 2304 + (q - 1280));
        case 3: return 2480 + q;
        case 4: return 3120 + q;
        default: return 4416 + q;
    }
}
template <int LIST>
__device__ __forceinline__ void prep_run(const Params& p, LAS unsigned char* lds, int q0, int qs, int qend) {
    const int tid = threadIdx.x, wid = tid >> 6, lane = tid & 63;
    constexpr int TROW = 144;
    int it = 0, q = q0;
    TileInfo cur; f32x4 v[8];
    if (q < qend) { prep_decode(p, list_tile(LIST, q), cur);
#pragma unroll
        for (int i = 0; i < 8; ++i) v[i] = __builtin_nontemporal_load((const f32x4*)(cur.src + (size_t)(cur.k0 + wid * 8 + i) * cur.ld + cur.n0 + lane * 4)); }
    while (q < qend) {
        LAS unsigned char* buf = lds + (it & 1) * (256 * TROW);
        if (cur.nscale) { const f32x4 sc = *(const f32x4*)(cur.nscale + cur.n0 + lane * 4);
#pragma unroll
            for (int i = 0; i < 8; ++i) v[i] = v[i] * sc; }
#pragma unroll
        for (int e = 0; e < 4; ++e) { u32x4 w; w.x = cvt_pk_bf16(v[0][e], v[1][e]); w.y = cvt_pk_bf16(v[2][e], v[3][e]); w.z = cvt_pk_bf16(v[4][e], v[5][e]); w.w = cvt_pk_bf16(v[6][e], v[7][e]);
            *(LAS u32x4*)(buf + (lane * 4 + e) * TROW + wid * 16) = w; }
        const int nq = q + qs; TileInfo nxt = cur;
        if (nq < qend) { prep_decode(p, list_tile(LIST, nq), nxt);
#pragma unroll
            for (int i = 0; i < 8; ++i) v[i] = __builtin_nontemporal_load((const f32x4*)(nxt.src + (size_t)(nxt.k0 + wid * 8 + i) * nxt.ld + nxt.n0 + lane * 4)); }
        __syncthreads();
#pragma unroll
        for (int i = 0; i < 4; ++i) { const int n = i * 64 + (tid >> 3), kq = (tid & 7) * 8; const int ns = cur.n0 + n;
            int drow = ns; if (cur.half) { const int which = ns >= cur.half ? 1 : 0, nn = ns - which * cur.half; drow = (nn >> 7) * 256 + which * 128 + (nn & 127); }
            *(u32x4*)(cur.dst + (size_t)drow * (cur.K + PADK) + cur.k0 + kq) = *(const LAS u32x4*)(buf + n * TROW + kq * 2); }
        cur = nxt; q = nq; ++it;
    }
    __syncthreads();
}
__device__ __forceinline__ void phase_prep(const Params& p, LAS unsigned char* lds) {
    const int tid = threadIdx.x, wid = tid >> 6, lane = tid & 63;
    prep_run<0>(p, lds, (int)blockIdx.x, (int)gridDim.x, NL0);
    if (gridDim.x != 256) {
        prep_run<1>(p, lds, (int)blockIdx.x, (int)gridDim.x, NL1); prep_run<2>(p, lds, (int)blockIdx.x, (int)gridDim.x, NL2); prep_run<3>(p, lds, (int)blockIdx.x, (int)gridDim.x, NL3);
        prep_run<4>(p, lds, (int)blockIdx.x, (int)gridDim.x, NL4); prep_run<5>(p, lds, (int)blockIdx.x, (int)gridDim.x, NL5); }
    const int gtid = blockIdx.x * 512 + tid, gstride = gridDim.x * 512;
    { bf16_t* wg = (bf16_t*)(p.ws + OFF_WG);
      for (int i = gtid; i < DM * 16; i += gstride) { const int k = i >> 4, r = i & 15; wg[r * DM + k] = (bf16_t)(cvt_pk_bf16(p.in[11][(size_t)k * NE_SRC + NE + r], 0.f) & 0xffffu); } }
    { bf16_t* wsm = (bf16_t*)(p.ws + OFF_WSM);
      for (int i = gtid; i < 8 * 128 * 128; i += gstride) { const int jj = i & 127, ii = (i >> 7) & 127; const float w = ((jj >> 6) <= (ii >> 6)) ? p.in[12][i] : 0.f; wsm[i] = (bf16_t)(cvt_pk_bf16(w, 0.f) & 0xffffu); } }
    { bf16_t* h = (bf16_t*)(p.ws + OFF_H); const float* g = p.in[7];
      for (int row = blockIdx.x * 8 + wid; row < T; row += gridDim.x * 8) {
          const float* x = xrow_in(p, row); f32x4 v[8]; float ss = 0.f;
#pragma unroll
          for (int q = 0; q < 4; ++q) { v[2 * q] = *(const f32x4*)(x + q * 512 + lane * 8); v[2 * q + 1] = *(const f32x4*)(x + q * 512 + lane * 8 + 4); }
#pragma unroll
          for (int q = 0; q < 8; ++q) ss += v[q][0] * v[q][0] + v[q][1] * v[q][1] + v[q][2] * v[q][2] + v[q][3] * v[q][3];
          ss = wave_sum(ss); const float rstd = rsqrtf(ss * (1.0f / DM) + EPS);
#pragma unroll
          for (int q = 0; q < 4; ++q) { const f32x4 ga = *(const f32x4*)(g + q * 512 + lane * 8), gb = *(const f32x4*)(g + q * 512 + lane * 8 + 4); const f32x4 a = v[2 * q] * rstd * ga, c = v[2 * q + 1] * rstd * gb;
              *(u32x4*)(h + (size_t)row * HLD + q * 512 + lane * 8) = (u32x4){cvt_pk_bf16(a[0], a[1]), cvt_pk_bf16(a[2], a[3]), cvt_pk_bf16(c[0], c[1]), cvt_pk_bf16(c[2], c[3])}; }
      } }
}

__device__ __forceinline__ void phase_norm(const Params& p, bool x_from_input, float* xout_f32, const float* g_post, const float* g_pre, const bf16_t* slabs, int nslab) {
    const int tid = threadIdx.x, wid = tid >> 6, lane = tid & 63;
    const bf16_t* m = (const bf16_t*)(p.ws + OFF_M); bf16_t* xa = (bf16_t*)(p.ws + OFF_XA); bf16_t* h = (bf16_t*)(p.ws + OFF_H);
    for (int row = blockIdx.x * 8 + wid; row < T; row += gridDim.x * 8) {
        float mv[4][8], xv[4][8]; float ss = 0.f;
        if (x_from_input) { const float* x = xrow_in(p, row);
#pragma unroll
            for (int q = 0; q < 4; ++q) { const f32x4 a = *(const f32x4*)(x + q * 512 + lane * 8), c = *(const f32x4*)(x + q * 512 + lane * 8 + 4);
#pragma unroll
                for (int e = 0; e < 4; ++e) { xv[q][e] = a[e]; xv[q][4 + e] = c[e]; } }
        } else { const bf16_t* x = xa + (size_t)row * DM;
#pragma unroll
            for (int q = 0; q < 4; ++q) { const u32x4 w = *(const u32x4*)(x + q * 512 + lane * 8);
#pragma unroll
                for (int e = 0; e < 4; ++e) { xv[q][2 * e] = bf_lo(w[e]); xv[q][2 * e + 1] = bf_hi(w[e]); } } }
        if (row < TP) { const bf16_t* mr = m + (size_t)row * DM;
#pragma unroll
            for (int q = 0; q < 4; ++q) { const u32x4 w = *(const u32x4*)(mr + q * 512 + lane * 8);
#pragma unroll
                for (int e = 0; e < 4; ++e) { mv[q][2 * e] = bf_lo(w[e]); mv[q][2 * e + 1] = bf_hi(w[e]); } }
        } else { const bf16_t* sr = slabs + (size_t)(row - TP) * DM;
#pragma unroll
            for (int q = 0; q < 4; ++q)
#pragma unroll
                for (int e = 0; e < 8; ++e) mv[q][e] = 0.f;
#pragma unroll 4
            for (int k = 0; k < nslab; ++k) {
#pragma unroll
                for (int q = 0; q < 4; ++q) { const u32x4 w = *(const u32x4*)(sr + (size_t)k * 1024 * DM + q * 512 + lane * 8);
#pragma unroll
                    for (int e = 0; e < 4; ++e) { mv[q][2 * e] += bf_lo(w[e]); mv[q][2 * e + 1] += bf_hi(w[e]); } } } }
#pragma unroll
        for (int q = 0; q < 4; ++q)
#pragma unroll
            for (int e = 0; e < 8; ++e) ss += mv[q][e] * mv[q][e];
        ss = wave_sum(ss); const float rstd = rsqrtf(ss * (1.0f / DM) + EPS); float s2 = 0.f;
#pragma unroll
        for (int q = 0; q < 4; ++q) { const f32x4 ga = *(const f32x4*)(g_post + q * 512 + lane * 8), gb = *(const f32x4*)(g_post + q * 512 + lane * 8 + 4);
#pragma unroll
            for (int e = 0; e < 8; ++e) { xv[q][e] += mv[q][e] * rstd * (e < 4 ? ga[e & 3] : gb[e & 3]); s2 += xv[q][e] * xv[q][e]; }
            if (xout_f32) { float* o = xout_f32 + (size_t)row * DM + q * 512 + lane * 8; __builtin_nontemporal_store((f32x4){xv[q][0], xv[q][1], xv[q][2], xv[q][3]}, (f32x4*)o); __builtin_nontemporal_store((f32x4){xv[q][4], xv[q][5], xv[q][6], xv[q][7]}, (f32x4*)(o + 4)); }
            else *(u32x4*)(xa + (size_t)row * DM + q * 512 + lane * 8) = (u32x4){cvt_pk_bf16(xv[q][0], xv[q][1]), cvt_pk_bf16(xv[q][2], xv[q][3]), cvt_pk_bf16(xv[q][4], xv[q][5]), cvt_pk_bf16(xv[q][6], xv[q][7])}; }
        if (g_pre) { s2 = wave_sum(s2); const float r2 = rsqrtf(s2 * (1.0f / DM) + EPS);
#pragma unroll
            for (int q = 0; q < 4; ++q) { const f32x4 ga = *(const f32x4*)(g_pre + q * 512 + lane * 8), gb = *(const f32x4*)(g_pre + q * 512 + lane * 8 + 4); float o[8];
#pragma unroll
                for (int e = 0; e < 8; ++e) o[e] = xv[q][e] * r2 * (e < 4 ? ga[e & 3] : gb[e & 3]);
                *(u32x4*)(h + (size_t)row * HLD + q * 512 + lane * 8) = (u32x4){cvt_pk_bf16(o[0], o[1]), cvt_pk_bf16(o[2], o[3]), cvt_pk_bf16(o[4], o[5]), cvt_pk_bf16(o[6], o[7])}; } }
    }
}

__device__ __forceinline__ void phase_glr(const Params& p, int vb) {
    const int tid = threadIdx.x, wid = tid >> 6, lane = tid & 63, fr = lane & 15, fq = lane >> 4;
    const bf16_t* h = (const bf16_t*)(p.ws + OFF_H); const bf16_t* wg = (const bf16_t*)(p.ws + OFF_WG); float* glr = (float*)(p.ws + OFF_GLR);
    for (int grp = ((int)gridDim.x - 1 - vb) * 8 + wid; grp < T / 16; grp += (int)gridDim.x * 8) {
        f32x4 acc = (f32x4){0.f, 0.f, 0.f, 0.f};
        const bf16_t* ap = h + (size_t)(grp * 16 + fr) * HLD + fq * 8; const bf16_t* bp = wg + (size_t)fr * DM + fq * 8;
#pragma unroll 8
        for (int ks = 0; ks < DM / 32; ++ks) { const bf16x8 a = *(const bf16x8*)(ap + ks * 32), b = *(const bf16x8*)(bp + ks * 32); acc = __builtin_amdgcn_mfma_f32_16x16x32_bf16(a, b, acc, 0, 0, 0); }
#pragma unroll
        for (int j = 0; j < 4; ++j) glr[(size_t)(grp * 16 + fq * 4 + j) * 16 + fr] = acc[j];
    }
}

template <int L>
__device__ __forceinline__ void amix_item(const Params& p, LAS unsigned char* lds, int item) {
    const int tid = threadIdx.x, wid = tid >> 6, lane = tid & 63;
    const bf16_t* proj = (const bf16_t*)(p.ws + OFF_PROJ); bf16_t* mix = (bf16_t*)(p.ws + OFF_MIX); const bf16_t* wsm = (const bf16_t*)(p.ws + OFF_WSM);
    const int tb = item >> 2, hp = item & 3; constexpr bool smp = (L == 32); const int row0 = smp ? TP + (tb - 64) * 32 : tb * 128;
    constexpr int VROW = 272;
    LAS float* stats = (LAS float*)(lds + 256 * VROW);
    for (int l0 = wid * 4; l0 < L; l0 += 32) {
        u32x4 a[4], b[4];
#pragma unroll
        for (int r4 = 0; r4 < 4; ++r4) { const bf16_t* r = proj + (size_t)(row0 + l0 + r4) * NE + 1024; a[r4] = *(const u32x4*)(r + lane * 8); b[r4] = *(const u32x4*)(r + 512 + lane * 8); }
#pragma unroll
        for (int r4 = 0; r4 < 4; ++r4) { float s = 0.f, q = 0.f;
#pragma unroll
            for (int e = 0; e < 4; ++e) { const float a0 = bf_lo(a[r4][e]), a1 = bf_hi(a[r4][e]), b0 = bf_lo(b[r4][e]), b1 = bf_hi(b[r4][e]); s += (a0 + a1) + (b0 + b1); q += (a0 * a0 + a1 * a1) + (b0 * b0 + b1 * b1); }
            s = wave_sum(s); q = wave_sum(q); const float mean = s * (1.0f / 1024.f), var = fmaxf(q * (1.0f / 1024.f) - mean * mean, 0.f);
            if (lane == 0) { stats[(l0 + r4) * 2] = mean; stats[(l0 + r4) * 2 + 1] = rsqrtf(var + EPS); } }
    }
    __syncthreads();
    const int c0 = hp * 256; const float* gain = p.in[14];
    for (int wi0 = tid; wi0 < L * 32; wi0 += 2048) {
        u32x4 av4[4];
#pragma unroll
        for (int u4 = 0; u4 < 4; ++u4) { const int wi = wi0 + u4 * 512; if (wi < L * 32) { const int j = wi % L, cg8 = wi / L; av4[u4] = *(const u32x4*)(proj + (size_t)(row0 + j) * NE + 1024 + c0 + cg8 * 8); } }
#pragma unroll
        for (int u4 = 0; u4 < 4; ++u4) { const int wi = wi0 + u4 * 512; if (wi < L * 32) { const int j = wi % L, cg8 = wi / L;
            const u32x4 a = av4[u4]; const float mean = stats[j * 2], rstd = stats[j * 2 + 1];
            const f32x4 g0 = *(const f32x4*)(gain + c0 + cg8 * 8), g1 = *(const f32x4*)(gain + c0 + cg8 * 8 + 4); float o[8];
#pragma unroll
            for (int e = 0; e < 4; ++e) { o[2 * e] = (bf_lo(a[e]) - mean) * rstd * (e < 2 ? g0[2 * e] : g1[2 * e - 4]); o[2 * e + 1] = (bf_hi(a[e]) - mean) * rstd * (e < 2 ? g0[2 * e + 1] : g1[2 * e - 3]); }
#pragma unroll
            for (int e = 0; e < 8; ++e) *(LAS bf16_t*)(lds + (cg8 * 8 + e) * VROW + j * 2) = (bf16_t)(cvt_pk_bf16(o[e], 0.f) & 0xffffu);
            if (smp) { float* av = p.out + O_AV + (size_t)(row0 - TP + j) * 1024 + c0 + cg8 * 8; *(f32x4*)av = (f32x4){o[0], o[1], o[2], o[3]}; *(f32x4*)(av + 4) = (f32x4){o[4], o[5], o[6], o[7]}; } } }
    }
    __syncthreads();
    const int hh = wid >> 2, dq = wid & 3, head = hp * 2 + hh, l31 = lane & 31, lh = lane >> 5;
    constexpr int nit = L >> 5, nks = L >> 4;
    f32x16 acc[4];
#pragma unroll
    for (int i = 0; i < 4; ++i)
#pragma unroll
        for (int r = 0; r < 16; ++r) acc[i][r] = 0.f;
    const LAS unsigned char* ap = lds + (hh * 128 + dq * 32 + l31) * VROW + lh * 16;
    const bf16_t* bp = wsm + (size_t)head * 16384 + (size_t)l31 * 128 + lh * 8;
    bf16x8 bq[4], bn[4];
#pragma unroll
    for (int i = 0; i < 4; ++i) { bq[i] = (bf16x8){0, 0, 0, 0, 0, 0, 0, 0}; if (i < nit) bq[i] = *(const bf16x8*)(bp + (size_t)i * 32 * 128); }
#pragma unroll
    for (int ks = 0; ks < nks; ++ks) {
        const bf16x8 a = *(const LAS bf16x8*)(ap + ks * 32);
#pragma unroll
        for (int i = 0; i < 4; ++i) { bn[i] = bq[i]; if (i < nit && ks + 1 < nks) bn[i] = *(const bf16x8*)(bp + (size_t)i * 32 * 128 + (ks + 1) * 16); }
#pragma unroll
        for (int i = 0; i < 4; ++i) if (i < nit) acc[i] = __builtin_amdgcn_mfma_f32_32x32x16_bf16(a, bq[i], acc[i], 0, 0, 0);
#pragma unroll
        for (int i = 0; i < 4; ++i) bq[i] = bn[i];
    }
    const float* bs = p.in[13] + head * 128;
#pragma unroll
    for (int i = 0; i < 4; ++i) if (i < nit) { const int ii = i * 32 + l31, row = row0 + ii; const float bias = bs[ii];
#pragma unroll
        for (int rg = 0; rg < 4; ++rg) { const int d = dq * 32 + rg * 8 + lh * 4, c = head * 128 + d; const u32x2 uu = *(const u32x2*)(proj + (size_t)row * NE + c);
            u32x2 w; w.x = cvt_pk_bf16(bf_lo(uu.x) * (acc[i][rg * 4] + bias), bf_hi(uu.x) * (acc[i][rg * 4 + 1] + bias)); w.y = cvt_pk_bf16(bf_lo(uu.y) * (acc[i][rg * 4 + 2] + bias), bf_hi(uu.y) * (acc[i][rg * 4 + 3] + bias));
            *(u32x2*)(mix + (size_t)row * HLD + c) = w; } }
    __syncthreads();
}

__device__ __forceinline__ void gla_item_decode(int it, int& s, int& h, int& row0, int& L) {
    if (it < 512) { s = it >> 8; h = (it >> 6) & 3; row0 = s * 4096 + (it & 63) * 64; L = 64; } else { const int q = it - 512; s = q >> 2; h = q & 3; row0 = TP + s * 32; L = 32; }
}
template <int L>
__device__ __forceinline__ void glau_item(const Params& p, LAS unsigned char* lds, int it) {
    const int tid = threadIdx.x, wid = tid >> 6, lane = tid & 63;
    const bf16_t* proj = (const bf16_t*)(p.ws + OFF_PROJ); const float* glr = (const float*)(p.ws + OFF_GLR);
    int s, h, row0, Lrt; gla_item_decode(it, s, h, row0, Lrt); constexpr bool smp = (L == 32);
    constexpr int KROW = 144;
    LAS unsigned char* kdT = lds;
    LAS unsigned char* vT = lds + 128 * KROW;
    LAS float* glt = (LAS float*)(lds + 384 * KROW);
    LAS float* part = glt + 64 * 16;
    LAS float* totl = part + 4 * 128;
    if (tid < L * 4) *(LAS f32x4*)(glt + tid * 4) = *(const f32x4*)(glr + (size_t)row0 * 16 + tid * 4);
    __syncthreads();
    const int d = tid & 127, lq = tid >> 7; constexpr int Lq = L >> 2;
    float wg[16];
#pragma unroll
    for (int r = 0; r < 16; ++r) wg[r] = p.in[15][r * 512 + h * 128 + d];
    const float gb = p.in[16][h * 128 + d];
    float cum[16]; float run = 0.f;
#pragma unroll
    for (int i = 0; i < 16; ++i) { cum[i] = 0.f; if (i < Lq) { const int l = lq * Lq + i; float x = gb;
#pragma unroll
            for (int r4 = 0; r4 < 4; ++r4) { const f32x4 gg = *(const LAS f32x4*)(glt + l * 16 + r4 * 4); x += gg[0] * wg[r4 * 4] + gg[1] * wg[r4 * 4 + 1] + gg[2] * wg[r4 * 4 + 2] + gg[3] * wg[r4 * 4 + 3]; }
            const float ls = fminf(x, 0.f) - __logf(1.0f + __expf(-fabsf(x)));
            run += ls * (1.0f / 16.0f); cum[i] = run; } }
    part[lq * 128 + d] = run;
    __syncthreads();
    float offs = 0.f, tot = 0.f;
#pragma unroll
    for (int q = 0; q < 4; ++q) { const float pv = part[q * 128 + d]; tot += pv; if (q < lq) offs += pv; }
    if (lq == 0) { totl[d] = tot; ((float*)(p.ws + OFF_DECAY))[(size_t)it * 128 + d] = __expf(tot); }
    { unsigned pk[8];
#pragma unroll
      for (int i = 0; i < 16; i += 2) { float v0 = 0.f, v1 = 0.f;
          if (i < Lq) { const int l = lq * Lq + i; v0 = bf1(proj[(size_t)(row0 + l) * NE + 2560 + h * 128 + d]) * __expf(tot - offs - cum[i]); v1 = bf1(proj[(size_t)(row0 + l + 1) * NE + 2560 + h * 128 + d]) * __expf(tot - offs - cum[i + 1]); }
          pk[i >> 1] = cvt_pk_bf16(v0, v1); }
      LAS unsigned char* dstp = kdT + d * KROW + lq * Lq * 2;
      *(LAS u32x4*)dstp = (u32x4){pk[0], pk[1], pk[2], pk[3]};
      if (Lq == 16) *(LAS u32x4*)(dstp + 16) = (u32x4){pk[4], pk[5], pk[6], pk[7]}; }
    { const int v = tid & 255, hf = tid >> 8; constexpr int Lh = L >> 1; unsigned pk[16];
#pragma unroll
      for (int i = 0; i < 32; i += 2) { unsigned a = 0, b = 0; if (i < Lh) { const int l = hf * Lh + i; a = proj[(size_t)(row0 + l) * NE + 3072 + h * 256 + v]; b = proj[(size_t)(row0 + l + 1) * NE + 3072 + h * 256 + v]; } pk[i >> 1] = a | (b << 16); }
      LAS unsigned char* dstp = vT + v * KROW + hf * Lh * 2;
      *(LAS u32x4*)dstp = (u32x4){pk[0], pk[1], pk[2], pk[3]}; *(LAS u32x4*)(dstp + 16) = (u32x4){pk[4], pk[5], pk[6], pk[7]};
      if (Lh == 32) { *(LAS u32x4*)(dstp + 32) = (u32x4){pk[8], pk[9], pk[10], pk[11]}; *(LAS u32x4*)(dstp + 48) = (u32x4){pk[12], pk[13], pk[14], pk[15]}; } }
    __syncthreads();
    const int l31 = lane & 31, lh = lane >> 5, vs = wid * 32; constexpr int nks = L >> 4;
    f32x16 acc[4];
#pragma unroll
    for (int i = 0; i < 4; ++i)
#pragma unroll
        for (int r = 0; r < 16; ++r) acc[i][r] = 0.f;
#pragma unroll
    for (int ks = 0; ks < nks; ++ks) { const bf16x8 b = *(const LAS bf16x8*)(vT + (vs + l31) * KROW + ks * 32 + lh * 16);
#pragma unroll
        for (int dt = 0; dt < 4; ++dt) { const bf16x8 a = *(const LAS bf16x8*)(kdT + (dt * 32 + l31) * KROW + ks * 32 + lh * 16); acc[dt] = __builtin_amdgcn_mfma_f32_32x32x16_bf16(a, b, acc[dt], 0, 0, 0); } }
    const int v = vs + l31;
    if (!smp) { bf16_t* ut = (bf16_t*)(p.ws + OFF_UT) + ((size_t)it * 256 + v) * 128;
#pragma unroll
        for (int dt = 0; dt < 4; ++dt)
#pragma unroll
            for (int rg = 0; rg < 4; ++rg) { u32x2 w; w.x = cvt_pk_bf16(acc[dt][rg * 4], acc[dt][rg * 4 + 1]); w.y = cvt_pk_bf16(acc[dt][rg * 4 + 2], acc[dt][rg * 4 + 3]); *(u32x2*)(ut + dt * 32 + rg * 8 + lh * 4) = w; }
    } else { const float* s0 = p.in[2] + ((size_t)s * 4 + h) * 128 * 256; float* so = p.out + O_GLA_S + ((size_t)s * 4 + h) * 128 * 256; bf16_t* st = (bf16_t*)(p.ws + OFF_ST) + ((size_t)it * 256 + v) * 128;
#pragma unroll
        for (int dt = 0; dt < 4; ++dt)
#pragma unroll
            for (int rg = 0; rg < 4; ++rg) { const int dd = dt * 32 + rg * 8 + lh * 4; float sv[4];
#pragma unroll
                for (int e = 0; e < 4; ++e) { sv[e] = __expf(totl[dd + e]) * s0[(size_t)(dd + e) * 256 + v] + acc[dt][rg * 4 + e]; so[(size_t)(dd + e) * 256 + v] = sv[e]; }
                u32x2 w; w.x = cvt_pk_bf16(sv[0], sv[1]); w.y = cvt_pk_bf16(sv[2], sv[3]); *(u32x2*)(st + dd) = w; } }
    __syncthreads();
}

__device__ __forceinline__ void phase_gla_scan(const Params& p) {
    for (int gtid = blockIdx.x * 512 + threadIdx.x; gtid < 2 * 4 * 256 * 64; gtid += gridDim.x * 512) {
    const int dq = gtid & 63, v = (gtid >> 6) & 255, sh = gtid >> 14;
    const bf16_t* ut = (const bf16_t*)(p.ws + OFF_UT); const float* dec = (const float*)(p.ws + OFF_DECAY); bf16_t* st = (bf16_t*)(p.ws + OFF_ST);
    f32x2 S = (f32x2){0.f, 0.f};
#pragma unroll 16
    for (int c = 0; c < 64; ++c) { const int it = sh * 64 + c; const unsigned uw = *(const unsigned*)(ut + ((size_t)it * 256 + v) * 128 + dq * 2); const f32x2 u = (f32x2){bf_lo(uw), bf_hi(uw)}, dc = *(const f32x2*)(dec + (size_t)it * 128 + dq * 2);
        S = S * dc + u; *(unsigned*)(st + ((size_t)it * 256 + v) * 128 + dq * 2) = cvt_pk_bf16(S[0], S[1]); }
    float* o = p.out + O_GLA_P + (size_t)sh * 128 * 256;
    o[(size_t)(dq * 2) * 256 + v] = S[0]; o[(size_t)(dq * 2 + 1) * 256 + v] = S[1];
    }
}

template <int L>
__device__ __forceinline__ void glao_item(const Params& p, LAS unsigned char* lds, int it) {
    const int tid = threadIdx.x, wid = tid >> 6, lane = tid & 63, l31 = lane & 31, lh = lane >> 5;
    const bf16_t* proj = (const bf16_t*)(p.ws + OFF_PROJ); bf16_t* mix = (bf16_t*)(p.ws + OFF_MIX);
    int s, h, row0, Lrt; gla_item_decode(it, s, h, row0, Lrt);
    constexpr int nlt = L >> 5; const int vs = wid * 32;
    LAS float* red = (LAS float*)lds;
    const bf16_t* ap = (const bf16_t*)(p.ws + OFF_ST) + ((size_t)it * 256 + vs + l31) * 128 + lh * 8;
    const bf16_t* bp = proj + (size_t)(row0 + l31) * NE + 2048 + h * 128 + lh * 8;
    f32x16 acc[2];
#pragma unroll
    for (int i = 0; i < 2; ++i)
#pragma unroll
        for (int r = 0; r < 16; ++r) acc[i][r] = 0.f;
#pragma unroll
    for (int ks = 0; ks < 8; ++ks) { const bf16x8 a = *(const bf16x8*)(ap + ks * 16);
#pragma unroll
        for (int lt = 0; lt < 2; ++lt) if (lt < nlt) { const bf16x8 b = *(const bf16x8*)(bp + (size_t)lt * 32 * NE + ks * 16); acc[lt] = __builtin_amdgcn_mfma_f32_32x32x16_bf16(a, b, acc[lt], 0, 0, 0); } }
    const float qs = 0.08838834764831845f;
#pragma unroll
    for (int lt = 0; lt < 2; ++lt) { float ss = 0.f;
#pragma unroll
        for (int r = 0; r < 16; ++r) { acc[lt][r] *= qs; ss += acc[lt][r] * acc[lt][r]; }
        ss += __shfl_xor(ss, 32);
        if (lh == 0) red[wid * 64 + lt * 32 + l31] = ss; }
    __syncthreads();
    const float* og = p.in[17] + h * 256;
#pragma unroll
    for (int lt = 0; lt < 2; ++lt) if (lt < nlt) { float tot = 0.f;
#pragma unroll
        for (int w = 0; w < 8; ++w) tot += red[w * 64 + lt * 32 + l31];
        const float rstd = rsqrtf(tot * (1.0f / 256.f) + EPS); const int row = row0 + lt * 32 + l31;
#pragma unroll
        for (int rg = 0; rg < 4; ++rg) { const int vv = vs + rg * 8 + lh * 4; const u32x2 rr = *(const u32x2*)(proj + (size_t)row * NE + 4096 + h * 256 + vv); const f32x4 gg = *(const f32x4*)(og + vv);
            const float r0 = bf_lo(rr.x), r1 = bf_hi(rr.x), r2 = bf_lo(rr.y), r3 = bf_hi(rr.y);
            u32x2 w; w.x = cvt_pk_bf16(acc[lt][rg * 4] * rstd * gg[0] * r0 * sigmoidf(r0), acc[lt][rg * 4 + 1] * rstd * gg[1] * r1 * sigmoidf(r1));
            w.y = cvt_pk_bf16(acc[lt][rg * 4 + 2] * rstd * gg[2] * r2 * sigmoidf(r2), acc[lt][rg * 4 + 3] * rstd * gg[3] * r3 * sigmoidf(r3));
            *(u32x2*)(mix + (size_t)row * HLD + 1024 + h * 256 + vv) = w; } }
    __syncthreads();
}

__device__ __forceinline__ void phase_convfix(const Params& p, int layer) {
    bf16_t* ACT = (bf16_t*)(p.ws + OFF_VAL); const bf16_t* GF = (const bf16_t*)(p.ws + OFF_GF); const bf16_t* VF = (const bf16_t*)(p.ws + OFF_VF); const bf16_t* GL = (const bf16_t*)(p.ws + OFF_GL);
    const float* cw = p.in[33] + (size_t)layer * 3 * DFF; const float* cb = p.in[34] + (size_t)layer * DFF; const float* st = p.in[6] + (size_t)layer * 32 * 2 * DFF;
    for (int idx = blockIdx.x * 512 + threadIdx.x; idx < 160 * 704; idx += gridDim.x * 512) {
        const int pr = idx / 704, c = (idx - pr * 704) * 8;
        const int ra = pr < 128 ? pr * 64 : TP + (pr - 128) * 32, hb = ra >> 5;
        float w0[8], w1[8], w2[8], bb[8], h0[8], h1[8], ga[8], gb[8], va[8], vb[8];
#pragma unroll
        for (int e = 0; e < 8; e += 4) { const f32x4 a = *(const f32x4*)(cw + c + e), b = *(const f32x4*)(cw + DFF + c + e), d = *(const f32x4*)(cw + 2 * DFF + c + e), f = *(const f32x4*)(cb + c + e);
#pragma unroll
            for (int j = 0; j < 4; ++j) { w0[e + j] = a[j]; w1[e + j] = b[j]; w2[e + j] = d[j]; bb[e + j] = f[j]; } }
        if (ra >= TP) { const float* sp = st + (size_t)(pr - 128) * 2 * DFF + c;
#pragma unroll
            for (int e = 0; e < 8; e += 4) { const f32x4 a = *(const f32x4*)(sp + e), b = *(const f32x4*)(sp + DFF + e);
#pragma unroll
                for (int j = 0; j < 4; ++j) { h0[e + j] = a[j]; h1[e + j] = b[j]; } } }
        else if ((ra & 4095) == 0) {
#pragma unroll
            for (int e = 0; e < 8; ++e) { h0[e] = 0.f; h1[e] = 0.f; } }
        else { const u32x4 a = *(const u32x4*)(GL + ((size_t)((ra >> 6) - 1) * 2) * DFF + c), b = *(const u32x4*)(GL + ((size_t)((ra >> 6) - 1) * 2 + 1) * DFF + c);
#pragma unroll
            for (int e = 0; e < 4; ++e) { h0[2 * e] = bf_lo(a[e]); h0[2 * e + 1] = bf_hi(a[e]); h1[2 * e] = bf_lo(b[e]); h1[2 * e + 1] = bf_hi(b[e]); } }
        { const u32x4 a = *(const u32x4*)(GF + ((size_t)hb * 2) * DFF + c), b = *(const u32x4*)(GF + ((size_t)hb * 2 + 1) * DFF + c), d = *(const u32x4*)(VF + ((size_t)hb * 2) * DFF + c), f = *(const u32x4*)(VF + ((size_t)hb * 2 + 1) * DFF + c);
#pragma unroll
          for (int e = 0; e < 4; ++e) { ga[2 * e] = bf_lo(a[e]); ga[2 * e + 1] = bf_hi(a[e]); gb[2 * e] = bf_lo(b[e]); gb[2 * e + 1] = bf_hi(b[e]); va[2 * e] = bf_lo(d[e]); va[2 * e + 1] = bf_hi(d[e]); vb[2 * e] = bf_lo(f[e]); vb[2 * e + 1] = bf_hi(f[e]); } }
        float oa[8], ob[8];
#pragma unroll
        for (int e = 0; e < 8; ++e) { oa[e] = gelu_t(bb[e] + w0[e] * h0[e] + w1[e] * h1[e] + w2[e] * ga[e]) * va[e]; ob[e] = gelu_t(bb[e] + w0[e] * h1[e] + w1[e] * ga[e] + w2[e] * gb[e]) * vb[e]; }
        *(u32x4*)(ACT + (size_t)ra * ALD + c) = (u32x4){cvt_pk_bf16(oa[0], oa[1]), cvt_pk_bf16(oa[2], oa[3]), cvt_pk_bf16(oa[4], oa[5]), cvt_pk_bf16(oa[6], oa[7])};
        *(u32x4*)(ACT + (size_t)(ra + 1) * ALD + c) = (u32x4){cvt_pk_bf16(ob[0], ob[1]), cvt_pk_bf16(ob[2], ob[3]), cvt_pk_bf16(ob[4], ob[5]), cvt_pk_bf16(ob[6], ob[7])};
    }
}

template <int W>
__device__ __forceinline__ void pool_item(const Params& p, const bf16_t* proj2, bf16_t* delta, int r8, int c) {
    const int row0 = r8 * 8; const bool smp = row0 >= TP;
    const int seq = smp ? (row0 - TP) >> 5 : row0 >> 12, t0 = smp ? (row0 - TP) & 31 : row0 & 4095, rowbase = row0 - t0;
    const float* spool = p.in[3] + (size_t)seq * 15 * 1024 + c;
    f32x4 xs[W + 7];
#pragma unroll
    for (int j = 0; j < W + 7; ++j) { const int t = t0 - (W - 1) + j; const bool hist = smp && t < 0; const bool ok = t >= 0 || hist;
        f32x4 v;
        if (hist) v = *(const f32x4*)(spool + (size_t)(15 + t) * 1024);
        else { const u32x2 w = *(const u32x2*)(proj2 + (size_t)(rowbase + (t >= 0 ? t : 0)) * DM + c); v = (f32x4){bf_lo(w.x), bf_hi(w.x), bf_lo(w.y), bf_hi(w.y)}; }
        xs[j] = ok ? v : (f32x4){0.f, 0.f, 0.f, 0.f}; }
    f32x4 Wd = xs[0];
#pragma unroll
    for (int j = 1; j < W; ++j) Wd = Wd + xs[j];
#pragma unroll
    for (int u = 0; u < 8; ++u) { const int t = t0 + u; const f32x4 x = xs[u + W - 1];
        const float cnt = smp ? (float)W : (float)((t + 1) < W ? (t + 1) : W); const f32x4 dl = Wd * (1.0f / cnt) - x;
        u32x2 o; o.x = cvt_pk_bf16(dl[0], dl[1]); o.y = cvt_pk_bf16(dl[2], dl[3]); *(u32x2*)(delta + (size_t)(row0 + u) * YLD + c) = o;
        if (!smp && t >= 4081) *(f32x4*)(p.out + O_POOL_P + ((size_t)seq * 15 + (t - 4081)) * 1024 + c) = x;
        if (smp && t >= 17) *(f32x4*)(p.out + O_POOL_S + ((size_t)seq * 15 + (t - 17)) * 1024 + c) = x;
        if (u < 7) Wd = Wd + xs[u + W] - xs[u]; }
}
__device__ __forceinline__ void phase_pool(const Params& p) {
    const bf16_t* proj2 = (const bf16_t*)(p.ws + OFF_PROJ2); bf16_t* delta = (bf16_t*)(p.ws + OFF_DELTA);
    for (int idx = blockIdx.x * 512 + threadIdx.x; idx < (T / 8) * 256; idx += gridDim.x * 512) {
        const int r8 = idx >> 8, c = (idx & 255) * 4, g = c >> 8;
        if (g == 0) pool_item<2>(p, proj2, delta, r8, c); else if (g == 1) pool_item<4>(p, proj2, delta, r8, c);
        else if (g == 2) pool_item<8>(p, proj2, delta, r8, c); else pool_item<16>(p, proj2, delta, r8, c);
    }
}

template <int PASS>
__device__ __forceinline__ void phase_s5(const Params& p, LAS unsigned char* lds, int nitems) {
    const int tid = threadIdx.x, wid = tid >> 6, lane = tid & 63, hcol = lane & 15, q4 = lane >> 4;
    const float* proj2 = (const float*)(p.ws + OFF_PROJ2); float* Eb = (float*)(p.ws + OFF_E); bf16_t* yb = (bf16_t*)(p.ws + OFF_YB);
    LAS float* ut = (LAS float*)lds;
    constexpr int SROW = 272;
    LAS unsigned char* sb = lds + 32768 + wid * 32 * SROW;
    int oct_cur = -1;
    float lbr = 0.f, lbi = 0.f, p64r = 0.f, p64i = 0.f, dsk = 0.f; f32x2 bb[16]; bf16x8 Bc[4];
#pragma unroll
    for (int i = 0; i < 16; ++i) bb[i] = (f32x2){0.f, 0.f};
#pragma unroll
    for (int i = 0; i < 4; ++i) Bc[i] = (bf16x8){0, 0, 0, 0, 0, 0, 0, 0};
    f32x4 un[4];
    auto issue_u = [&](int item) {
        const int cs = item >> 3, oct = item & 7; const bool smp = cs >= 128;
        const int b = smp ? cs - 128 : cs >> 6, ch = smp ? 0 : cs & 63, L = smp ? 32 : 64, row0 = smp ? TP + b * 32 : b * 4096 + ch * 64;
#pragma unroll
        for (int k = 0; k < 4; ++k) { const int i = tid + k * 512; un[k] = (f32x4){0.f, 0.f, 0.f, 0.f}; if (i < L * 32) un[k] = *(const f32x4*)(proj2 + (size_t)(row0 + (i >> 5)) * DM + 1024 + oct * 128 + (i & 31) * 4); }
    };
    if ((int)blockIdx.x < nitems) issue_u((int)blockIdx.x);
    for (int item = blockIdx.x; item < nitems; item += gridDim.x) {
        const int cs = item >> 3, oct = item & 7, g = oct * 8 + wid; const bool smp = cs >= 128;
        const int b = smp ? cs - 128 : cs >> 6, ch = smp ? 0 : cs & 63, L = smp ? 32 : 64, row0 = smp ? TP + b * 32 : b * 4096 + ch * 64;
#pragma unroll
        for (int k = 0; k < 4; ++k) { const int i = tid + k * 512; if (i < L * 32) *(LAS f32x4*)(ut + (i >> 5) * 128 + (i & 31) * 4) = un[k]; }
        if (item + (int)gridDim.x < nitems) issue_u(item + (int)gridDim.x);
        if (oct != oct_cur) {
            oct_cur = oct;
            const float are = p.in[22][g * 64 + lane], aim = p.in[23][g * 64 + lane], dt = __expf(p.in[24][g]);
            const float er = __expf(are * dt); float rev = aim * dt * 0.15915494309189535f; rev -= floorf(rev);
            lbr = er * __builtin_amdgcn_cosf(rev); lbi = er * __builtin_amdgcn_sinf(rev);
            const float den = 1.0f / (are * are + aim * aim); const float nr = lbr - 1.0f, ni = lbi;
            const float cr = (nr * are + ni * aim) * den, ci = (ni * are - nr * aim) * den;
            const float* br = p.in[25] + ((size_t)g * 64 + lane) * 16; const float* bi = p.in[26] + ((size_t)g * 64 + lane) * 16;
#pragma unroll
            for (int q = 0; q < 4; ++q) { const f32x4 x = *(const f32x4*)(br + q * 4), y = *(const f32x4*)(bi + q * 4);
#pragma unroll
                for (int e = 0; e < 4; ++e) bb[q * 4 + e] = (f32x2){cr * x[e] - ci * y[e], cr * y[e] + ci * x[e]}; }
            if (PASS == 2) {
                p64r = lbr; p64i = lbi;
#pragma unroll
                for (int q = 0; q < 6; ++q) { const float t = p64r * p64r - p64i * p64i; p64i = 2.f * p64r * p64i; p64r = t; }
#pragma unroll
                for (int ks = 0; ks < 4; ++ks) { const float* src = (ks < 2 ? p.in[27] : p.in[28]) + ((size_t)g * 16 + hcol) * 64 + (ks & 1) * 32 + q4 * 8; const float sg = ks < 2 ? 1.f : -1.f;
                    const f32x4 x = *(const f32x4*)src, y = *(const f32x4*)(src + 4); u32x4 w; w.x = cvt_pk_bf16(sg * x[0], sg * x[1]); w.y = cvt_pk_bf16(sg * x[2], sg * x[3]); w.z = cvt_pk_bf16(sg * y[0], sg * y[1]); w.w = cvt_pk_bf16(sg * y[2], sg * y[3]);
                    Bc[ks] = __builtin_bit_cast(bf16x8, w); }
                dsk = p.in[29][g * 16 + hcol]; }
        }
        float sr = 0.f, si = 0.f;
        if (PASS == 2) {
            if (smp) { sr = p.in[4][((size_t)b * 64 + g) * 64 + lane]; si = p.in[5][((size_t)b * 64 + g) * 64 + lane]; }
            else { const float* e0 = Eb + (((size_t)b * 64) * 64 + g) * 128 + lane * 2;
                for (int j0 = 0; j0 < ch; j0 += 16) { f32x2 ev[16];
#pragma unroll
                    for (int jj = 0; jj < 16; ++jj) { const int j = (j0 + jj) < ch ? (j0 + jj) : (ch - 1); ev[jj] = *(const f32x2*)(e0 + (size_t)j * 64 * 128); }
#pragma unroll
                    for (int jj = 0; jj < 16; ++jj) { const bool on = (j0 + jj) < ch; const float t = p64r * sr - p64i * si + ev[jj].x, u2 = p64r * si + p64i * sr + ev[jj].y; sr = on ? t : sr; si = on ? u2 : si; } } }
        }
        __syncthreads();
        for (int sub = 0; sub < L; sub += 32) {
#pragma unroll 2
            for (int tt = 0; tt < 32; ++tt) { const int t = sub + tt; f32x2 bu0 = (f32x2){0.f, 0.f}, bu1 = (f32x2){0.f, 0.f};
#pragma unroll
                for (int q = 0; q < 4; ++q) { const f32x4 u = *(const LAS f32x4*)(ut + t * 128 + wid * 16 + q * 4);
                    bu0 = bu0 + bb[q * 4] * u[0]; bu1 = bu1 + bb[q * 4 + 1] * u[1]; bu0 = bu0 + bb[q * 4 + 2] * u[2]; bu1 = bu1 + bb[q * 4 + 3] * u[3]; }
                const float bur = bu0[0] + bu1[0], bui = bu0[1] + bu1[1];
                const float nr2 = lbr * sr - lbi * si + bur; si = lbr * si + lbi * sr + bui; sr = nr2;
                if (PASS == 2) { *(LAS bf16_t*)(sb + tt * SROW + lane * 2) = (bf16_t)(cvt_pk_bf16(sr, 0.f) & 0xffffu); *(LAS bf16_t*)(sb + tt * SROW + 128 + lane * 2) = (bf16_t)(cvt_pk_bf16(si, 0.f) & 0xffffu); } }
            if (PASS == 2) {
                __syncthreads();
#pragma unroll
                for (int mt = 0; mt < 2; ++mt) { f32x4 acc = (f32x4){0.f, 0.f, 0.f, 0.f};
#pragma unroll
                    for (int ks = 0; ks < 4; ++ks) { const bf16x8 a = *(const LAS bf16x8*)(sb + (mt * 16 + hcol) * SROW + ks * 64 + q4 * 16); acc = __builtin_amdgcn_mfma_f32_16x16x32_bf16(a, Bc[ks], acc, 0, 0, 0); }
#pragma unroll
                    for (int j = 0; j < 4; ++j) { const int t = sub + mt * 16 + q4 * 4 + j; const float y = acc[j] + dsk * ut[t * 128 + wid * 16 + hcol];
                        yb[(size_t)(row0 + t) * YLD + g * 16 + hcol] = (bf16_t)(cvt_pk_bf16(gelu_t(y), 0.f) & 0xffffu); } }
                __syncthreads();
            }
        }
        if (PASS == 1) { *(f32x2*)(Eb + ((((size_t)b * 64 + ch) * 64) + g) * 128 + lane * 2) = (f32x2){sr, si}; }
        else { if (smp) { p.out[O_S5RE_S + ((size_t)b * 64 + g) * 64 + lane] = sr; p.out[O_S5IM_S + ((size_t)b * 64 + g) * 64 + lane] = si; }
               else if (ch == 63) { p.out[O_S5RE_P + ((size_t)b * 64 + g) * 64 + lane] = sr; p.out[O_S5IM_P + ((size_t)b * 64 + g) * 64 + lane] = si; } }
        __syncthreads();
    }
}


__device__ __forceinline__ void phase_s5_ends(const Params& p, LAS unsigned char* lds, int nitems) {
    const int tid = threadIdx.x, wid = tid >> 6, lane = tid & 63, l31 = lane & 31, hh = lane >> 5;
    const bf16_t* proj2 = (const bf16_t*)(p.ws + OFF_PROJ2); float* Eb = (float*)(p.ws + OFF_E);
    constexpr int UROW = 272;
    int oct_cur = -1;
    float lr[2] = {0.f, 0.f}, li[2] = {0.f, 0.f}, l4r[2] = {0.f, 0.f}, l4i[2] = {0.f, 0.f}; bf16x8 Bre[2], Bim[2];
#pragma unroll
    for (int i = 0; i < 2; ++i) { Bre[i] = (bf16x8){0, 0, 0, 0, 0, 0, 0, 0}; Bim[i] = Bre[i]; }
    for (int item = blockIdx.x; item < nitems; item += gridDim.x) {
        const int cs = item >> 3, oct = item & 7, g = oct * 8 + wid, b = cs >> 6, ch = cs & 63, row0 = b * 4096 + ch * 64;
#pragma unroll
        for (int k = 0; k < 4; ++k) { const int i = tid + k * 512, t = i >> 5, q = i & 31; const u32x2 w = *(const u32x2*)(proj2 + (size_t)(row0 + t) * DM + 1024 + oct * 128 + q * 4);
            *(LAS u32x2*)(lds + t * UROW + q * 8) = w; }
        if (oct != oct_cur) { oct_cur = oct;
            const float dt = __expf(p.in[24][g]);
#pragma unroll
            for (int sx = 0; sx < 2; ++sx) { const int st = l31 + 32 * sx;
                const float are = p.in[22][g * 64 + st], aim = p.in[23][g * 64 + st];
                const float er = __expf(are * dt); float rev = aim * dt * 0.15915494309189535f; rev -= floorf(rev);
                lr[sx] = er * __builtin_amdgcn_cosf(rev); li[sx] = er * __builtin_amdgcn_sinf(rev);
                const float den = 1.0f / (are * are + aim * aim); const float nr = lr[sx] - 1.0f, ni = li[sx];
                const float cr = (nr * are + ni * aim) * den, ci = (ni * are - nr * aim) * den;
                const float* br = p.in[25] + ((size_t)g * 64 + st) * 16 + hh * 8; const float* bi = p.in[26] + ((size_t)g * 64 + st) * 16 + hh * 8;
                const f32x4 x0 = *(const f32x4*)br, x1 = *(const f32x4*)(br + 4), y0 = *(const f32x4*)bi, y1 = *(const f32x4*)(bi + 4);
                u32x4 wr, wi;
                wr.x = cvt_pk_bf16(cr * x0[0] - ci * y0[0], cr * x0[1] - ci * y0[1]); wr.y = cvt_pk_bf16(cr * x0[2] - ci * y0[2], cr * x0[3] - ci * y0[3]);
                wr.z = cvt_pk_bf16(cr * x1[0] - ci * y1[0], cr * x1[1] - ci * y1[1]); wr.w = cvt_pk_bf16(cr * x1[2] - ci * y1[2], cr * x1[3] - ci * y1[3]);
                wi.x = cvt_pk_bf16(cr * y0[0] + ci * x0[0], cr * y0[1] + ci * x0[1]); wi.y = cvt_pk_bf16(cr * y0[2] + ci * x0[2], cr * y0[3] + ci * x0[3]);
                wi.z = cvt_pk_bf16(cr * y1[0] + ci * x1[0], cr * y1[1] + ci * x1[1]); wi.w = cvt_pk_bf16(cr * y1[2] + ci * x1[2], cr * y1[3] + ci * x1[3]);
                Bre[sx] = __builtin_bit_cast(bf16x8, wr); Bim[sx] = __builtin_bit_cast(bf16x8, wi);
                const float t2r = lr[sx] * lr[sx] - li[sx] * li[sx], t2i = 2.f * lr[sx] * li[sx]; l4r[sx] = t2r * t2r - t2i * t2i; l4i[sx] = 2.f * t2r * t2i; } }
        __syncthreads();
        float sr[2] = {0.f, 0.f}, si[2] = {0.f, 0.f};
#pragma unroll
        for (int sub = 0; sub < 2; ++sub) {
            const bf16x8 a = *(const LAS bf16x8*)(lds + (sub * 32 + l31) * UROW + (wid * 16 + hh * 8) * 2);
            f32x16 z;
#pragma unroll
            for (int r = 0; r < 16; ++r) z[r] = 0.f;
#pragma unroll
            for (int sx = 0; sx < 2; ++sx) { const f32x16 ar = __builtin_amdgcn_mfma_f32_32x32x16_bf16(a, Bre[sx], z, 0, 0, 0), ai = __builtin_amdgcn_mfma_f32_32x32x16_bf16(a, Bim[sx], z, 0, 0, 0);
#pragma unroll
                for (int ag = 0; ag < 4; ++ag) {
#pragma unroll
                    for (int bq = 0; bq < 4; ++bq) { const float t = lr[sx] * sr[sx] - li[sx] * si[sx] + ar[ag * 4 + bq]; si[sx] = lr[sx] * si[sx] + li[sx] * sr[sx] + ai[ag * 4 + bq]; sr[sx] = t; }
                    if (!(sub == 1 && ag == 3)) { const float t = l4r[sx] * sr[sx] - l4i[sx] * si[sx]; si[sx] = l4r[sx] * si[sx] + l4i[sx] * sr[sx]; sr[sx] = t; } } }
        }
#pragma unroll
        for (int sx = 0; sx < 2; ++sx) { if (hh == 0) { const float t = l4r[sx] * sr[sx] - l4i[sx] * si[sx]; si[sx] = l4r[sx] * si[sx] + l4i[sx] * sr[sx]; sr[sx] = t; }
            const float tr = sr[sx] + __shfl_xor(sr[sx], 32), ti = si[sx] + __shfl_xor(si[sx], 32);
            if (hh == 0) *(f32x2*)(Eb + ((((size_t)b * 64 + ch) * 64) + g) * 128 + (l31 + 32 * sx) * 2) = (f32x2){tr, ti}; }
        __syncthreads();
    }
}

__device__ __forceinline__ void phase_s5_out(const Params& p, LAS unsigned char* lds, int nitems) {
    const int tid = threadIdx.x, wid = tid >> 6, lane = tid & 63, l31 = lane & 31, hh = lane >> 5, hcol = lane & 15, q4 = lane >> 4;
    const bf16_t* proj2 = (const bf16_t*)(p.ws + OFF_PROJ2); const float* Eb = (const float*)(p.ws + OFF_E); bf16_t* yb = (bf16_t*)(p.ws + OFF_YB);
    constexpr int UROW = 272, SROW = 272;
    LAS unsigned char* sb = lds + 64 * UROW + wid * 32 * SROW;
    int oct_cur = -1;
    float lr[2] = {0.f, 0.f}, li[2] = {0.f, 0.f}, p64r[2] = {0.f, 0.f}, p64i[2] = {0.f, 0.f}; f32x4 dsk4 = (f32x4){0.f, 0.f, 0.f, 0.f}; bf16x8 Bre[2], Bim[2], Bc[4];
#pragma unroll
    for (int i = 0; i < 2; ++i) { Bre[i] = (bf16x8){0, 0, 0, 0, 0, 0, 0, 0}; Bim[i] = Bre[i]; }
#pragma unroll
    for (int i = 0; i < 4; ++i) Bc[i] = (bf16x8){0, 0, 0, 0, 0, 0, 0, 0};
    for (int item = blockIdx.x; item < nitems; item += gridDim.x) {
        const int cs = item >> 3, oct = item & 7, g = oct * 8 + wid; const bool smp = cs >= 128;
        const int b = smp ? cs - 128 : cs >> 6, ch = smp ? 0 : cs & 63, L = smp ? 32 : 64, row0 = smp ? TP + b * 32 : b * 4096 + ch * 64;
#pragma unroll
        for (int k = 0; k < 4; ++k) { const int i = tid + k * 512, t = i >> 5, q = i & 31; if (i < L * 32) { const u32x2 w = *(const u32x2*)(proj2 + (size_t)(row0 + t) * DM + 1024 + oct * 128 + q * 4);
            *(LAS u32x2*)(lds + t * UROW + q * 8) = w; } }
        if (oct != oct_cur) { oct_cur = oct;
            const float dt = __expf(p.in[24][g]);
#pragma unroll
            for (int sx = 0; sx < 2; ++sx) { const int st = l31 + 32 * sx;
                const float are = p.in[22][g * 64 + st], aim = p.in[23][g * 64 + st];
                const float er = __expf(are * dt); float rev = aim * dt * 0.15915494309189535f; rev -= floorf(rev);
                lr[sx] = er * __builtin_amdgcn_cosf(rev); li[sx] = er * __builtin_amdgcn_sinf(rev);
                const float den = 1.0f / (are * are + aim * aim); const float nr = lr[sx] - 1.0f, ni = li[sx];
                const float cr = (nr * are + ni * aim) * den, ci = (ni * are - nr * aim) * den;
                const float* br = p.in[25] + ((size_t)g * 64 + st) * 16 + hh * 8; const float* bi = p.in[26] + ((size_t)g * 64 + st) * 16 + hh * 8;
                const f32x4 x0 = *(const f32x4*)br, x1 = *(const f32x4*)(br + 4), y0 = *(const f32x4*)bi, y1 = *(const f32x4*)(bi + 4);
                u32x4 wr, wi;
                wr.x = cvt_pk_bf16(cr * x0[0] - ci * y0[0], cr * x0[1] - ci * y0[1]); wr.y = cvt_pk_bf16(cr * x0[2] - ci * y0[2], cr * x0[3] - ci * y0[3]);
                wr.z = cvt_pk_bf16(cr * x1[0] - ci * y1[0], cr * x1[1] - ci * y1[1]); wr.w = cvt_pk_bf16(cr * x1[2] - ci * y1[2], cr * x1[3] - ci * y1[3]);
                wi.x = cvt_pk_bf16(cr * y0[0] + ci * x0[0], cr * y0[1] + ci * x0[1]); wi.y = cvt_pk_bf16(cr * y0[2] + ci * x0[2], cr * y0[3] + ci * x0[3]);
                wi.z = cvt_pk_bf16(cr * y1[0] + ci * x1[0], cr * y1[1] + ci * x1[1]); wi.w = cvt_pk_bf16(cr * y1[2] + ci * x1[2], cr * y1[3] + ci * x1[3]);
                Bre[sx] = __builtin_bit_cast(bf16x8, wr); Bim[sx] = __builtin_bit_cast(bf16x8, wi);
                float pr = lr[sx], pi = li[sx];
#pragma unroll
                for (int q = 0; q < 6; ++q) { const float t = pr * pr - pi * pi; pi = 2.f * pr * pi; pr = t; }
                p64r[sx] = pr; p64i[sx] = pi; }
#pragma unroll
            for (int ks = 0; ks < 4; ++ks) { const float* src = (ks < 2 ? p.in[27] : p.in[28]) + ((size_t)g * 16 + hcol) * 64 + (ks & 1) * 32 + q4 * 8; const float sg = ks < 2 ? 1.f : -1.f;
                const f32x4 x = *(const f32x4*)src, y = *(const f32x4*)(src + 4); u32x4 w; w.x = cvt_pk_bf16(sg * x[0], sg * x[1]); w.y = cvt_pk_bf16(sg * x[2], sg * x[3]); w.z = cvt_pk_bf16(sg * y[0], sg * y[1]); w.w = cvt_pk_bf16(sg * y[2], sg * y[3]);
                Bc[ks] = __builtin_bit_cast(bf16x8, w); }
            dsk4 = *(const f32x4*)(p.in[29] + g * 16 + q4 * 4); }
        float sr[2] = {0.f, 0.f}, si[2] = {0.f, 0.f};
        if (smp) {
#pragma unroll
            for (int sx = 0; sx < 2; ++sx) { const int st = l31 + 32 * sx; sr[sx] = p.in[4][((size_t)b * 64 + g) * 64 + st]; si[sx] = p.in[5][((size_t)b * 64 + g) * 64 + st]; }
        } else { const float* e0 = Eb + (((size_t)b * 64) * 64 + g) * 128 + l31 * 2;
            for (int j0 = 0; j0 < ch; j0 += 16) { f32x2 ev[2][16];
#pragma unroll
                for (int jj = 0; jj < 16; ++jj) { const int j = (j0 + jj) < ch ? (j0 + jj) : (ch - 1); ev[0][jj] = *(const f32x2*)(e0 + (size_t)j * 64 * 128); ev[1][jj] = *(const f32x2*)(e0 + (size_t)j * 64 * 128 + 64); }
#pragma unroll
                for (int jj = 0; jj < 16; ++jj) { const bool on = (j0 + jj) < ch;
#pragma unroll
                    for (int sx = 0; sx < 2; ++sx) { const float t = p64r[sx] * sr[sx] - p64i[sx] * si[sx] + ev[sx][jj].x, u2 = p64r[sx] * si[sx] + p64i[sx] * sr[sx] + ev[sx][jj].y; sr[sx] = on ? t : sr[sx]; si[sx] = on ? u2 : si[sx]; } } } }
        __syncthreads();
        for (int sub = 0; sub < L; sub += 32) {
            const bf16x8 a = *(const LAS bf16x8*)(lds + (sub + l31) * UROW + (wid * 16 + hh * 8) * 2);
            f32x16 z;
#pragma unroll
            for (int r = 0; r < 16; ++r) z[r] = 0.f;
#pragma unroll
            for (int sx = 0; sx < 2; ++sx) {
                const f32x16 ar = __builtin_amdgcn_mfma_f32_32x32x16_bf16(a, Bre[sx], z, 0, 0, 0), ai = __builtin_amdgcn_mfma_f32_32x32x16_bf16(a, Bim[sx], z, 0, 0, 0);
                const float lrs = lr[sx], lis = li[sx]; float s_r = sr[sx], s_i = si[sx];
#pragma unroll
                for (int ag = 0; ag < 4; ++ag) {
                    float c1r[4], c1i[4], c2r[4], c2i[4]; float tr = s_r, ti = s_i;
#pragma unroll
                    for (int bq = 0; bq < 4; ++bq) { const float t = lrs * tr - lis * ti + ar[ag * 4 + bq]; ti = lrs * ti + lis * tr + ai[ag * 4 + bq]; tr = t; c1r[bq] = tr; c1i[bq] = ti; }
                    float xr = __shfl_xor(tr, 32), xi = __shfl_xor(ti, 32);
#pragma unroll
                    for (int bq = 0; bq < 4; ++bq) { const float t = lrs * xr - lis * xi + ar[ag * 4 + bq]; xi = lrs * xi + lis * xr + ai[ag * 4 + bq]; xr = t; c2r[bq] = xr; c2i[bq] = xi; }
                    s_r = __shfl_xor(xr, 32); s_i = __shfl_xor(xi, 32);
#pragma unroll
                    for (int bq = 0; bq < 4; ++bq) { const int tt = ag * 8 + hh * 4 + bq; const float vr = hh ? c2r[bq] : c1r[bq], vi = hh ? c2i[bq] : c1i[bq];
                        *(LAS bf16_t*)(sb + tt * SROW + (l31 + 32 * sx) * 2) = (bf16_t)(cvt_pk_bf16(vr, 0.f) & 0xffffu); *(LAS bf16_t*)(sb + tt * SROW + 128 + (l31 + 32 * sx) * 2) = (bf16_t)(cvt_pk_bf16(vi, 0.f) & 0xffffu); }
                }
                sr[sx] = s_r; si[sx] = s_i; __builtin_amdgcn_sched_barrier(0); }
            __syncthreads();
#pragma unroll
            for (int mt = 0; mt < 2; ++mt) { f32x4 acc = (f32x4){0.f, 0.f, 0.f, 0.f};
#pragma unroll
                for (int ks = 0; ks < 4; ++ks) { const bf16x8 af = *(const LAS bf16x8*)(sb + (mt * 16 + hcol) * SROW + ks * 64 + q4 * 16); acc = __builtin_amdgcn_mfma_f32_16x16x32_bf16(Bc[ks], af, acc, 0, 0, 0); }
                const int t = sub + mt * 16 + hcol; const u32x2 uw = *(const LAS u32x2*)(lds + t * UROW + (wid * 16 + q4 * 4) * 2);
                const float y0 = acc[0] + dsk4[0] * bf_lo(uw.x), y1 = acc[1] + dsk4[1] * bf_hi(uw.x), y2 = acc[2] + dsk4[2] * bf_lo(uw.y), y3 = acc[3] + dsk4[3] * bf_hi(uw.y);
                u32x2 w; w.x = cvt_pk_bf16(gelu_t(y0), gelu_t(y1)); w.y = cvt_pk_bf16(gelu_t(y2), gelu_t(y3));
                *(u32x2*)(yb + (size_t)(row0 + t) * YLD + g * 16 + q4 * 4) = w; }
            __syncthreads();
        }
        if (hh == 0 && (smp || ch == 63)) { float* ore = p.out + (smp ? O_S5RE_S : O_S5RE_P) + ((size_t)b * 64 + g) * 64; float* oim = p.out + (smp ? O_S5IM_S : O_S5IM_P) + ((size_t)b * 64 + g) * 64;
#pragma unroll
            for (int sx = 0; sx < 2; ++sx) { ore[l31 + 32 * sx] = sr[sx]; oim[l31 + 32 * sx] = si[sx]; } }
        __syncthreads();
    }
}

#define XB_TMO      128
#define XB_XCNT(j)  (256  + 64 * (j))
#define XB_XSUB(j)  (1280 + 64 * (j))
#define XB_XGEN(j)  (2304 + 64 * (j))
#define XB_TOP      3328
#define XB_TOPGEN   3392
#define XCD_BAR_WORDS 3456
#define XB_SPIN_CAP (1u << 20)
__device__ __forceinline__ unsigned xb_ld(unsigned* p)              { return __hip_atomic_load(p, __ATOMIC_RELAXED, __HIP_MEMORY_SCOPE_AGENT); }
__device__ __forceinline__ unsigned xb_add(unsigned* p, unsigned v) { return __hip_atomic_fetch_add(p, v, __ATOMIC_RELAXED, __HIP_MEMORY_SCOPE_AGENT); }
__device__ __forceinline__ unsigned xb_xcc_id() { return (unsigned)__builtin_amdgcn_s_getreg((3 << 11) | 20) & 0xFu; }
#define XB_SPIN(cond, bar) do { unsigned _sp = 0; while (cond) { __builtin_amdgcn_s_sleep(1); \
    if ((++_sp & 255u) == 0u) { if (xb_ld(&(bar)[XB_TMO])) break; if (_sp > XB_SPIN_CAP) { atomicAdd(&(bar)[XB_TMO], 1u); break; } } } } while (0)
struct XcdBarrier { unsigned* bar; unsigned x; volatile LAS unsigned* st; };
__device__ __forceinline__ XcdBarrier xcd_barrier_post(unsigned* bar, volatile LAS unsigned* st) {
    XcdBarrier b; b.bar = bar; b.x = xb_xcc_id(); b.st = st;
    if (threadIdx.x == 0) (void)xb_add(&bar[XB_XCNT(b.x)], 1u);
    return b;
}
__device__ __forceinline__ void xcd_barrier_complete(unsigned* bar, unsigned x, unsigned& nloc, unsigned& nx) {
    const unsigned G = gridDim.x * gridDim.y * gridDim.z;
    unsigned sum, cnt, mine, sp = 0u;
    for (;;) {
        sum = 0u; cnt = 0u; mine = 0u;
#pragma unroll
        for (unsigned j = 0; j < 16; ++j) { const unsigned c = xb_ld(&bar[XB_XCNT(j)]); sum += c; cnt += (c > 0u) ? 1u : 0u; mine = (j == x) ? c : mine; }
        if (sum == G) break;
        __builtin_amdgcn_s_sleep(1);
        if ((++sp & 255u) == 0u) { if (xb_ld(&bar[XB_TMO])) break; if (sp > XB_SPIN_CAP) { atomicAdd(&bar[XB_TMO], 1u); break; } }
    }
    nloc = mine > 0u ? mine : 1u; nx = cnt > 0u ? cnt : 1u;
}
__device__ __forceinline__ void xcd_barrier(const XcdBarrier& b) {
    asm volatile("s_waitcnt vmcnt(0)" ::: "memory");
    __syncthreads();
    if (threadIdx.x == 0) {
        unsigned* bar = b.bar;
        __builtin_amdgcn_s_waitcnt(0);
        unsigned nloc = b.st[0], nx = b.st[1];
        if (nloc == 0u) { xcd_barrier_complete(bar, b.x, nloc, nx); b.st[0] = nloc; b.st[1] = nx; }
        const unsigned old = xb_add(&bar[XB_XSUB(b.x)], 1u);
        const unsigned gen = old / nloc;
        if (old + 1u == (gen + 1u) * nloc) {
            __builtin_amdgcn_fence(__ATOMIC_RELEASE, "agent");
            asm volatile("s_waitcnt vmcnt(0)" ::: "memory");
            const unsigned og = xb_add(&bar[XB_TOP], 1u);
            const unsigned tg = og / nx;
            if (og + 1u == (tg + 1u) * nx) xb_add(&bar[XB_TOPGEN], 1u);
            else XB_SPIN(xb_ld(&bar[XB_TOPGEN]) == tg, bar);
            __builtin_amdgcn_fence(__ATOMIC_ACQUIRE, "agent");
            xb_add(&bar[XB_XGEN(b.x)], 1u);
            asm volatile("s_waitcnt vmcnt(0)" ::: "memory");
        } else {
            XB_SPIN(xb_ld(&bar[XB_XGEN(b.x)]) == gen, bar);
            __builtin_amdgcn_fence(__ATOMIC_ACQUIRE, "agent");
            asm volatile("s_waitcnt vmcnt(0)" ::: "memory");
        }
    }
    __syncthreads();
}

__device__ __forceinline__ void run_phase(const Params& p, LAS unsigned char* lds, const int ph, const int vb) {
#ifdef ONLY_PH
    if (ph != ONLY_PH) return;
#endif
    unsigned char* ws = p.ws; const int nb = gridDim.x;
    switch (ph) {
    case 0: phase_prep(p, lds); break;
    case 1: { pg8::EpiBf16<1> E; E.O = (bf16_t*)(ws + OFF_PROJ); E.ldc = NE; E.gelu_tiles = 8; E.scale = nullptr; E.slab = 0;
              run_gemm(lds, (const bf16_t*)(ws + OFF_H), (const bf16_t*)(ws + OFF_WIN_E), NE, DM, HLD, HLD, 0, E, vb);
              phase_glr(p, vb);
              if (nb == 256 && vb >= 208) prep_run<1>(p, lds, vb - 208, 48, NL1); } break;
    case 2: { for (int it = blockIdx.x; it < 640; it += nb) { if (it < 512) glau_item<64>(p, lds, it); else glau_item<32>(p, lds, it); }
              for (int it = nb - 1 - (int)blockIdx.x; it < 384; it += nb) { if (it < 256) amix_item<128>(p, lds, it); else amix_item<32>(p, lds, it); } } break;
    case 3: phase_gla_scan(p); break;
    case 4: for (int it = blockIdx.x; it < 640; it += nb) { if (it < 512) glao_item<64>(p, lds, it); else glao_item<32>(p, lds, it); } break;
    case 5: case 15: { pg8::EpiBf16<1> E; E.O = (bf16_t*)(ws + OFF_M); E.ldc = DM; E.gelu_tiles = 0; E.scale = nullptr; E.slab = 0;
              const bf16_t* W = (const bf16_t*)(ws + (ph == 5 ? OFF_WOUT_E : OFF_WOUT_O));
              run_gemm(lds, (const bf16_t*)(ws + OFF_MIX), W, DM, DM, HLD, HLD, 0, E, vb, TP);
              run_gemm_split(lds, (const bf16_t*)(ws + OFF_MIX), W, DM, HLD, 8, (bf16_t*)(ws + OFF_SLAB_A), vb); } break;
    case 6: phase_norm(p, true, nullptr, p.in[8], p.in[9], (const bf16_t*)(ws + OFF_SLAB_A), 8); break;
    case 7: case 17: { const int layer = ph == 7 ? 0 : 1; pg8::EpiGateVal E; E.ACT = (bf16_t*)(ws + OFF_VAL); E.GF = (bf16_t*)(ws + OFF_GF); E.VF = (bf16_t*)(ws + OFF_VF); E.GL = (bf16_t*)(ws + OFF_GL);
              E.ffn_p = p.out + O_FFN_P + (size_t)layer * 2 * 2 * DFF; E.ffn_s = p.out + O_FFN_S + (size_t)layer * 32 * 2 * DFF;
              E.cw = p.in[33] + (size_t)layer * 3 * DFF; E.cb = p.in[34] + (size_t)layer * DFF;
              run_gemm(lds, (const bf16_t*)(ws + OFF_H), (const bf16_t*)(ws + (layer ? OFF_WUP1 : OFF_WUP0)), 2 * DFF, DM, HLD, HLD, 0, E, vb);
              if (nb == 256 && vb >= 48) { if (layer == 0) prep_run<2>(p, lds, vb - 48, 208, NL2); else prep_run<5>(p, lds, vb - 48, 208, NL5); } } break;
    case 8: phase_convfix(p, 0); break;
    case 18: phase_convfix(p, 1); break;
    case 9: case 19: { pg8::EpiBf16<1> E; E.O = (bf16_t*)(ws + OFF_M); E.ldc = DM; E.gelu_tiles = 0; E.scale = nullptr; E.slab = 0;
              const bf16_t* W = (const bf16_t*)(ws + (ph == 9 ? OFF_WDN0 : OFF_WDN1));
              run_gemm(lds, (const bf16_t*)(ws + OFF_VAL), W, DM, DFF, ALD, ALD, 0, E, vb, TP);
              run_gemm_split(lds, (const bf16_t*)(ws + OFF_VAL), W, DFF, ALD, 4, (bf16_t*)(ws + OFF_SLAB_B), vb);
              if (ph == 9 && nb == 256 && vb >= 128) prep_run<3>(p, lds, vb - 128, 128, NL3); } break;
    case 10: phase_norm(p, false, nullptr, p.in[10], p.in[7] + DM, (const bf16_t*)(ws + OFF_SLAB_B), 4); break;
    case 11: { pg8::EpiBf16<1> E; E.O = (bf16_t*)(ws + OFF_PROJ2); E.ldc = DM; E.gelu_tiles = 0; E.scale = nullptr; E.slab = 0;
              run_gemm(lds, (const bf16_t*)(ws + OFF_H), (const bf16_t*)(ws + OFF_WIN_O), DM, DM, HLD, HLD, 0, E, vb);
              if (nb == 256 && vb >= 32) prep_run<4>(p, lds, vb - 32, 224, NL4); } break;
    case 12: { phase_pool(p); phase_s5_ends(p, lds, 1024); } break;
    case 13: phase_s5_out(p, lds, 1280); break;
    case 14: { pg8::EpiGlu E; E.O = (bf16_t*)(ws + OFF_MIX) + 1024; E.ldc = HLD;
              run_gemm(lds, (const bf16_t*)(ws + OFF_YB), (const bf16_t*)(ws + OFF_WGLU), 2048, 1024, YLD, YLD, 0, E, vb); }
             { pg8::EpiBf16<1> E2; E2.O = (bf16_t*)(ws + OFF_MIX); E2.ldc = HLD; E2.gelu_tiles = 0; E2.scale = nullptr; E2.slab = 0;
              run_gemm(lds, (const bf16_t*)(ws + OFF_DELTA), (const bf16_t*)(ws + OFF_CMAP), 1024, 256, YLD, CLD, 256, E2, vb, T, nb >= 64 ? 32 : 0); } break;
    case 16: phase_norm(p, false, nullptr, p.in[8] + DM, p.in[9] + DM, (const bf16_t*)(ws + OFF_SLAB_A), 8); break;
    case 20: phase_norm(p, false, p.out + O_Y, p.in[10] + DM, nullptr, (const bf16_t*)(ws + OFF_SLAB_B), 4); break;
    default: break;
    }
}

__global__ void __launch_bounds__(512, 2) fwd_megakernel(Params p) {
    extern __shared__ __attribute__((aligned(16))) unsigned char shm[];
    LAS unsigned char* lds = (LAS unsigned char*)shm;
    cg::grid_group grid = cg::this_grid();
    volatile LAS unsigned* xst = (volatile LAS unsigned*)(lds + 131072);
    if (threadIdx.x == 0) { xst[0] = 0u; xst[1] = 0u; }
    __syncthreads();
    const XcdBarrier xb = xcd_barrier_post((unsigned*)(p.ws + OFF_BAR), xst);
    const int vb = (int)blockIdx.x;
    if (p.ph_hi > NPHASE) grid.sync();
#define GSYNC() xcd_barrier(xb)
#ifndef DUP_MASK
#define DUP_MASK 0u
#endif
#ifndef EXTRA_SYNC
#define EXTRA_SYNC 0
#endif
#define PH(n) if (p.ph_lo <= (n) && (n) < p.ph_hi) { run_phase(p, lds, SEQ[n], vb); if ((DUP_MASK >> (n)) & 1u) { GSYNC(); run_phase(p, lds, SEQ[n], vb); } \
        if ((n) + 1 < p.ph_hi) { GSYNC(); for (int _e = 0; _e < EXTRA_SYNC; ++_e) GSYNC(); } }
    PH(0) PH(1) PH(2) PH(3) PH(4) PH(5) PH(6) PH(7) PH(8) PH(9) PH(10) PH(11) PH(12) PH(13) PH(14) PH(15) PH(16) PH(17) PH(18) PH(19) PH(20)
#undef PH
}

extern "C" void kernel_launch(void* const* d_in, const int* in_sizes, int n_in, void* d_out, int out_size, void* d_ws, size_t ws_size, hipStream_t stream) {
    static int grid_blocks = 0;
    if (grid_blocks == 0) {
        if (n_in != 36 || (size_t)out_size != O_END || ws_size < WS_END) { fprintf(stderr, "kernel_launch: unexpected sizes n_in %d out %d ws %zu (need %zu)\n", n_in, out_size, ws_size, (size_t)WS_END); grid_blocks = -1; return; }
        int dev = 0, cus = 0, per_cu = 0;
        hipGetDevice(&dev); hipDeviceGetAttribute(&cus, hipDeviceAttributeMultiprocessorCount, dev);
        if (hipFuncSetAttribute((const void*)fwd_megakernel, hipFuncAttributeMaxDynamicSharedMemorySize, LDS_BYTES) != hipSuccess) { fprintf(stderr, "kernel_launch: hipFuncSetAttribute failed\n"); grid_blocks = -1; return; }
        hipOccupancyMaxActiveBlocksPerMultiprocessor(&per_cu, (const void*)fwd_megakernel, 512, LDS_BYTES);
        if (per_cu < 1) { fprintf(stderr, "kernel_launch: occupancy query says %d blocks per CU\n", per_cu); per_cu = 1; }
        (void)hipGetLastError();
        grid_blocks = cus;
    }
    if (grid_blocks < 0) return;
    Params p{};
    for (int i = 0; i < 36; ++i) p.in[i] = (const float*)d_in[i];
    p.out = (float*)d_out; p.ws = (unsigned char*)d_ws;
#if MULTI_LAUNCH
    for (int ph = 0; ph < NPHASE; ++ph) { p.ph_lo = ph; p.ph_hi = ph + 1; hipLaunchKernelGGL(fwd_megakernel, dim3(grid_blocks), dim3(512), LDS_BYTES, stream, p); }
#else
    p.ph_lo = 0; p.ph_hi = NPHASE;
    if (hipMemsetAsync((unsigned char*)d_ws + OFF_BAR, 0, 16384, stream) != hipSuccess) { fprintf(stderr, "kernel_launch: barrier memset failed\n"); return; }
    void* args[] = {&p};
    hipError_t e = hipLaunchCooperativeKernel((const void*)fwd_megakernel, dim3(grid_blocks), dim3(512), args, LDS_BYTES, stream);
    if (e != hipSuccess) fprintf(stderr, "cooperative launch failed: %s (grid %d)\n", hipGetErrorString(e), grid_blocks);
#endif
}
```
